# Optimizing an MI355X kernel written in HIP

```python
import jax, jax.numpy as jnp
from jax import lax
import numpy as np

D_MODEL = 1024
BATCH = 8
SEQ = 2048
DEPTH = 2

GRID_W = 64
N_MIXERS = 2
HEAD_DIM = 64
A_HEADS = D_MODEL // HEAD_DIM
A_GROUPS = ((128, 1), (512, 4), (2048, 16))
B_HEADS = D_MODEL // HEAD_DIM
B_KV_HEADS = B_HEADS // 4
Q_BLOCK = 128
ROPE_THETA = 10000.0
N_EXPERTS = 32
TOP_K = 4
D_FF = D_MODEL
SWIGLU_LIMIT = 7.0
SWIGLU_ALPHA = 1.702
NORM_EPS = 1e-6

kernel_name = "hybrid_dilated_axial_gqa_moe_encoder"


def rms_norm(x, g):
    xf = x.astype(jnp.float32)
    y = xf * lax.rsqrt(jnp.mean(xf * xf, axis=-1, keepdims=True) + NORM_EPS)
    return (y * g.astype(jnp.float32)).astype(x.dtype)


def rope_tables(pos, dim):
    inv = 1.0 / (ROPE_THETA ** (jnp.arange(0, dim, 2, dtype=jnp.float32) / dim))
    ang = pos.astype(jnp.float32)[:, None] * inv[None, :]
    return jnp.cos(ang), jnp.sin(ang)


def apply_rope(x, cos, sin):
    half = x.shape[-1] // 2
    xf = x.astype(jnp.float32)
    x1, x2 = xf[..., :half], xf[..., half:]
    c, s = cos[:, None, :], sin[:, None, :]
    return jnp.concatenate([x1 * c - x2 * s, x2 * c + x1 * s], axis=-1).astype(x.dtype)


def to_strided(t, d):
    b, s = t.shape[:2]
    t = jnp.swapaxes(t.reshape(b, s // d, d, *t.shape[2:]), 1, 2)
    return t.reshape(b * d, s // d, *t.shape[3:])


def from_strided(t, b, d):
    n, l = t.shape[:2]
    t = jnp.swapaxes(t.reshape(b, d, l, *t.shape[2:]), 1, 2)
    return t.reshape(b, l * d, *t.shape[3:])


def banded_attention(q, k, v, half):
    n, l, h, dh = q.shape
    blk = half
    nb = -(-l // blk)
    lp = nb * blk
    pad = lp - l
    qp = jnp.pad(q, ((0, 0), (0, pad), (0, 0), (0, 0))).reshape(n, nb, blk, h, dh)
    kp = jnp.pad(k, ((0, 0), (blk, pad + blk), (0, 0), (0, 0))).reshape(n, nb + 2, blk, h, dh)
    vp = jnp.pad(v, ((0, 0), (blk, pad + blk), (0, 0), (0, 0))).reshape(n, nb + 2, blk, h, dh)
    kb = jnp.concatenate([kp[:, :-2], kp[:, 1:-1], kp[:, 2:]], axis=2)
    vb = jnp.concatenate([vp[:, :-2], vp[:, 1:-1], vp[:, 2:]], axis=2)
    qpos = jnp.arange(nb)[:, None] * blk + jnp.arange(blk)[None, :]
    kpos = jnp.arange(nb)[:, None] * blk - blk + jnp.arange(3 * blk)[None, :]
    diff = kpos[:, None, :] - qpos[:, :, None]
    valid = (jnp.abs(diff) <= half) & (kpos[:, None, :] >= 0) & (kpos[:, None, :] < l)
    s = jnp.einsum('nbqhd,nbkhd->nbhqk', qp.astype(jnp.float32), kb.astype(jnp.float32)) * (dh ** -0.5)
    s = jnp.where(valid[None, :, None], s, -jnp.inf)
    lse = jax.nn.logsumexp(s, axis=-1, keepdims=True)
    p = jnp.exp(s - lse)
    o = jnp.einsum('nbhqk,nbkhd->nbqhd', p, vb.astype(jnp.float32)).reshape(n, lp, h, dh)[:, :l]
    lse = jnp.transpose(lse[..., 0], (0, 1, 3, 2)).reshape(n, lp, h)[:, :l]
    return o, lse


def dilated_attention(h, w_in, w_out):
    b, s, _ = h.shape
    proj = (h @ w_in).reshape(b, s, len(A_GROUPS), 3, A_HEADS, HEAD_DIM)
    cos, sin = rope_tables(jnp.arange(s), HEAD_DIM)
    outs, lses = [], []
    for g, (window, dil) in enumerate(A_GROUPS):
        q = apply_rope(proj[:, :, g, 0], cos, sin)
        k = apply_rope(proj[:, :, g, 1], cos, sin)
        v = proj[:, :, g, 2]
        o, lse = banded_attention(to_strided(q, dil), to_strided(k, dil), to_strided(v, dil),
                                  window // (2 * dil))
        outs.append(from_strided(o, b, dil))
        lses.append(from_strided(lse, b, dil))
    wts = jax.nn.softmax(jnp.stack(lses, 0), axis=0)
    o = jnp.sum(jnp.stack(outs, 0) * wts[..., None], axis=0)
    return o.astype(h.dtype).reshape(b, s, A_HEADS * HEAD_DIM) @ w_out


def axial_gqa_attention(h, w_in, g_q, g_k, w_out):
    b, s, _ = h.shape
    rows = s // GRID_W
    row_pos = jnp.repeat(jnp.arange(rows), GRID_W)
    col_pos = jnp.tile(jnp.arange(GRID_W), rows)
    qd, kd = B_HEADS * HEAD_DIM, B_KV_HEADS * HEAD_DIM
    proj = h @ w_in
    q = rms_norm(proj[..., :qd].reshape(b, s, B_HEADS, HEAD_DIM), g_q)
    k = rms_norm(proj[..., qd:qd + kd].reshape(b, s, B_KV_HEADS, HEAD_DIM), g_k)
    v = proj[..., qd + kd:].reshape(b, s, B_KV_HEADS, HEAD_DIM)
    half = HEAD_DIM // 2
    cr, sr = rope_tables(row_pos, half)
    cc, sc = rope_tables(col_pos, half)
    q = jnp.concatenate([apply_rope(q[..., :half], cr, sr), apply_rope(q[..., half:], cc, sc)], axis=-1)
    k = jnp.concatenate([apply_rope(k[..., :half], cr, sr), apply_rope(k[..., half:], cc, sc)], axis=-1)
    grp = B_HEADS // B_KV_HEADS
    nq = s // Q_BLOCK
    qb = q.reshape(b, nq, Q_BLOCK, B_KV_HEADS, grp, HEAD_DIM).transpose(1, 0, 2, 3, 4, 5)
    kf = k.astype(jnp.float32)
    vf = v.astype(jnp.float32)
    scale = HEAD_DIM ** -0.5

    def block(qi):
        sc_ = jnp.einsum('bqkgd,bskd->bkgqs', qi.astype(jnp.float32), kf) * scale
        p = jax.nn.softmax(sc_, axis=-1)
        return jnp.einsum('bkgqs,bskd->bqkgd', p, vf).astype(h.dtype)

    o = lax.map(block, qb).transpose(1, 0, 2, 3, 4, 5).reshape(b, s, qd)
    return o @ w_out


def moe_ffn(h, w_router, b_router, w_up, b_up, w_down, b_down):
    b, s, d = h.shape
    t = h.reshape(b * s, d)
    logits = (t @ w_router + b_router).astype(jnp.float32)
    top_v, top_i = lax.top_k(logits, TOP_K)
    gates = jax.nn.softmax(top_v, axis=-1)
    combine = jnp.sum(jax.nn.one_hot(top_i, N_EXPERTS, dtype=jnp.float32) * gates[..., None], axis=1)
    combine = combine.astype(t.dtype)
    y = jnp.zeros_like(t)
    for e in range(N_EXPERTS):
        hu = t @ w_up[e] + b_up[e]
        x_glu = jnp.minimum(hu[..., :D_FF], SWIGLU_LIMIT)
        x_lin = jnp.clip(hu[..., D_FF:], -SWIGLU_LIMIT, SWIGLU_LIMIT)
        act = x_glu * jax.nn.sigmoid(SWIGLU_ALPHA * x_glu) * (x_lin + 1.0)
        y = y + combine[:, e:e + 1] * (act @ w_down[e] + b_down[e])
    return y.reshape(b, s, d)


def modulation(c, w, bias):
    m = jax.nn.silu(c) @ w + bias
    shift, scale, gate = jnp.split(m, 3, axis=-1)
    return shift[:, None, :], scale[:, None, :], gate[:, None, :]


def setup_inputs(seed: int = 0) -> dict:
    key = jax.random.key(seed)
    ks = jax.random.split(key, 24)
    d = D_MODEL
    n_a = len(range(0, DEPTH, N_MIXERS))
    n_b = len(range(1, DEPTH, N_MIXERS))
    a_cols = len(A_GROUPS) * 3 * A_HEADS * HEAD_DIM
    b_cols = (B_HEADS + 2 * B_KV_HEADS) * HEAD_DIM

    def nrm(k, shape, std):
        return jax.random.normal(k, shape, jnp.float32) * std

    return {
        "x": nrm(ks[0], (BATCH, SEQ, d), 1.0),
        "c": nrm(ks[1], (BATCH, d), 1.0),
        "w_mod": nrm(ks[2], (DEPTH, 2, d, 3 * d), 0.5 * d ** -0.5),
        "b_mod": nrm(ks[3], (DEPTH, 2, 3 * d), 0.02),
        "g_pre_mix": 1.0 + nrm(ks[4], (DEPTH, d), 0.05),
        "g_post_mix": 1.0 + nrm(ks[5], (DEPTH, d), 0.05),
        "g_pre_ffn": 1.0 + nrm(ks[6], (DEPTH, d), 0.05),
        "g_post_ffn": 1.0 + nrm(ks[7], (DEPTH, d), 0.05),
        "w_in_a": nrm(ks[8], (n_a, d, a_cols), d ** -0.5),
        "w_out_a": nrm(ks[9], (n_a, A_HEADS * HEAD_DIM, d), (A_HEADS * HEAD_DIM) ** -0.5),
        "w_in_b": nrm(ks[10], (n_b, d, b_cols), d ** -0.5),
        "g_q_b": 1.0 + nrm(ks[11], (n_b, HEAD_DIM), 0.05),
        "g_k_b": 1.0 + nrm(ks[12], (n_b, HEAD_DIM), 0.05),
        "w_out_b": nrm(ks[13], (n_b, B_HEADS * HEAD_DIM, d), (B_HEADS * HEAD_DIM) ** -0.5),
        "w_router": nrm(ks[14], (DEPTH, d, N_EXPERTS), d ** -0.5),
        "b_router": nrm(ks[15], (DEPTH, N_EXPERTS), 0.01),
        "w_up": nrm(ks[16], (DEPTH, N_EXPERTS, d, 2 * D_FF), d ** -0.5),
        "b_up": nrm(ks[17], (DEPTH, N_EXPERTS, 2 * D_FF), 0.02),
        "w_down": nrm(ks[18], (DEPTH, N_EXPERTS, D_FF, d), D_FF ** -0.5),
        "b_down": nrm(ks[19], (DEPTH, N_EXPERTS, d), 0.02),
    }


def reference(x, c, w_mod, b_mod, g_pre_mix, g_post_mix, g_pre_ffn, g_post_ffn,
              w_in_a, w_out_a, w_in_b, g_q_b, g_k_b, w_out_b,
              w_router, b_router, w_up, b_up, w_down, b_down):
    for i in range(DEPTH):
        j = i // N_MIXERS
        shift, scale, gate = modulation(c, w_mod[i, 0], b_mod[i, 0])
        h = rms_norm(x, g_pre_mix[i]) * (1.0 + scale) + shift
        if i % N_MIXERS == 0:
            y = dilated_attention(h, w_in_a[j], w_out_a[j])
        else:
            y = axial_gqa_attention(h, w_in_b[j], g_q_b[j], g_k_b[j], w_out_b[j])
        x = x + gate * rms_norm(y, g_post_mix[i])
        shift, scale, gate = modulation(c, w_mod[i, 1], b_mod[i, 1])
        h = rms_norm(x, g_pre_ffn[i]) * (1.0 + scale) + shift
        y = moe_ffn(h, w_router[i], b_router[i], w_up[i], b_up[i], w_down[i], b_down[i])
        x = x + gate * rms_norm(y, g_post_ffn[i])
    return x
```

```cpp
#include <hip/hip_runtime.h>
#include <cstdio>
#include <cstdint>
#include <cmath>
namespace nv {
constexpr int T = 16384, D = 1024, S = 2048, NB = 8;

__global__ void k_mod(const float* __restrict__ c, const float* __restrict__ w_mod, const float* __restrict__ b_mod, float* __restrict__ mod) {
    const int n = blockIdx.x * 256 + threadIdx.x, b = blockIdx.y, is = blockIdx.z;
    const float* w = w_mod + (size_t)is * 1024 * 3072;
    float acc = 0.f;
    for (int k = 0; k < 1024; ++k) { const float cv = c[b * 1024 + k]; const float s = cv / (1.f + expf(-cv)); acc += s * w[(size_t)k * 3072 + n]; }
    mod[(size_t)(is * 8 + b) * 3072 + n] = acc + b_mod[is * 3072 + n];
}
__device__ __forceinline__ float block_sum256(float v, float* red) {
    for (int o = 32; o > 0; o >>= 1) v += __shfl_xor(v, o);
    const int w = threadIdx.x >> 6;
    __syncthreads();
    if ((threadIdx.x & 63) == 0) red[w] = v;
    __syncthreads();
    return red[0] + red[1] + red[2] + red[3];
}
__global__ void k_prenorm(const float* __restrict__ x, const float* __restrict__ g, const float* __restrict__ mod, float* __restrict__ h) {
    __shared__ float red[4];
    const int t = blockIdx.x, b = t / S;
    float v[4]; float ss = 0.f;
    for (int j = 0; j < 4; ++j) { v[j] = x[(size_t)t * D + threadIdx.x + 256 * j]; ss += v[j] * v[j]; }
    ss = block_sum256(ss, red);
    const float rstd = rsqrtf(ss / D + 1e-6f);
    for (int j = 0; j < 4; ++j) { const int cidx = threadIdx.x + 256 * j;
        h[(size_t)t * D + cidx] = v[j] * rstd * g[cidx] * (1.f + mod[(size_t)b * 3072 + 1024 + cidx]) + mod[(size_t)b * 3072 + cidx]; }
}
__global__ void k_postnorm(const float* xin, const float* __restrict__ y, const float* __restrict__ g, const float* __restrict__ mod, float* xout) {
    __shared__ float red[4];
    const int t = blockIdx.x, b = t / S;
    float v[4]; float ss = 0.f;
    for (int j = 0; j < 4; ++j) { v[j] = y[(size_t)t * D + threadIdx.x + 256 * j]; ss += v[j] * v[j]; }
    ss = block_sum256(ss, red);
    const float rstd = rsqrtf(ss / D + 1e-6f);
    for (int j = 0; j < 4; ++j) { const int cidx = threadIdx.x + 256 * j;
        xout[(size_t)t * D + cidx] = xin[(size_t)t * D + cidx] + mod[(size_t)b * 3072 + 2048 + cidx] * (v[j] * rstd * g[cidx]); }
}
template <int MODE>
__global__ void k_gemm(const float* __restrict__ A, int lda, const int* __restrict__ arows, int ashift, const float* __restrict__ B, int ldb, const float* __restrict__ bias,
                       float* __restrict__ C, int ldc, int M, const int* __restrict__ Mptr, int N, int K, const float* __restrict__ gates) {
    __shared__ float As[16][65], Bs[16][65];
    if (Mptr) M = *Mptr;
    const int m0 = blockIdx.y * 64, n0 = blockIdx.x * 64;
    if (m0 >= M) return;
    const int tx = threadIdx.x & 15, ty = threadIdx.x >> 4;
    float acc[4][4] = {};
    for (int k0 = 0; k0 < K; k0 += 16) {
        for (int i = threadIdx.x; i < 64 * 16; i += 256) { const int r = i >> 4, kk = i & 15; const int m = m0 + r;
            float v = 0.f; if (m < M) { const int ar = (arows && MODE == 0) ? (arows[m] >> ashift) : m; v = A[(size_t)ar * lda + k0 + kk]; } As[kk][r] = v; }
        for (int i = threadIdx.x; i < 64 * 16; i += 256) { const int kk = i >> 6, cc = i & 63; Bs[kk][cc] = B[(size_t)(k0 + kk) * ldb + n0 + cc]; }
        __syncthreads();
#pragma unroll
        for (int kk = 0; kk < 16; ++kk) { float a[4], b[4];
#pragma unroll
            for (int i = 0; i < 4; ++i) { a[i] = As[kk][ty * 4 + i]; b[i] = Bs[kk][tx * 4 + i]; }
#pragma unroll
            for (int i = 0; i < 4; ++i)
#pragma unroll
                for (int j = 0; j < 4; ++j) acc[i][j] += a[i] * b[j]; }
        __syncthreads();
    }
    for (int i = 0; i < 4; ++i) { const int m = m0 + ty * 4 + i; if (m >= M) continue;
        for (int j = 0; j < 4; ++j) { const int n = n0 + tx * 4 + j; float v = acc[i][j] + (bias ? bias[n] : 0.f);
            if (MODE == 0) C[(size_t)m * ldc + n] = v;
            else { const int e = arows[m]; C[(size_t)(e >> ashift) * ldc + n] += gates[e] * v; } } }
}
__global__ void k_rope_a(float* __restrict__ proj) {
    const int t = blockIdx.x, pos = t % S;
    for (int p = threadIdx.x; p < 3072; p += 256) {
        const int f = p & 31, hh = (p >> 5) & 15, j = (p >> 9) & 1, g = p >> 10;
        const float inv = powf(10000.f, -(float)f / 32.f), ang = (float)pos * inv, cs = cosf(ang), sn = sinf(ang);
        float* base = proj + (size_t)t * 9216 + g * 3072 + j * 1024 + hh * 64;
        const float x1 = base[f], x2 = base[f + 32];
        base[f] = x1 * cs - x2 * sn; base[f + 32] = x2 * cs + x1 * sn;
    }
}
__global__ void k_attn_a(const float* __restrict__ proj, float* __restrict__ o) {
    __shared__ float qs[64], ps[132];
    const int t = blockIdx.x, hh = blockIdx.y, lane = threadIdx.x, b = t / S, s = t % S;
    float og[3], lse[3];
    for (int g = 0; g < 3; ++g) {
        const int dl = (g == 0) ? 1 : (g == 1 ? 4 : 16);
        const float* qp = proj + (size_t)t * 9216 + g * 3072 + hh * 64;
        __syncthreads();
        qs[lane] = qp[lane];
        __syncthreads();
        float sc[3]; float mx = -INFINITY;
        for (int r = 0; r < 3; ++r) {
            const int j = lane + 64 * r - 64; sc[r] = -INFINITY;
            if (j <= 64) { const int sk = s + j * dl;
                if (sk >= 0 && sk < S) { const float* kp = proj + (size_t)(b * S + sk) * 9216 + g * 3072 + 1024 + hh * 64; float a = 0.f;
                    for (int d = 0; d < 64; ++d) a += qs[d] * kp[d]; sc[r] = a * 0.125f; } }
            mx = fmaxf(mx, sc[r]);
        }
        for (int o2 = 32; o2 > 0; o2 >>= 1) mx = fmaxf(mx, __shfl_xor(mx, o2));
        float sum = 0.f;
        for (int r = 0; r < 3; ++r) { const float p = (sc[r] == -INFINITY) ? 0.f : expf(sc[r] - mx); sum += p; const int idx = lane + 64 * r; if (idx < 132) ps[idx] = p; }
        for (int o2 = 32; o2 > 0; o2 >>= 1) sum += __shfl_xor(sum, o2);
        __syncthreads();
        float acc = 0.f;
        for (int jj = 0; jj <= 128; ++jj) { const int sk = s + (jj - 64) * dl; if (sk < 0 || sk >= S) continue;
            acc += ps[jj] * proj[(size_t)(b * S + sk) * 9216 + g * 3072 + 2048 + hh * 64 + lane]; }
        og[g] = acc / sum; lse[g] = mx + logf(sum);
    }
    const float m = fmaxf(lse[0], fmaxf(lse[1], lse[2]));
    const float w0 = expf(lse[0] - m), w1 = expf(lse[1] - m), w2 = expf(lse[2] - m), ws = w0 + w1 + w2;
    o[(size_t)t * D + hh * 64 + lane] = (og[0] * w0 + og[1] * w1 + og[2] * w2) / ws;
}
__global__ void k_qknorm_rope_b(float* __restrict__ proj, const float* __restrict__ gq, const float* __restrict__ gk) {
    const int t = blockIdx.x, hh = blockIdx.y, lane = threadIdx.x, s = t % S;
    float* base = proj + (size_t)t * 1536 + hh * 64;
    const float* g = hh < 16 ? gq : gk;
    const float v = base[lane]; float ss = v * v;
    for (int o2 = 32; o2 > 0; o2 >>= 1) ss += __shfl_xor(ss, o2);
    const float xn = v * rsqrtf(ss / 64.f + 1e-6f) * g[lane];
    const int part = lane >> 5, dd = lane & 31, f = dd & 15;
    const int pos = part == 0 ? (s / 64) : (s % 64);
    const float inv = powf(10000.f, -(float)f / 16.f), ang = (float)pos * inv, cs = cosf(ang), sn = sinf(ang);
    const float other = __shfl_xor(xn, 16);
    const float r = (dd < 16) ? (xn * cs - other * sn) : (xn * cs + other * sn);
    __syncthreads();
    base[lane] = r;
}
__global__ void k_attn_b(const float* __restrict__ proj, float* __restrict__ o) {
    __shared__ float qs[64], ps[2048];
    const int t = blockIdx.x, hq = blockIdx.y, lane = threadIdx.x, b = t / S, kvh = hq >> 2;
    qs[lane] = proj[(size_t)t * 1536 + hq * 64 + lane];
    __syncthreads();
    float sc[32]; float mx = -INFINITY;
    for (int i = 0; i < 32; ++i) { const int key = lane + 64 * i; const float* kp = proj + (size_t)(b * S + key) * 1536 + 1024 + kvh * 64; float a = 0.f;
        for (int d = 0; d < 64; ++d) a += qs[d] * kp[d]; sc[i] = a * 0.125f; mx = fmaxf(mx, sc[i]); }
    for (int o2 = 32; o2 > 0; o2 >>= 1) mx = fmaxf(mx, __shfl_xor(mx, o2));
    float sum = 0.f;
    for (int i = 0; i < 32; ++i) { const float p = expf(sc[i] - mx); sum += p; ps[lane + 64 * i] = p; }
    for (int o2 = 32; o2 > 0; o2 >>= 1) sum += __shfl_xor(sum, o2);
    __syncthreads();
    float acc = 0.f;
    for (int key = 0; key < S; ++key) acc += ps[key] * proj[(size_t)(b * S + key) * 1536 + 1280 + kvh * 64 + lane];
    o[(size_t)t * D + hq * 64 + lane] = acc / sum;
}
__global__ void k_router(const float* __restrict__ h, const float* __restrict__ wr, const float* __restrict__ br, int* __restrict__ cnt, int* __restrict__ list, float* __restrict__ gates, int* __restrict__ topi_out) {
    __shared__ float lg[32];
    const int t = blockIdx.x, e = threadIdx.x;
    if (e < 32) { float a = 0.f; for (int k = 0; k < 1024; ++k) a += h[(size_t)t * D + k] * wr[k * 32 + e]; lg[e] = a + br[e]; }
    __syncthreads();
    if (e == 0) {
        int idx[4]; float val[4]; unsigned used = 0;
        for (int k = 0; k < 4; ++k) { int bi = -1; float bv = -INFINITY; for (int j = 0; j < 32; ++j) if (!((used >> j) & 1) && lg[j] > bv) { bv = lg[j]; bi = j; } used |= 1u << bi; idx[k] = bi; val[k] = bv; }
        float sum = 0.f, p[4]; for (int k = 0; k < 4; ++k) { p[k] = expf(val[k] - val[0]); sum += p[k]; }
        for (int k = 0; k < 4; ++k) { const int pos = atomicAdd(&cnt[idx[k]], 1); list[idx[k] * T + pos] = t * 4 + k; gates[t * 4 + k] = p[k] / sum; if (topi_out) topi_out[t * 4 + k] = idx[k]; }
    }
}
__global__ void k_swiglu(float* __restrict__ hu, const int* __restrict__ Mptr) {
    const int m = blockIdx.x; if (m >= *Mptr) return;
    for (int j = threadIdx.x; j < 1024; j += 256) { const float gl = fminf(hu[(size_t)m * 2048 + j], 7.f); const float li = fminf(fmaxf(hu[(size_t)m * 2048 + 1024 + j], -7.f), 7.f);
        hu[(size_t)m * 2048 + j] = gl / (1.f + expf(-1.702f * gl)) * (li + 1.f); }
}
}
struct NvBufs { float *mod, *h, *o, *y, *x, *proj, *gates; int *cnt, *list; };
static NvBufs nv_carve(unsigned char* base) {
    NvBufs b; size_t off = 0; const size_t MiB = 1u << 20;
    b.mod = (float*)(base + off); off += 1 * MiB;
    b.cnt = (int*)(base + off); off += 1 * MiB;
    b.list = (int*)(base + off); off += 2 * MiB;
    b.gates = (float*)(base + off); off += 1 * MiB;
    b.h = (float*)(base + off); off += 64 * MiB;
    b.o = (float*)(base + off); off += 64 * MiB;
    b.y = (float*)(base + off); off += 64 * MiB;
    b.x = (float*)(base + off); off += 64 * MiB;
    b.proj = (float*)(base + off); off += 576 * MiB;
    return b;
}
constexpr size_t NV_BYTES = (size_t)(1 + 1 + 2 + 1 + 64 * 4 + 576) << 20;
struct Inputs { const float *x, *c, *w_mod, *b_mod, *g_pre_mix, *g_post_mix, *g_pre_ffn, *g_post_ffn, *w_in_a, *w_out_a, *w_in_b, *g_q_b, *g_k_b, *w_out_b, *w_router, *b_router, *w_up, *b_up, *w_down, *b_down; };
static Inputs get_inputs(void* const* d_in) {
    Inputs I; const float** p = (const float**)&I; for (int i = 0; i < 20; ++i) p[i] = (const float*)d_in[i]; return I;
}
template <class Hook>
static void nv_forward(const Inputs& I, const NvBufs& B, float* out, hipStream_t st, Hook hook, int n_layers = 2) {
    using namespace nv;
    k_mod<<<dim3(12, 8, 4), 256, 0, st>>>(I.c, I.w_mod, I.b_mod, B.mod);
    const float* xcur = I.x;
    for (int i = 0; i < n_layers; ++i) {
        const float* mod0 = B.mod + (size_t)(i * 2 + 0) * 8 * 3072; const float* mod1 = B.mod + (size_t)(i * 2 + 1) * 8 * 3072;
        k_prenorm<<<T, 256, 0, st>>>(xcur, I.g_pre_mix + i * 1024, mod0, B.h); hook(i, 0);
        if (i == 0) {
            k_gemm<0><<<dim3(9216 / 64, T / 64), 256, 0, st>>>(B.h, 1024, nullptr, 0, I.w_in_a, 9216, nullptr, B.proj, 9216, T, nullptr, 9216, 1024, nullptr);
            k_rope_a<<<T, 256, 0, st>>>(B.proj); hook(i, 1);
            k_attn_a<<<dim3(T, 16), 64, 0, st>>>(B.proj, B.o); hook(i, 2);
            k_gemm<0><<<dim3(1024 / 64, T / 64), 256, 0, st>>>(B.o, 1024, nullptr, 0, I.w_out_a, 1024, nullptr, B.y, 1024, T, nullptr, 1024, 1024, nullptr); hook(i, 3);
        } else {
            k_gemm<0><<<dim3(1536 / 64, T / 64), 256, 0, st>>>(B.h, 1024, nullptr, 0, I.w_in_b, 1536, nullptr, B.proj, 1536, T, nullptr, 1536, 1024, nullptr);
            k_qknorm_rope_b<<<dim3(T, 20), 64, 0, st>>>(B.proj, I.g_q_b, I.g_k_b); hook(i, 1);
            k_attn_b<<<dim3(T, 16), 64, 0, st>>>(B.proj, B.o); hook(i, 2);
            k_gemm<0><<<dim3(1024 / 64, T / 64), 256, 0, st>>>(B.o, 1024, nullptr, 0, I.w_out_b, 1024, nullptr, B.y, 1024, T, nullptr, 1024, 1024, nullptr); hook(i, 3);
        }
        k_postnorm<<<T, 256, 0, st>>>(xcur, B.y, I.g_post_mix + i * 1024, mod0, B.x); hook(i, 4);
        k_prenorm<<<T, 256, 0, st>>>(B.x, I.g_pre_ffn + i * 1024, mod1, B.h); hook(i, 5);
        hipMemsetAsync(B.cnt, 0, 256, st);
        hipMemsetAsync(B.y, 0, (size_t)T * 1024 * 4, st);
        k_router<<<T, 64, 0, st>>>(B.h, I.w_router + (size_t)i * 1024 * 32, I.b_router + i * 32, B.cnt, B.list, B.gates, nullptr); hook(i, 6);
        float* hu = B.proj;
        for (int e = 0; e < 32; ++e) {
            const float* wu = I.w_up + ((size_t)i * 32 + e) * 1024 * 2048; const float* bu = I.b_up + ((size_t)i * 32 + e) * 2048;
            const float* wd = I.w_down + ((size_t)i * 32 + e) * 1024 * 1024; const float* bd = I.b_down + ((size_t)i * 32 + e) * 1024;
            k_gemm<0><<<dim3(2048 / 64, T / 64), 256, 0, st>>>(B.h, 1024, B.list + e * T, 2, wu, 2048, bu, hu, 2048, T, B.cnt + e, 2048, 1024, nullptr);
            k_swiglu<<<T, 256, 0, st>>>(hu, B.cnt + e);
            k_gemm<1><<<dim3(1024 / 64, T / 64), 256, 0, st>>>(hu, 2048, B.list + e * T, 2, wd, 1024, bd, B.y, 1024, T, B.cnt + e, 1024, 1024, B.gates);
        }
        hook(i, 7);
        float* xo = (i == n_layers - 1) ? out : B.x;
        k_postnorm<<<T, 256, 0, st>>>(B.x, B.y, I.g_post_ffn + i * 1024, mod1, xo); hook(i, 8);
        xcur = B.x;
    }
}
extern "C" void kernel_launch(void* const* d_in, const int* in_sizes, int n_in, void* d_out, int out_size, void* d_ws, size_t ws_size, hipStream_t stream) {
    if (n_in != 20 || ws_size < NV_BYTES) { fprintf(stderr, "kernel_launch: unexpected n_in %d / ws %zu\n", n_in, ws_size); return; }
    const Inputs I = get_inputs(d_in);
    const NvBufs B = nv_carve((unsigned char*)d_ws);
    nv_forward(I, B, (float*)d_out, stream, [](int, int) {});
}
```

```cpp
#include <hip/hip_runtime.h>
#include <cstdio>
#include <cstdint>
#include <cmath>
#define GAS __attribute__((address_space(1)))
#define LAS __attribute__((address_space(3)))
typedef unsigned short bf16;
typedef unsigned v4u __attribute__((ext_vector_type(4)));
typedef float f32x4 __attribute__((ext_vector_type(4)));
typedef short bf16x8 __attribute__((ext_vector_type(8)));
typedef GAS unsigned gu32;
typedef GAS unsigned long long gu64;
#define RLX_AGENT __ATOMIC_RELAXED, __HIP_MEMORY_SCOPE_AGENT
#define LDS_WAIT() asm volatile("s_waitcnt lgkmcnt(0)" ::: "memory")
#define VM_WAIT() asm volatile("s_waitcnt vmcnt(0)" ::: "memory")
__device__ __forceinline__ unsigned long long rt() { return __builtin_amdgcn_s_memrealtime(); }
__device__ __forceinline__ unsigned f2bf(float f) { unsigned u = __builtin_bit_cast(unsigned, f); return (u + 0x7fffu + ((u >> 16) & 1u)) >> 16; }
__device__ __forceinline__ unsigned pk2(float lo, float hi) { return f2bf(lo) | (f2bf(hi) << 16); }

#define XB_TMO      128
#define XB_XCNT(j)  (256  + 64 * (j))
#define XB_XSUB(j)  (1280 + 64 * (j))
#define XB_XGEN(j)  (2304 + 64 * (j))
#define XB_TOP      3328
#define XB_TOPGEN   3392
#define XCD_BAR_WORDS 3456
#define XB_SPIN_CAP (1u << 18)

__device__ __forceinline__ unsigned xb_ld(unsigned* p)              { return __hip_atomic_load(p, __ATOMIC_RELAXED, __HIP_MEMORY_SCOPE_AGENT); }
__device__ __forceinline__ unsigned xb_add(unsigned* p, unsigned v) { return __hip_atomic_fetch_add(p, v, __ATOMIC_RELAXED, __HIP_MEMORY_SCOPE_AGENT); }
__device__ __forceinline__ unsigned xb_xcc_id() { return (unsigned)__builtin_amdgcn_s_getreg((3 << 11) | 20) & 0xFu; }
#define XB_SPIN(cond, bar) do { unsigned _sp = 0; while (cond) { __builtin_amdgcn_s_sleep(1); \
    if ((++_sp & 255u) == 0u) { if (xb_ld(&(bar)[XB_TMO])) break; if (_sp > XB_SPIN_CAP) { atomicAdd(&(bar)[XB_TMO], 1u); break; } } } } while (0)

struct XcdBarrier {
    unsigned* bar; unsigned x;
    volatile LAS unsigned* st;
};

__device__ __forceinline__ XcdBarrier xcd_barrier_post(unsigned* bar, volatile LAS unsigned* st) {
    XcdBarrier b; b.bar = bar; b.x = xb_xcc_id(); b.st = st;
    if (threadIdx.x == 0) (void)xb_add(&bar[XB_XCNT(b.x)], 1u);
    return b;
}
__device__ __forceinline__ void xcd_barrier_complete(unsigned* bar, unsigned x, unsigned& nloc, unsigned& nx) {
    const unsigned G = gridDim.x * gridDim.y * gridDim.z;
    unsigned sum, cnt, mine, sp = 0u;
    for (;;) {
        sum = 0u; cnt = 0u; mine = 0u;
#pragma unroll
        for (unsigned j = 0; j < 16; ++j) { const unsigned c = xb_ld(&bar[XB_XCNT(j)]); sum += c; cnt += (c > 0u) ? 1u : 0u; mine = (j == x) ? c : mine; }
        if (sum == G) break;
        __builtin_amdgcn_s_sleep(1);
        if ((++sp & 255u) == 0u) { if (xb_ld(&bar[XB_TMO])) break; if (sp > XB_SPIN_CAP) { atomicAdd(&bar[XB_TMO], 1u); break; } }
    }
    nloc = mine > 0u ? mine : 1u; nx = cnt > 0u ? cnt : 1u;
}

__device__ __forceinline__ void xcd_barrier(const XcdBarrier& b) {
    asm volatile("s_waitcnt vmcnt(0)" ::: "memory");
    __syncthreads();
    if (threadIdx.x == 0) {
        unsigned* bar = b.bar;
        __builtin_amdgcn_s_waitcnt(0);
        unsigned nloc = b.st[0], nx = b.st[1];
        if (nloc == 0u) { xcd_barrier_complete(bar, b.x, nloc, nx); b.st[0] = nloc; b.st[1] = nx; }
        const unsigned old = xb_add(&bar[XB_XSUB(b.x)], 1u);
        const unsigned gen = old / nloc;
        if (old + 1u == (gen + 1u) * nloc) {
            __builtin_amdgcn_fence(__ATOMIC_RELEASE, "agent");
            asm volatile("s_waitcnt vmcnt(0)" ::: "memory");
            const unsigned og = xb_add(&bar[XB_TOP], 1u);
            const unsigned tg = og / nx;
            if (og + 1u == (tg + 1u) * nx) xb_add(&bar[XB_TOPGEN], 1u);
            else XB_SPIN(xb_ld(&bar[XB_TOPGEN]) == tg, bar);
            __builtin_amdgcn_fence(__ATOMIC_ACQUIRE, "agent");
            xb_add(&bar[XB_XGEN(b.x)], 1u);
            asm volatile("s_waitcnt vmcnt(0)" ::: "memory");
        } else {
            XB_SPIN(xb_ld(&bar[XB_XGEN(b.x)]) == gen, bar);
            __builtin_amdgcn_fence(__ATOMIC_ACQUIRE, "agent");
            asm volatile("s_waitcnt vmcnt(0)" ::: "memory");
        }
    }
    __syncthreads();
}
namespace pg8 {
#define PG8_LAS __attribute__((address_space(3)))
typedef unsigned short bf16_t;
typedef short bf16x8 __attribute__((ext_vector_type(8)));
typedef float f32x4 __attribute__((ext_vector_type(4)));
typedef unsigned u32x4 __attribute__((ext_vector_type(4)));
typedef int v4i_t __attribute__((ext_vector_type(4)));
typedef int v8i_t __attribute__((ext_vector_type(8)));
constexpr int BM = 256, BK = 64, HALF = 128, HTB = HALF * BK * 2  , STAGE_BYTES = 8 * HTB, NXCD = 8, WGM = 8;

__host__ __device__ __forceinline__ int lds_byte(int r, int c) { const int st = (r >> 4) * 2 + (c >> 5), rr = r & 15, cc = c & 31, ob = rr * 64 + cc * 2; return st * 1024 + (ob ^ (((ob >> 9) & 1) << 5)); }
__host__ __device__ __forceinline__ void stage_rc(int b, int& R, int& C) { const int st = b / 1024, sb = b % 1024, swz = sb ^ (((sb >> 9) & 1) << 5); R = (st >> 1) * 16 + swz / 64; C = (st & 1) * 32 + (swz % 64) / 2; }
__host__ __device__ __forceinline__ int perm32(int rho) { const int n = rho >> 4, i = rho & 15; return 8 * (i >> 2) + 4 * n + (i & 3); }

struct Unit { const char* a; const char* b; int pm, pn, aux; };
typedef unsigned u32x2 __attribute__((ext_vector_type(2)));
__device__ __forceinline__ unsigned cvt_pk_bf16(float lo, float hi) { unsigned r; asm volatile("v_cvt_pk_bf16_f32 %0, %1, %2" : "=v"(r) : "v"(lo), "v"(hi)); return r; }
struct GridOrder {
    int nM, nN, nwg, G, c;
    __device__ __forceinline__ void init(int nM_, int nN_, int G_, int c_) { nM = nM_; nN = nN_; nwg = nM * nN; G = G_; c = c_; }
    __device__ __forceinline__ bool tile(int i, int& pm, int& pn) const {
        const int L = i * G + c; if (L >= nwg) return false;
        int wgid = L; { const int q = nwg / NXCD, r = nwg % NXCD, xcd = wgid % NXCD, off = wgid / NXCD; wgid = (xcd < r ? xcd * (q + 1) : r * (q + 1) + (xcd - r) * q) + off; }
        const int nig = WGM * nN, gid = wgid / nig, fm = gid * WGM, gsz = (nM - fm) < WGM ? (nM - fm) : WGM;
        pm = fm + ((wgid % nig) % gsz); pn = (wgid % nig) / gsz; return true;
    }
};

template <class Epi, class Sched, bool ALIGN_EPI = false, bool SP2 = false, bool F8 = false>
__device__ __forceinline__ void gemm_phase(PG8_LAS unsigned char* lds, const char* rbase  , const int K, const Sched& S, const Epi& E, const int wid_in  ) {
    int lane; asm volatile("v_mbcnt_lo_u32_b32 %0, -1, 0\n\tv_mbcnt_hi_u32_b32 %0, -1, %0" : "=v"(lane));
    const int wid = wid_in, tid = wid * 64 + lane, wr = wid >> 2, wc = wid & 3, fr = lane & 15, fq = lane >> 4;
    const int nt = K / BK;
    int sc_ab = 122 | (127 << 8); asm volatile("" : "+v"(sc_ab));
    const __amdgpu_buffer_rsrc_t rsrc = __builtin_amdgcn_make_buffer_rsrc((void*)rbase, 0, 0xffffffff, 0x00020000);
    unsigned voffA[2], voffB[2];
#pragma unroll
    for (int i = 0; i < 2; ++i) { int R, C; stage_rc(tid * 16 + i * 8192, R, C); const int Rb = Epi::PERM ? ((R & ~31) + perm32(R & 31)) : R;
        voffA[i] = (unsigned)(R * K + C) * 2u; voffB[i] = (unsigned)(Rb * K + C) * 2u; }
    const size_t kstep = (size_t)(BK * 2);
    const size_t hstep = (size_t)HALF * K * 2;
    const unsigned ldsw = (unsigned)wid * 1024u;
    const int aoff = lds_byte(wr * 64 + fr, fq * 8), boff = lds_byte(wc * 32 + fr, fq * 8);
#define PG8_SA(b, h) (((b) * 2 + (h)) * HTB)
#define PG8_SB(b, h) ((4 + (b) * 2 + (h)) * HTB)
#define PG8_STAGE(bufoff, gbase, voff) do { const unsigned _so = (unsigned)((const char*)(gbase) - rbase); _Pragma("unroll") for (int _i = 0; _i < 2; ++_i) \
        __builtin_amdgcn_raw_ptr_buffer_load_lds(rsrc, (PG8_LAS unsigned*)(lds + (bufoff) + ldsw + _i * 8192), 16, (voff)[_i], _so, 0, 0); } while (0)
#define PG8_LD8(p) __builtin_shufflevector(*(const PG8_LAS v4i_t*)(p), *(const PG8_LAS v4i_t*)((p) + 1024), 0, 1, 2, 3, 4, 5, 6, 7)
#define PG8_LDA(dst, b, h) do { if constexpr (F8) { _Pragma("unroll") for (int m = 0; m < 4; ++m) dst##8[m] = PG8_LD8(lds + PG8_SA(b, h) + aoff + m * 2048); } else { \
        _Pragma("unroll") for (int m = 0; m < 4; ++m) _Pragma("unroll") for (int k = 0; k < 2; ++k) dst[m][k] = *(const PG8_LAS bf16x8*)(lds + PG8_SA(b, h) + aoff + m * 2048 + k * 1024); } } while (0)
#define PG8_LDB(dst, b, h) do { if constexpr (F8) { _Pragma("unroll") for (int n = 0; n < 2; ++n) dst##8[n] = PG8_LD8(lds + PG8_SB(b, h) + boff + n * 2048); } else { \
        _Pragma("unroll") for (int n = 0; n < 2; ++n) _Pragma("unroll") for (int k = 0; k < 2; ++k) dst[n][k] = *(const PG8_LAS bf16x8*)(lds + PG8_SB(b, h) + boff + n * 2048 + k * 1024); } } while (0)
#define PG8_MMA(ai, bj, At, Bt) do { __builtin_amdgcn_s_setprio(1); if constexpr (F8) { _Pragma("unroll") for (int m = 0; m < 4; ++m) _Pragma("unroll") for (int n = 0; n < 2; ++n) \
        acc[ai][bj][m][n] = __builtin_amdgcn_mfma_scale_f32_16x16x128_f8f6f4(Bt##8[n], At##8[m], acc[ai][bj][m][n], 0, 0, 0, sc_ab, 1, sc_ab); } else { \
        _Pragma("unroll") for (int m = 0; m < 4; ++m) _Pragma("unroll") for (int n = 0; n < 2; ++n) _Pragma("unroll") for (int k = 0; k < 2; ++k) \
        acc[ai][bj][m][n] = __builtin_amdgcn_mfma_f32_16x16x32_bf16(Bt[n][k], At[m][k], acc[ai][bj][m][n], 0, 0, 0); } __builtin_amdgcn_s_setprio(0); } while (0)
#define PG8_WAIT_V(n) asm volatile("s_waitcnt vmcnt(" #n ")" ::: "memory")
#define PG8_WAIT_L(n) asm volatile("s_waitcnt lgkmcnt(" #n ")" ::: "memory")
#define PG8_BAR __builtin_amdgcn_s_barrier()
#define PG8_SCHED __builtin_amdgcn_sched_barrier(0)
    Unit cur, nxt; int ui = 0;
    if (!S.next(0, cur)) return;
    f32x4 acc[2][2][4][2];
#pragma unroll
    for (int a = 0; a < 2; ++a)
#pragma unroll
        for (int b = 0; b < 2; ++b)
#pragma unroll
            for (int m = 0; m < 4; ++m)
#pragma unroll
                for (int n = 0; n < 2; ++n) acc[a][b][m][n] = (f32x4){0.f, 0.f, 0.f, 0.f};
    bf16x8 At[4][2], B0[2][2], B1[2][2]; v8i_t At8[4], B08[2], B18[2];
    const char* cA = cur.a; const char* cB = cur.b;
    if constexpr (SP2) {
        PG8_STAGE(PG8_SB(0, 0), cB, voffB); PG8_STAGE(PG8_SB(0, 1), cB + hstep, voffB); PG8_STAGE(PG8_SA(0, 0), cA, voffA); PG8_STAGE(PG8_SA(0, 1), cA + hstep, voffA);
        if (wr == 1) PG8_BAR;
        PG8_WAIT_V(2); PG8_BAR;
        PG8_STAGE(PG8_SB(1, 0), cB + kstep, voffB); PG8_STAGE(PG8_SA(1, 0), cA + kstep, voffA); PG8_STAGE(PG8_SB(1, 1), cB + hstep + kstep, voffB);
        PG8_WAIT_V(6); PG8_BAR;
    } else {
        PG8_STAGE(PG8_SB(0, 0), cB, voffB); PG8_STAGE(PG8_SA(0, 0), cA, voffA); PG8_STAGE(PG8_SB(0, 1), cB + hstep, voffB); PG8_STAGE(PG8_SA(0, 1), cA + hstep, voffA);
        if (wr == 1) PG8_BAR;
        PG8_WAIT_V(4); PG8_BAR;
        PG8_STAGE(PG8_SB(1, 0), cB + kstep, voffB); PG8_STAGE(PG8_SA(1, 0), cA + kstep, voffA); PG8_STAGE(PG8_SB(1, 1), cB + hstep + kstep, voffB);
        PG8_WAIT_V(6); PG8_BAR;
    }
    for (;;) {
        const bool has_next = S.next(ui + 1, nxt);
        const char* nA = has_next ? nxt.a : cA; const char* nB = has_next ? nxt.b : cB;
#pragma nounroll
        for (int t = 0; t < nt; t += 2) {
            const bool last = (t == nt - 2);
            const char* a1 = cA + (size_t)(t + 1) * kstep;
            const char* a2 = last ? nA : cA + (size_t)(t + 2) * kstep; const char* b2 = last ? nB : cB + (size_t)(t + 2) * kstep;
            const char* a3 = a2 + kstep; const char* b3 = b2 + kstep;
            if constexpr (SP2) {
            PG8_LDB(B0, 0, 0); PG8_LDB(B1, 0, 1); PG8_SCHED; PG8_LDA(At, 0, 0); PG8_STAGE(PG8_SA(1, 1), a1 + hstep, voffA);
            PG8_WAIT_V(8); PG8_WAIT_L(0); PG8_BAR; PG8_MMA(0, 0, At, B0); PG8_MMA(0, 1, At, B1); PG8_BAR; PG8_SCHED;
            PG8_LDA(At, 0, 1); PG8_STAGE(PG8_SB(0, 0), b2, voffB); PG8_STAGE(PG8_SB(0, 1), b2 + hstep, voffB); PG8_STAGE(PG8_SA(0, 0), a2, voffA);
            PG8_WAIT_V(8); PG8_WAIT_L(0); PG8_BAR; PG8_MMA(1, 0, At, B0); PG8_MMA(1, 1, At, B1); PG8_BAR; PG8_SCHED;
            PG8_LDB(B0, 1, 0); PG8_LDB(B1, 1, 1); PG8_SCHED; PG8_LDA(At, 1, 0); PG8_STAGE(PG8_SA(0, 1), a2 + hstep, voffA);
            PG8_WAIT_V(8); PG8_WAIT_L(0); PG8_BAR; PG8_MMA(0, 0, At, B0); PG8_MMA(0, 1, At, B1); PG8_BAR; PG8_SCHED;
            PG8_LDA(At, 1, 1); PG8_STAGE(PG8_SB(1, 0), b3, voffB); PG8_STAGE(PG8_SB(1, 1), b3 + hstep, voffB); PG8_STAGE(PG8_SA(1, 0), a3, voffA);
            PG8_WAIT_V(8); PG8_WAIT_L(0); PG8_BAR; PG8_MMA(1, 0, At, B0); PG8_MMA(1, 1, At, B1); PG8_BAR; PG8_SCHED;
            } else {
            PG8_LDB(B0, 0, 0); PG8_SCHED; PG8_LDA(At, 0, 0); PG8_STAGE(PG8_SA(1, 1), a1 + hstep, voffA);
            PG8_WAIT_L(8); PG8_BAR; PG8_WAIT_L(0); PG8_MMA(0, 0, At, B0); PG8_BAR; PG8_SCHED;
            PG8_LDB(B1, 0, 1); PG8_STAGE(PG8_SB(0, 0), b2, voffB);
            PG8_BAR; PG8_WAIT_L(0); PG8_MMA(0, 1, At, B1); PG8_BAR;
            PG8_LDA(At, 0, 1); PG8_STAGE(PG8_SA(0, 0), a2, voffA);
            PG8_BAR; PG8_WAIT_L(0); PG8_MMA(1, 0, At, B0); PG8_BAR; PG8_SCHED;
            PG8_STAGE(PG8_SB(0, 1), b2 + hstep, voffB);
            PG8_WAIT_V(6); PG8_BAR; PG8_MMA(1, 1, At, B1); PG8_BAR;
            PG8_LDB(B0, 1, 0); PG8_SCHED; PG8_LDA(At, 1, 0); PG8_STAGE(PG8_SA(0, 1), a2 + hstep, voffA);
            PG8_WAIT_L(8); PG8_BAR; PG8_WAIT_L(0); PG8_MMA(0, 0, At, B0); PG8_BAR; PG8_SCHED;
            PG8_LDB(B1, 1, 1); PG8_STAGE(PG8_SB(1, 0), b3, voffB);
            PG8_BAR; PG8_WAIT_L(0); PG8_MMA(0, 1, At, B1); PG8_BAR;
            PG8_LDA(At, 1, 1); PG8_STAGE(PG8_SA(1, 0), a3, voffA);
            PG8_BAR; PG8_WAIT_L(0); PG8_MMA(1, 0, At, B0); PG8_BAR; PG8_SCHED;
            PG8_STAGE(PG8_SB(1, 1), b3 + hstep, voffB);
            PG8_WAIT_V(6); PG8_BAR; PG8_MMA(1, 1, At, B1); PG8_BAR;
            }
        }
        if constexpr (ALIGN_EPI) { if (wr == 0) PG8_BAR; }
        E(acc, cur, wr, wc, fr, fq);
        if (!has_next) break;
#pragma unroll
        for (int a = 0; a < 2; ++a)
#pragma unroll
            for (int b = 0; b < 2; ++b)
#pragma unroll
                for (int m = 0; m < 4; ++m)
#pragma unroll
                    for (int n = 0; n < 2; ++n) acc[a][b][m][n] = (f32x4){0.f, 0.f, 0.f, 0.f};
        cur = nxt; cA = nA; cB = nB; ++ui;
        if constexpr (ALIGN_EPI) { if (wr == 1) PG8_BAR; }
    }
    PG8_WAIT_V(0);
    if constexpr (!ALIGN_EPI) { if (wr == 0) PG8_BAR; }
    PG8_BAR;
#undef PG8_SA
#undef PG8_SB
#undef PG8_STAGE
#undef PG8_LDA
#undef PG8_LDB
#undef PG8_MMA
#undef PG8_LD8
#undef PG8_WAIT_V
#undef PG8_WAIT_L
#undef PG8_BAR
#undef PG8_SCHED
}
}

#include <hip/hip_bf16.h>
namespace attn_body {
using bf16=__hip_bfloat16;
using bf16x8=__attribute__((ext_vector_type(8)))short;
using s16x4=__attribute__((ext_vector_type(4)))short;
using f32x16=__attribute__((ext_vector_type(16)))float;
using u32x4=__attribute__((ext_vector_type(4)))unsigned;
constexpr int BATCH=8,NHEAD=16,SEQ=2048,D=64,QP=1024,KVP=256;
constexpr int NW=8,QBLK=32,QB=QBLK*NW,KVBLK=64,NQB=SEQ/QB;
constexpr int ATTN_UNIT_ROWS=QB;
__device__ __forceinline__ int crow(int r,int hi){return (r&3)+8*(r>>2)+4*hi;}
#define SBAR() __builtin_amdgcn_sched_barrier(0)
__device__ __forceinline__ void cmask(f32x16&p0,f32x16&p1,int jb,int qrel,int hi){
  const float NEG=-INFINITY; int kb=64*jb+4*hi;
  #pragma unroll
  for(int r=0;r<16;++r){int kv=kb+(r&3)+8*(r>>2); if(kv>qrel)p0[r]=NEG; if(kv+32>qrel)p1[r]=NEG;}
}

constexpr int NSLOT=3, SLOTB=8192;
constexpr int LDS_K=0, LDS_V=NSLOT*SLOTB, LDS_WS=2*NSLOT*SLOTB, LDS_OST=LDS_WS+NW*64*4, LDS_BYTES=LDS_OST+NW*4096;
constexpr float C2=0.125f*1.4426950408889634f;
__device__ __forceinline__ void glds16(const void*gsrc,unsigned lds_dst){unsigned keep;
  asm volatile("s_mov_b32 %0, m0\n\ts_mov_b32 m0, %2\n\ts_nop 0\n\tglobal_load_lds_dwordx4 %1, off\n\ts_mov_b32 m0, %0":"=&s"(keep):"v"(gsrc),"s"(lds_dst):"memory");}
__device__ __forceinline__ float max3f(float a,float b,float c){float r;asm("v_max3_f32 %0, %1, %2, %3":"=v"(r):"v"(a),"v"(b),"v"(c));return r;}
__device__ __forceinline__ float max2f(float a,float b){float r;asm("v_max_f32_e32 %0, %1, %2":"=v"(r):"v"(a),"v"(b));return r;}
__device__ __forceinline__ float fadd_s(float a,float b){float r;asm("v_add_f32_e32 %0, %1, %2":"=v"(r):"v"(a),"v"(b));return r;}
__device__ __forceinline__ float fsub_s(float a,float b){float r;asm("v_sub_f32_e32 %0, %1, %2":"=v"(r):"v"(a),"v"(b));return r;}
typedef float f32x2_t __attribute__((ext_vector_type(2))); typedef __bf16 bf16x2_t __attribute__((ext_vector_type(2)));
__device__ __forceinline__ unsigned cvtpk_s(float lo,float hi){f32x2_t v={lo,hi};bf16x2_t b=__builtin_convertvector(v,bf16x2_t);return __builtin_bit_cast(unsigned,b);}
#define WAIT_BAR(N) asm volatile("s_waitcnt vmcnt(" #N ") lgkmcnt(0)\n\ts_barrier":::"memory")

__device__ __forceinline__ void qkt(f32x16&p0,f32x16&p1,const char*Kslot,const bf16x8*qr,const f32x16&negm,int r32,int hi){
  const char*kb=Kslot+hi*1024+r32*16;
  #pragma unroll
  for(int d0=0;d0<4;++d0){
    const bf16x8 b0=*reinterpret_cast<const bf16x8*>(kb+d0*2048);
    const bf16x8 b1=*reinterpret_cast<const bf16x8*>(kb+d0*2048+512);
    if(d0==0){p0=__builtin_amdgcn_mfma_f32_32x32x16_bf16(b0,qr[0],negm,0,0,0);p1=__builtin_amdgcn_mfma_f32_32x32x16_bf16(b1,qr[0],negm,0,0,0);}
    else{p0=__builtin_amdgcn_mfma_f32_32x32x16_bf16(b0,qr[d0],p0,0,0,0);p1=__builtin_amdgcn_mfma_f32_32x32x16_bf16(b1,qr[d0],p1,0,0,0);}}
}
typedef __attribute__((address_space(3))) const char* lds_cptr;
typedef short v4i16_t __attribute__((ext_vector_type(4)));
__device__ __forceinline__ void kload8(bf16x8*kf,lds_cptr kp){
  kf[0]=*(const __attribute__((address_space(3))) bf16x8*)(kp);      kf[1]=*(const __attribute__((address_space(3))) bf16x8*)(kp+512);
  kf[2]=*(const __attribute__((address_space(3))) bf16x8*)(kp+2048); kf[3]=*(const __attribute__((address_space(3))) bf16x8*)(kp+2560);
  kf[4]=*(const __attribute__((address_space(3))) bf16x8*)(kp+4096); kf[5]=*(const __attribute__((address_space(3))) bf16x8*)(kp+4608);
  kf[6]=*(const __attribute__((address_space(3))) bf16x8*)(kp+6144); kf[7]=*(const __attribute__((address_space(3))) bf16x8*)(kp+6656);
}
__device__ __forceinline__ void kload2(bf16x8*kf,lds_cptr kp,int j){ kf[2*j]=*(const __attribute__((address_space(3))) bf16x8*)(kp+j*2048); kf[2*j+1]=*(const __attribute__((address_space(3))) bf16x8*)(kp+j*2048+512); }
__device__ __forceinline__ s16x4 vtr(lds_cptr p){ return __builtin_bit_cast(s16x4,__builtin_amdgcn_ds_read_tr16_b64_v4i16((__attribute__((address_space(3))) v4i16_t*)p)); }
__device__ __forceinline__ float rowmax(const f32x16&p0,const f32x16&p1){
  float a=max3f(p0[0],p0[1],p1[0]),b=max3f(p0[2],p0[3],p1[1]);a=max3f(a,p1[2],p1[3]);
  #pragma unroll
  for(int r=4;r<16;r+=4){a=max3f(a,p0[r],p0[r+1]);b=max3f(b,p0[r+2],p0[r+3]);a=max3f(a,p1[r],p1[r+1]);b=max3f(b,p1[r+2],p1[r+3]);}
  const float m=max2f(a,b);
  auto rr=__builtin_amdgcn_permlane32_swap(__float_as_uint(m),__float_as_uint(m),false,false);
  return max2f(__uint_as_float(rr[0]),__uint_as_float(rr[1]));
}
__device__ __forceinline__ void pv(f32x16*o,int vb,bf16x8 pa0,bf16x8 pa1,bf16x8 pa2,bf16x8 pa3){
  #pragma unroll
  for(int d0=0;d0<2;++d0){s16x4 lo[4],hi[4];
    #pragma unroll
    for(int ks=0;ks<4;++ks){
      asm volatile("ds_read_b64_tr_b16 %0,%1 offset:%c2":"=&v"(lo[ks]):"v"(vb),"i"(d0*4096+ks*1024):"memory");
      asm volatile("ds_read_b64_tr_b16 %0,%1 offset:%c2":"=&v"(hi[ks]):"v"(vb),"i"(d0*4096+ks*1024+512):"memory");}
    asm volatile("s_waitcnt lgkmcnt(0)":::"memory");SBAR();
    #define PK(k) (bf16x8){lo[k][0],lo[k][1],lo[k][2],lo[k][3],hi[k][0],hi[k][1],hi[k][2],hi[k][3]}
    o[d0]=__builtin_amdgcn_mfma_f32_32x32x16_bf16(pa0,PK(0),o[d0],0,0,0);
    o[d0]=__builtin_amdgcn_mfma_f32_32x32x16_bf16(pa1,PK(1),o[d0],0,0,0);
    o[d0]=__builtin_amdgcn_mfma_f32_32x32x16_bf16(pa2,PK(2),o[d0],0,0,0);
    o[d0]=__builtin_amdgcn_mfma_f32_32x32x16_bf16(pa3,PK(3),o[d0],0,0,0);
    #undef PK
  }
}

#ifndef ATTN_STORE16
#define ATTN_STORE16(p,v) (*(u32x4*)(p)=(v))
#endif
template<int THRL> __device__ __forceinline__ void attn_unit(int b,int h,int kvh,int qb,const bf16*Q,const bf16*__restrict__ K,const bf16*__restrict__ V,bf16*O,char*shm,const int wid_in){
  int lane; asm volatile("v_mbcnt_lo_u32_b32 %0, -1, 0\n\tv_mbcnt_hi_u32_b32 %0, -1, %0":"=v"(lane)); const int r32=lane&31,hi=lane>>5; const int wid=wid_in;
  const long rowbase=(long)b*SEQ; const int q0=qb*QB;
  const bf16*Qw=Q+(rowbase+q0+wid*QBLK)*QP+h*D;
  const bf16*Kh=K+((long)(b*4+kvh)*(SEQ/KVBLK))*4096,*Vh=V+((long)(b*4+kvh)*(SEQ/KVBLK))*4096;
  const unsigned lds0=(unsigned)(uintptr_t)shm;
  float*wsf=(float*)(shm+LDS_WS)+wid*64;
  const bf16*ksrc=Kh+wid*512+lane*8;
  const bf16*vsrc=Vh+wid*512+lane*8;
  const unsigned kdst=lds0+LDS_K+wid*1024, vdst=lds0+LDS_V+wid*1024;
  #define DMA_K(t,slot) glds16(ksrc+(long)(t)*4096,(unsigned)__builtin_amdgcn_readfirstlane(kdst+(slot)))
  #define DMA_V(t,slot) glds16(vsrc+(long)(t)*4096,(unsigned)__builtin_amdgcn_readfirstlane(vdst+(slot)))
  const int vb0=(int)(lds0+LDS_V)+((lane>>4)&1)*32+(lane&3)*8+(4*hi+((lane&15)>>2))*64;
  const char*Kbase=shm+LDS_K; bf16x8 kf[8];
  const lds_cptr shm3=(lds_cptr)shm; const lds_cptr kp0=shm3+LDS_K+hi*1024+r32*16; const lds_cptr vp0=shm3+LDS_V+((lane>>4)&1)*32+(lane&3)*8+(4*hi+((lane&15)>>2))*64;
  constexpr int NT=SEQ/KVBLK;
  DMA_K(0,0);DMA_V(0,0);DMA_K(1,SLOTB);
  bf16x8 qr[4];
  #pragma unroll
  for(int d0=0;d0<4;++d0)qr[d0]=*reinterpret_cast<const bf16x8*>(&Qw[(long)r32*QP+d0*16+hi*8]);
  float mhat=0.f,l_reg=0.f;f32x16 o[2];o[0]=f32x16{};o[1]=f32x16{};f32x16 negm=f32x16{};asm volatile("":"+v"(negm));
  #define CMASK(P0,P1,t) do{}while(0)
  bool resc=false;
  #define START(P0,P1) do{ const float rm=rowmax(P0,P1); resc=false; \
    { const float dl=rm; mhat=fadd_s(mhat,dl); \
      _Pragma("unroll") for(int r=0;r<16;++r){P0[r]=fsub_s(P0[r],dl);P1[r]=fsub_s(P1[r],dl);} \
      _Pragma("unroll") for(int r=0;r<16;++r)negm[r]=-mhat; asm volatile("":"+v"(negm)); } \
    _Pragma("unroll") for(int r=0;r<16;++r)P0[r]=__builtin_amdgcn_exp2f(P0[r]); }while(0)
  #define RESC() do{ if(resc){ asm volatile("s_waitcnt lgkmcnt(0)":::"memory"); \
      _Pragma("unroll") for(int d_=0;d_<2;++d_) _Pragma("unroll") for(int r=0;r<16;++r)o[d_][r]*=wsf[crow(r,hi)]; } }while(0)
  f32x16 pA0,pA1,pB0,pB1;
  int sl_prev=0,sl_cur=0,sl_next=SLOTB;
  #define ROT() do{sl_prev=sl_cur;sl_cur=sl_next;sl_next=(sl_next==(NSLOT-1)*SLOTB)?0:sl_next+SLOTB;}while(0)
  DMA_K(2,2*SLOTB);
  WAIT_BAR(3);
  qkt(pA0,pA1,Kbase,qr,negm,r32,hi);asm volatile("s_nop 15\n\ts_nop 7":"+v"(pA0),"+v"(pA1));CMASK(pA0,pA1,0);
  START(pA0,pA1);
  _Pragma("unroll") for(int r=0;r<16;++r)pA1[r]=__builtin_amdgcn_exp2f(pA1[r]);
  WAIT_BAR(0);
  DMA_K(3,0);DMA_V(1,SLOTB);
  ROT();
  kload8(kf,kp0+sl_cur);
  WAIT_BAR(2);
  s16x4 vlo[8],vhi[8]; u32x4 pw0,pw1,pw2,pw3;
  #define PKW(P,B) cvtpk_s(P[B],P[B+1])
  #define PAF(k) __builtin_bit_cast(bf16x8,pw##k)
  #define VFR(i) (bf16x8){vlo[i][0],vlo[i][1],vlo[i][2],vlo[i][3],vhi[i][0],vhi[i][1],vhi[i][2],vhi[i][3]}
  #define PIN(x) asm volatile("":"+v"(x))
  #define MX3(a,b,c) __builtin_fmaxf(__builtin_fmaxf((a),(b)),(c))
  #define GAPA(MF,A0,A1,A2,A3,W0,W1,PW) do{ MF; sacc+=A0; sacc+=A1; sacc+=A2; sacc+=A3; PIN(sacc); W0; W1; PIN(PW); SBAR(); }while(0)
  #define EX(v) __builtin_amdgcn_exp2f(v)
  #define GAPB(MF,X,B) do{ MF; X[B]=EX(X[B]); X[B+1]=EX(X[B+1]); X[B+2]=EX(X[B+2]); X[B+3]=EX(X[B+3]); PIN(X); SBAR(); }while(0)
  #define VRD(i) do{ vlo[i]=vtr(vp_+(((i)>>2)*4096+((i)&3)*1024)); vhi[i]=vtr(vp_+(((i)>>2)*4096+((i)&3)*1024+512)); }while(0)
  #define KRD(G,j) do{ if(G){ kload2(kf,kp0+sl_next,j); SBAR(); } }while(0)
  #define STEP(C0,C1,P0,P1,t,GK,GV,GL) do{ SBAR(); \
    const lds_cptr vp_=vp0+sl_prev; \
    VRD(0); SBAR(); float sacc=(P0[0]+P0[1]); \
    GAPA(C0=__builtin_amdgcn_mfma_f32_32x32x16_bf16(kf[0],qr[0],negm,0,0,0), P0[2],P0[3],P0[4],P0[5],     pw0[0]=PKW(P0,0), pw0[1]=PKW(P0,2), pw0); \
    VRD(4); SBAR(); GAPA(C1=__builtin_amdgcn_mfma_f32_32x32x16_bf16(kf[1],qr[0],negm,0,0,0), P0[6],P0[7],P0[8],P0[9],     pw0[2]=PKW(P0,4), pw0[3]=PKW(P0,6), pw0); \
    VRD(1); SBAR(); GAPA(C0=__builtin_amdgcn_mfma_f32_32x32x16_bf16(kf[2],qr[1],C0,0,0,0),   P0[10],P0[11],P0[12],P0[13], pw1[0]=PKW(P0,8), pw1[1]=PKW(P0,10), pw1); \
    VRD(5); SBAR(); GAPA(C1=__builtin_amdgcn_mfma_f32_32x32x16_bf16(kf[3],qr[1],C1,0,0,0),   P0[14],P0[15],P1[0],P1[1],   pw1[2]=PKW(P0,12),pw1[3]=PKW(P0,14), pw1); \
    VRD(2); SBAR(); GAPA(C0=__builtin_amdgcn_mfma_f32_32x32x16_bf16(kf[4],qr[2],C0,0,0,0),   P1[2],P1[3],P1[4],P1[5],     pw2[0]=PKW(P1,0), pw2[1]=PKW(P1,2), pw2); \
    VRD(6); SBAR(); GAPA(C1=__builtin_amdgcn_mfma_f32_32x32x16_bf16(kf[5],qr[2],C1,0,0,0),   P1[6],P1[7],P1[8],P1[9],     pw2[2]=PKW(P1,4), pw2[3]=PKW(P1,6), pw2); \
    VRD(3); SBAR(); GAPA(C0=__builtin_amdgcn_mfma_f32_32x32x16_bf16(kf[6],qr[3],C0,0,0,0),   P1[10],P1[11],P1[12],P1[13], pw3[0]=PKW(P1,8), pw3[1]=PKW(P1,10), pw3); \
    VRD(7); SBAR(); GAPA(C1=__builtin_amdgcn_mfma_f32_32x32x16_bf16(kf[7],qr[3],C1,0,0,0),   P1[14],P1[15],0.f,0.f,       pw3[2]=PKW(P1,12),pw3[3]=PKW(P1,14), pw3); \
    l_reg+=sacc; \
    if(GK){DMA_K((t)+3,sl_cur);} if(GV){DMA_V((t)+1,sl_next);} \
    CMASK(C0,C1,t); \
    { float a=MX3(C0[0],C0[1],C1[0]),b=MX3(C0[2],C0[3],C1[1]); a=MX3(a,C1[2],C1[3]); \
      _Pragma("unroll") for(int r=4;r<16;r+=4){a=MX3(a,C0[r],C0[r+1]);b=MX3(b,C0[r+2],C0[r+3]);a=MX3(a,C1[r],C1[r+1]);b=MX3(b,C1[r+2],C1[r+3]);} \
      float rm=__builtin_fmaxf(a,b); { auto rr=__builtin_amdgcn_permlane32_swap(__float_as_uint(rm),__float_as_uint(rm),false,false); rm=__builtin_fmaxf(__uint_as_float(rr[0]),__uint_as_float(rr[1])); } \
      resc=false; \
      if(__builtin_expect(__any(rm>(float)THRL),0)){ const float dl=__builtin_fmaxf(rm,0.f); mhat+=dl; \
        _Pragma("unroll") for(int r=0;r<16;++r){C0[r]-=dl;C1[r]-=dl;} \
        _Pragma("unroll") for(int r=0;r<16;++r)negm[r]=-mhat; asm volatile("":"+v"(negm)); \
        const float f=__builtin_amdgcn_exp2f(-dl); l_reg*=f; if(hi==0)wsf[r32]=f; resc=true; } } \
    SBAR(); \
    GAPB(o[0]=__builtin_amdgcn_mfma_f32_32x32x16_bf16(PAF(0),VFR(0),o[0],0,0,0), C0,0); \
    GAPB(o[1]=__builtin_amdgcn_mfma_f32_32x32x16_bf16(PAF(0),VFR(4),o[1],0,0,0), C0,4); \
    KRD(GL,0); GAPB(o[0]=__builtin_amdgcn_mfma_f32_32x32x16_bf16(PAF(1),VFR(1),o[0],0,0,0), C0,8); \
    KRD(GL,1); GAPB(o[1]=__builtin_amdgcn_mfma_f32_32x32x16_bf16(PAF(1),VFR(5),o[1],0,0,0), C0,12); \
    KRD(GL,2); GAPB(o[0]=__builtin_amdgcn_mfma_f32_32x32x16_bf16(PAF(2),VFR(2),o[0],0,0,0), C1,0); \
    KRD(GL,3); GAPB(o[1]=__builtin_amdgcn_mfma_f32_32x32x16_bf16(PAF(2),VFR(6),o[1],0,0,0), C1,4); \
    GAPB(o[0]=__builtin_amdgcn_mfma_f32_32x32x16_bf16(PAF(3),VFR(3),o[0],0,0,0), C1,8); \
    GAPB(o[1]=__builtin_amdgcn_mfma_f32_32x32x16_bf16(PAF(3),VFR(7),o[1],0,0,0), C1,12); \
    }while(0)
  int t=1;
  #undef CMASK
  #define CMASK(P0,P1,t) do{}while(0)
  for(;t+5<NT;t+=2){
    STEP(pB0,pB1,pA0,pA1,t,true,true,true);     WAIT_BAR(2); RESC(); ROT();
    STEP(pA0,pA1,pB0,pB1,t+1,true,true,true);   WAIT_BAR(2); RESC(); ROT();
  }
  #undef CMASK
  #define CMASK(P0,P1,t) do{}while(0)
  #define ENDW(tt) do{ if((tt)+3<NT){WAIT_BAR(2);} else if((tt)+2<NT){WAIT_BAR(1);} else {WAIT_BAR(0);} }while(0)
  for(;t+1<NT;t+=2){
    STEP(pB0,pB1,pA0,pA1,t,(t+3<NT),(t+1<NT),(t+1<NT));       ENDW(t);   RESC(); ROT();
    STEP(pA0,pA1,pB0,pB1,t+1,(t+4<NT),(t+2<NT),(t+2<NT));     ENDW(t+1); RESC(); ROT();
  }
  STEP(pB0,pB1,pA0,pA1,NT-1,false,false,false); RESC();
  { float sacc=pB0[0]+pB0[1]; _Pragma("unroll") for(int r=2;r<16;++r)sacc+=pB0[r]; _Pragma("unroll") for(int r=0;r<16;++r)sacc+=pB1[r]; l_reg+=sacc;
    pw0=(u32x4){PKW(pB0,0),PKW(pB0,2),PKW(pB0,4),PKW(pB0,6)};pw1=(u32x4){PKW(pB0,8),PKW(pB0,10),PKW(pB0,12),PKW(pB0,14)};pw2=(u32x4){PKW(pB1,0),PKW(pB1,2),PKW(pB1,4),PKW(pB1,6)};pw3=(u32x4){PKW(pB1,8),PKW(pB1,10),PKW(pB1,12),PKW(pB1,14)};
    SBAR(); pv(o,vb0+sl_cur,PAF(0),PAF(1),PAF(2),PAF(3)); }
  #undef PKW
  #undef PAF
  #undef VFR
  #undef PIN
  #undef MX3
  #undef GAPA
  #undef GAPB
  #undef EX
  #undef VRD
  #undef KRD
  #undef STEP
  #undef ENDW
  {auto rr=__builtin_amdgcn_permlane32_swap(__float_as_uint(l_reg),__float_as_uint(l_reg),false,false);l_reg=__uint_as_float(rr[0])+__uint_as_float(rr[1]);}
  if(hi==0)wsf[32+r32]=l_reg;asm volatile("s_waitcnt lgkmcnt(0)":::"memory");
  float rli[16];
  #pragma unroll
  for(int r=0;r<16;++r)rli[r]=__builtin_amdgcn_rcpf(wsf[32+crow(r,hi)]);
  bf16*Ow=O+(rowbase+q0+wid*QBLK)*QP+h*D;
  { bf16*stg=(bf16*)(shm+LDS_OST)+wid*2048;
    #pragma unroll
    for(int r=0;r<16;++r){const int orow=crow(r,hi);
      #pragma unroll
      for(int d0=0;d0<2;++d0)stg[orow*64+d0*32+r32]=__float2bfloat16(o[d0][r]*rli[r]);}
    asm volatile("s_waitcnt lgkmcnt(0)":::"memory");
    #pragma unroll
    for(int i=0;i<4;++i){const int row=i*8+(lane>>3),ch=lane&7; const u32x4 v=*(const u32x4*)(stg+row*64+ch*8); ATTN_STORE16(Ow+(long)row*QP+ch*8,v);} }
  asm volatile("s_waitcnt lgkmcnt(0)\n\ts_barrier":::"memory");
  #undef DMA_K
  #undef DMA_V
  #undef CMASK
  #undef START
  #undef RESC
  #undef ROT
}
constexpr int ATTN_LDS_BYTES=LDS_BYTES;

#undef SBAR
#undef WAIT_BAR
}
constexpr int T = 16384, D = 1024, SEQ = 2048, NBATCH = 8, NEXP = 32;
constexpr float C2F = 0.125f * 1.4426950408889634f;
constexpr float LN2F = 0.6931471805599453f;
constexpr float NORM_EPS = 1e-6f;
constexpr size_t MiB = 1u << 20;
constexpr size_t WS_CTL = 0, CTL_ZERO_BYTES = 1 * MiB;
constexpr size_t WS_MOD = 1 * MiB;
constexpr size_t WS_ROPEA = 2 * MiB;
constexpr size_t WS_ROPEB = 3 * MiB;
constexpr size_t WS_WRT = 3 * MiB + 65536;
constexpr size_t WS_HIST = 4 * MiB;
constexpr size_t WS_TOT = 4 * MiB + 65536;
constexpr size_t WS_GSORT = 5 * MiB;
constexpr size_t WS_POSOF = 5 * MiB + 524288;
constexpr size_t WS_LSE = 6 * MiB;
constexpr size_t WS_WINA_QK = 16 * MiB, WS_WINA_V = 28 * MiB, WS_WOUTA = 34 * MiB, WS_WINB = 36 * MiB, WS_WOUTB = 39 * MiB;
constexpr size_t WS_WUP = 48 * MiB, WS_WDOWN = 304 * MiB;
constexpr size_t WS_XA = 432 * MiB;
constexpr size_t WS_H0 = 496 * MiB, WS_H1 = 528 * MiB, WS_H2 = 560 * MiB;
constexpr size_t WS_QA = 592 * MiB, WS_KA = 688 * MiB, WS_VTA = 784 * MiB;
constexpr size_t WS_OG = 880 * MiB;
constexpr size_t WS_O = 976 * MiB, WS_Y = 1008 * MiB;
constexpr size_t WS_XS = 592 * MiB, WS_ACT = 736 * MiB, WS_OUTS = 880 * MiB;
constexpr size_t WS_QB = 880 * MiB, WS_KB = 912 * MiB, WS_VB = 920 * MiB;
constexpr size_t WS_END = 1040 * MiB;
static_assert(WS_H2 - WS_H1 == WS_H1 - WS_H0, "H0/H1/H2 equally spaced");
constexpr int MAXROWS = 73728, MAXTILES = 288;
constexpr size_t TSTEP = (size_t)256 * 1024 * 2;
constexpr size_t TSTEP8 = (size_t)256 * 1024;
constexpr float W8_SCALE = 32.0f;
constexpr int CW_TMO = 0, CW_CODE = 1, CW_BAR = 4096, CW_CMP = 200000;
constexpr int RING_BYTES = 131072;
constexpr int TBL_OFF = 135168;
constexpr int RT_PITCH = 2064, RT_LO = 32 * RT_PITCH, T_LG = 139264;
constexpr int T_SEL = TBL_OFF, T_GTE = TBL_OFF + 1024, T_RNK = TBL_OFF + 2048, T_TOT = TBL_OFF + 3072, T_BEF = T_TOT + 128, T_PBASE = T_BEF + 128, T_MYOFF = T_PBASE + 128, T_TEXP = T_MYOFF + 128, T_MT = T_TEXP + 512;
constexpr int LDSCTL_OFF = 143360, MISC_OFF = LDSCTL_OFF + 320;
constexpr int LDS_BYTES = 151552;
constexpr int T_LG2 = 147456;
constexpr int NWAVES = 8;

typedef unsigned u32x2v __attribute__((ext_vector_type(2)));
typedef float f32x16 __attribute__((ext_vector_type(16)));
typedef float f32x2t __attribute__((ext_vector_type(2)));
typedef __bf16 bf16x2t __attribute__((ext_vector_type(2)));
__device__ __forceinline__ unsigned pkbf(float lo, float hi) { f32x2t v = {lo, hi}; bf16x2t b = __builtin_convertvector(v, bf16x2t); return __builtin_bit_cast(unsigned, b); }
__device__ __forceinline__ unsigned pk4_fp8(float a, float b, float c, float d) { unsigned w = 0; w = __builtin_amdgcn_cvt_pk_fp8_f32(a, b, w, false); w = __builtin_amdgcn_cvt_pk_fp8_f32(c, d, w, true); return w; }
__device__ __forceinline__ float bflo(unsigned u) { return __builtin_bit_cast(float, u << 16); }
__device__ __forceinline__ float bfhi(unsigned u) { return __builtin_bit_cast(float, u & 0xffff0000u); }
__device__ __forceinline__ v4u pack8(f32x4 a, f32x4 b) { v4u w; w.x = pkbf(a[0], a[1]); w.y = pkbf(a[2], a[3]); w.z = pkbf(b[0], b[1]); w.w = pkbf(b[2], b[3]); return w; }
__device__ __forceinline__ float wave_sum(float v) {
#pragma unroll
    for (int o = 1; o < 64; o <<= 1) v += __shfl_xor(v, o);
    return v;
}
__device__ __forceinline__ float hsum4(f32x4 v) { return (v[0] + v[1]) + (v[2] + v[3]); }
__device__ __forceinline__ float dot4(f32x4 a, f32x4 b) { return (a[0] * b[0] + a[1] * b[1]) + (a[2] * b[2] + a[3] * b[3]); }
__device__ __forceinline__ int perm_row(int t, int sh) { const int s = t & 2047; return (t & ~2047) + ((s & ((1 << sh) - 1)) << (11 - sh)) + (s >> sh); }
__device__ __forceinline__ int unperm_row(int p, int sh) { const int pp = p & 2047, Lsh = 11 - sh; return (p & ~2047) + ((pp & ((1 << Lsh) - 1)) << sh) + (pp >> Lsh); }

__host__ __device__ __forceinline__ int swap23(int r) { return (r & 0x13) | ((r & 4) << 1) | ((r & 8) >> 1); }
__host__ __device__ __forceinline__ size_t qk_chunk(int g, int h, int blk) { return ((size_t)(g * 16 + h) * 512 + blk) * 2048; }
struct Args { const float* in[20]; float* out; unsigned char* ws; int ph_lo, ph_hi, li, pad; };
__device__ __forceinline__ int lane_id() { int l; asm volatile("v_mbcnt_lo_u32_b32 %0, -1, 0\n\tv_mbcnt_hi_u32_b32 %0, -1, %0" : "=v"(l)); return l; }
__device__ __forceinline__ unsigned char* opaque_ptr(unsigned char* p) { asm volatile("" : "+s"(p)); return p; }
#ifndef PSEC
#define PSEC 0
#endif
#define SEC_BEGIN(id) unsigned long long tsec_##id = 0; if ((id) == PSEC) tsec_##id = __builtin_amdgcn_s_memrealtime()
#define SEC_END(id) do { if ((id) == PSEC && F.wave == 0 && lane_id() == 0) F.MISC[16] += (unsigned)(__builtin_amdgcn_s_memrealtime() - tsec_##id); } while (0)
struct Frame {
    LAS unsigned char* lds;
    volatile LAS unsigned* MISC;
    gu32* ctl;
    int wave, G, vcu;
    float* out; unsigned char* ws;
};
enum { IN_X = 0, IN_C, IN_WMOD, IN_BMOD, IN_GPREMIX, IN_GPOSTMIX, IN_GPREFFN, IN_GPOSTFFN, IN_WINA, IN_WOUTA, IN_WINB, IN_GQB, IN_GKB, IN_WOUTB, IN_WROUTER, IN_BROUTER, IN_WUP, IN_BUP, IN_WDOWN, IN_BDOWN };

struct RmNat { __device__ __forceinline__ int operator()(int c) const { return c; } };
struct RmInA { unsigned char* qk; unsigned char* v;
    __device__ __forceinline__ unsigned char* row(int c) const { const int g = c / 3072, rem = c - g * 3072, j = rem >> 10, cc = rem & 1023;
        if (j < 2) { const int hq4 = cc >> 8, wc = (cc >> 6) & 3, bj = (cc >> 5) & 1, t = cc & 31; return qk + (size_t)(g * 2048 + (j * 4 + hq4) * 256 + 128 * bj + 32 * wc + t) * 1024; }
        return v + (size_t)(g * 1024 + cc) * 1024; } };
__device__ __forceinline__ int rm_inb(int c) { const int pn = c >> 8, cc = c & 255, wc = cc >> 6, dm = cc & 63, bj = (dm >> 4) & 1, fq = 2 * (dm >> 5) + ((dm >> 3) & 1), n = (dm >> 2) & 1, i = dm & 3; return pn * 256 + 128 * bj + 32 * wc + 8 * fq + 4 * n + i; }
__device__ __forceinline__ int rm_lin(int c) { const int pn = c >> 8, cc = c & 255, wc = cc >> 6, bj = (cc >> 5) & 1, t = cc & 31; return pn * 256 + 128 * bj + 32 * wc + t; }
__device__ __forceinline__ int rm_up(int c) { const int bj = c >> 10, pn = (c & 1023) >> 7, jj = c & 127; return pn * 256 + 128 * bj + jj; }
constexpr int I_UP = 64 * 32 * 8, I_DN = 64 * 16 * 8, I_INA = 144 * 8, I_OUT = 16 * 16, I_INB = 24 * 16;
constexpr int NITEMS = I_UP + I_DN + I_INA + 2 * I_OUT + I_INB;
struct CvtItem { const float* src; int ldw; int kind, le, k0, n0; };
__device__ __forceinline__ CvtItem cvt_decode(const Args& args, int it) {
    CvtItem c; int r = it;
    if (r < I_UP) { c.kind = 0; c.le = r >> 8; const int q = r & 255; c.k0 = (q >> 5) * 128; c.n0 = (q & 31) * 64; c.ldw = 2048; c.src = args.in[IN_WUP] + (size_t)c.le * 1024 * 2048; }
    else if ((r -= I_UP) < I_DN) { c.kind = 1; c.le = r >> 7; const int q = r & 127; c.k0 = (q >> 4) * 128; c.n0 = (q & 15) * 64; c.ldw = 1024; c.src = args.in[IN_WDOWN] + (size_t)c.le * 1024 * 1024; }
    else if ((r -= I_DN) < I_INA) { c.kind = 2; c.le = 0; c.k0 = (r / 144) * 128; c.n0 = (r % 144) * 64; c.ldw = 9216; c.src = args.in[IN_WINA]; }
    else if ((r -= I_INA) < I_OUT) { c.kind = 3; c.le = 0; c.k0 = (r >> 4) * 64; c.n0 = (r & 15) * 64; c.ldw = 1024; c.src = args.in[IN_WOUTA]; }
    else if ((r -= I_OUT) < I_OUT) { c.kind = 4; c.le = 0; c.k0 = (r >> 4) * 64; c.n0 = (r & 15) * 64; c.ldw = 1024; c.src = args.in[IN_WOUTB]; }
    else { r -= I_OUT; c.kind = 5; c.le = 0; c.k0 = (r / 24) * 64; c.n0 = (r % 24) * 64; c.ldw = 1536; c.src = args.in[IN_WINB]; }
    return c;
}
__device__ __forceinline__ void cvt_load(const CvtItem& c, int half, f32x4 (&v)[16], int lane) {
    const float* p = c.src + (size_t)(c.k0 + 64 * half + 4 * (lane >> 4)) * c.ldw + c.n0 + 4 * (lane & 15);
#pragma unroll
    for (int i = 0; i < 16; ++i) v[i] = __builtin_nontemporal_load((const GAS f32x4*)(p + (size_t)(16 * (i >> 2) + (i & 3)) * c.ldw));
}
__device__ __forceinline__ unsigned char* cvt_row(const CvtItem& c, unsigned char* ws, int cidx) {
    switch (c.kind) {
    case 0: return ws + WS_WUP + ((size_t)c.le * 2048 + rm_up(cidx)) * 1024;
    case 1: return ws + WS_WDOWN + ((size_t)c.le * 1024 + rm_lin(cidx)) * 1024;
    case 2: { const RmInA rm{ws + WS_WINA_QK, ws + WS_WINA_V}; return rm.row(cidx); }
    case 3: return ws + WS_WOUTA + (size_t)rm_lin(cidx) * 2048;
    case 4: return ws + WS_WOUTB + (size_t)rm_lin(cidx) * 2048;
    default: return ws + WS_WINB + (size_t)rm_inb(cidx) * 2048;
    }
}
__device__ __forceinline__ void cvt_pack8(const f32x4 (&v)[16], int half, LAS unsigned* scr, int lane) {
    const int lr = lane >> 4, lc = 4 * (lane & 15);
#pragma unroll
    for (int j = 0; j < 4; ++j)
#pragma unroll
        for (int q = 0; q < 4; ++q) scr[(lc + q) * 33 + 16 * half + 4 * j + lr] = pk4_fp8(v[4 * j][q] * W8_SCALE, v[4 * j + 1][q] * W8_SCALE, v[4 * j + 2][q] * W8_SCALE, v[4 * j + 3][q] * W8_SCALE);
}
__device__ __forceinline__ void cvt_store8(const CvtItem& c, unsigned char* ws, LAS unsigned* scr, int lane) {
    LDS_WAIT(); asm volatile("" ::: "memory");
    const int cq = lane & 7;
#pragma unroll
    for (int s = 0; s < 8; ++s) { const int nl = 8 * s + (lane >> 3); const LAS unsigned* q = scr + nl * 33 + 4 * cq;
        v4u o; o.x = q[0]; o.y = q[1]; o.z = q[2]; o.w = q[3];
        *(GAS v4u*)(cvt_row(c, ws, c.n0 + nl) + c.k0 + 16 * cq) = o; }
    LDS_WAIT(); asm volatile("" ::: "memory");
}
__device__ __forceinline__ void cvt_finish16(const CvtItem& c, const f32x4 (&v)[16], unsigned char* ws, LAS float* scr, int lane) {
    const int lr = lane >> 4, lc = 4 * (lane & 15);
#pragma unroll
    for (int i = 0; i < 16; ++i) { LAS float* p = scr + (16 * (i >> 2) + 4 * lr + (i & 3)) * 65 + lc; p[0] = v[i][0]; p[1] = v[i][1]; p[2] = v[i][2]; p[3] = v[i][3]; }
    LDS_WAIT(); asm volatile("" ::: "memory");
    const int cq = lane & 7;
#pragma unroll
    for (int s = 0; s < 8; ++s) { const int nl = 8 * s + (lane >> 3); const LAS float* q = scr + (8 * cq) * 65 + nl;
        v4u o; o.x = pkbf(q[0], q[65]); o.y = pkbf(q[2 * 65], q[3 * 65]); o.z = pkbf(q[4 * 65], q[5 * 65]); o.w = pkbf(q[6 * 65], q[7 * 65]);
        *(GAS v4u*)(cvt_row(c, ws, c.n0 + nl) + (size_t)(c.k0 + 8 * cq) * 2) = o; }
    LDS_WAIT(); asm volatile("" ::: "memory");
}
__device__ __forceinline__ void p0_prologue(Frame& F, const Args& args) {
    unsigned char* const wsl = opaque_ptr(F.ws);
    unsigned char* ws = wsl;
    const int gtid = blockIdx.x * 512 + (F.wave * 64 + lane_id());
    if (gtid < 65536) { const int l = gtid >> 15, e = (gtid >> 10) & 31, k = gtid & 1023; const float wv = args.in[IN_WROUTER][((size_t)l * 1024 + k) * 32 + e];
        const unsigned hb = pkbf(wv, 0.f) & 0xffffu; const float hf_ = __builtin_bit_cast(float, hb << 16); const unsigned lb = pkbf(wv - hf_, 0.f) & 0xffffu;
        ((bf16*)(ws + WS_WRT))[gtid] = (bf16)hb; ((bf16*)(ws + WS_WRT + 131072))[gtid] = (bf16)lb; }
    if (blockIdx.x < 192) {
        const int is = blockIdx.x / 48, n0 = (blockIdx.x % 48) * 64;
        LAS float* sil = (LAS float*)F.lds;
        LAS float* red = (LAS float*)(F.lds + 32768);
        const int w = F.wave, lane = lane_id();
#pragma unroll
        for (int b = 0; b < 8; ++b)
#pragma unroll
            for (int q = 0; q < 2; ++q) { const int kk = lane * 2 + q; const float cv = args.in[IN_C][b * 1024 + 128 * w + kk]; sil[(w * 8 + b) * 128 + kk] = cv / (1.f + expf(-cv)); }
        LDS_WAIT(); asm volatile("" ::: "memory");
        const float* wm = args.in[IN_WMOD] + (size_t)is * 1024 * 3072 + (size_t)(128 * w) * 3072 + n0 + lane;
        float acc[8] = {0.f, 0.f, 0.f, 0.f, 0.f, 0.f, 0.f, 0.f};
#pragma unroll 8
        for (int kk = 0; kk < 128; ++kk) { const float wv = wm[(size_t)kk * 3072];
#pragma unroll
            for (int b = 0; b < 8; ++b) acc[b] += sil[(w * 8 + b) * 128 + kk] * wv; }
#pragma unroll
        for (int b = 0; b < 8; ++b) red[(w * 8 + b) * 64 + lane] = acc[b];
        __syncthreads();
        { const int b = (F.wave * 64 + lane_id()) >> 6, col = (F.wave * 64 + lane_id()) & 63; float s = 0.f;
#pragma unroll
          for (int ww = 0; ww < 8; ++ww) s += red[(ww * 8 + b) * 64 + col];
          ((float*)(ws + WS_MOD))[(size_t)(is * 8 + b) * 3072 + n0 + col] = s + args.in[IN_BMOD][is * 3072 + n0 + col]; }
        __syncthreads();
    }
    LAS float* scr = (LAS float*)(F.lds + F.wave * 16640);
    const int gw = blockIdx.x * NWAVES + F.wave, NGW = F.G * NWAVES, lane = lane_id();
    {
        f32x4 va[16], vb[16];
        int it = gw; if (it >= NITEMS) return;
        CvtItem ca = cvt_decode(args, it); int ha = 0;
        cvt_load(ca, ha, va, lane);
        for (;;) {
            CvtItem cb = ca; int hb = ha + 1; bool haveb = true;
            if (!(ca.kind < 3 && ha == 0)) { it += NGW; hb = 0; haveb = it < NITEMS; if (haveb) cb = cvt_decode(args, it); }
            if (haveb) cvt_load(cb, hb, vb, lane);
            if (ca.kind < 3) { cvt_pack8(va, ha, (LAS unsigned*)scr, lane); if (ha == 1) cvt_store8(ca, ws, (LAS unsigned*)scr, lane); } else cvt_finish16(ca, va, ws, scr, lane);
            if (!haveb) break;
            CvtItem cc = cb; int hc = hb + 1; bool havec = true;
            if (!(cb.kind < 3 && hb == 0)) { it += NGW; hc = 0; havec = it < NITEMS; if (havec) cc = cvt_decode(args, it); }
            if (havec) cvt_load(cc, hc, va, lane);
            if (cb.kind < 3) { cvt_pack8(vb, hb, (LAS unsigned*)scr, lane); if (hb == 1) cvt_store8(cb, ws, (LAS unsigned*)scr, lane); } else cvt_finish16(cb, vb, ws, scr, lane);
            if (!havec) break;
            ca = cc; ha = hc;
        }
    }
}

__device__ __forceinline__ void p1_prenorm0(Frame& F, const Args& args) {
    unsigned char* const wsl = opaque_ptr(F.ws);
    const int lane = lane_id(); const int gw = blockIdx.x * NWAVES + F.wave, NGW = F.G * NWAVES;
    unsigned char* H0 = wsl + WS_H0; unsigned char* H1 = wsl + WS_H1; unsigned char* H2 = wsl + WS_H2;
    for (int t0 = gw * 8; t0 < T; t0 += NGW * 8) {
        const int b = t0 >> 11;
        const float* m0 = (const float*)(wsl + WS_MOD) + (size_t)(0 * 8 + b) * 3072;
        f32x4 gs[4], sh[4];
#pragma unroll
        for (int j = 0; j < 4; ++j) { const int c = 16 * lane + 4 * j; const f32x4 g = *(const f32x4*)(args.in[IN_GPREMIX] + c), sc = *(const f32x4*)(m0 + 1024 + c); gs[j] = g * (sc + 1.0f); sh[j] = *(const f32x4*)(m0 + c); }
        for (int i0 = 0; i0 < 8; i0 += 4) {
            f32x4 v[4][4];
#pragma unroll
            for (int u = 0; u < 4; ++u)
#pragma unroll
                for (int j = 0; j < 4; ++j) v[u][j] = *(const GAS f32x4*)(args.in[IN_X] + (size_t)(t0 + i0 + u) * D + 16 * lane + 4 * j);
#pragma unroll
            for (int u = 0; u < 4; ++u) { const int t = t0 + i0 + u; float ss = 0.f;
#pragma unroll
                for (int j = 0; j < 4; ++j) ss += dot4(v[u][j], v[u][j]);
                const float rstd = rsqrtf(wave_sum(ss) * (1.f / D) + NORM_EPS);
                v4u w;
#pragma unroll
                for (int j = 0; j < 4; ++j) { const f32x4 h = v[u][j] * rstd * gs[j] + sh[j]; w[j] = pk4_fp8(h[0], h[1], h[2], h[3]); }
                *(GAS v4u*)(H0 + (size_t)t * 1024 + 16 * lane) = w; *(GAS v4u*)(H1 + (size_t)perm_row(t, 2) * 1024 + 16 * lane) = w; *(GAS v4u*)(H2 + (size_t)perm_row(t, 4) * 1024 + 16 * lane) = w; }
        }
    }
}

__device__ __forceinline__ int rfl(int v) { return __builtin_amdgcn_readfirstlane(v); }
__device__ __forceinline__ const char* uptr(const char* p) { const unsigned long long v = (unsigned long long)p; const unsigned lo = __builtin_amdgcn_readfirstlane((unsigned)v), hi = __builtin_amdgcn_readfirstlane((unsigned)(v >> 32)); return (const char*)(((unsigned long long)hi << 32) | lo); }
__device__ __forceinline__ void store_rows128(unsigned char* seg0  , size_t pitch, int fr, int off0  , int off1  , v4u p0, v4u p1) {
    const bool odd = fr & 1; const v4u snd = odd ? p0 : p1; v4u rcv;
#pragma unroll
    for (int e = 0; e < 4; ++e) rcv[e] = (unsigned)__builtin_amdgcn_update_dpp(0, (int)snd[e], 0xB1  , 0xF, 0xF, false);
    const v4u a = odd ? rcv : p0, b = odd ? p1 : rcv;
    const int off = odd ? off1 : off0;
    *(GAS v4u*)(seg0 + (size_t)(odd ? fr - 1 : fr) * pitch + off) = a; *(GAS v4u*)(seg0 + (size_t)(odd ? fr : fr + 1) * pitch + off) = b;
}
typedef pg8::f32x4 (&AccRef)[2][2][4][2];
struct SchedPlain {
    pg8::GridOrder go; const char* A; const char* B;
    __device__ __forceinline__ bool next(int i, pg8::Unit& u) const { int pm, pn; if (!go.tile(i, pm, pn)) return false; pm = rfl(pm); pn = rfl(pn); u.a = uptr(A + (size_t)pm * TSTEP); u.b = uptr(B + (size_t)pn * TSTEP); u.pm = pm; u.pn = pn; u.aux = 0; return true; }
};
struct EpiPlain {
    static constexpr bool PERM = true;
    bf16* O; size_t ldc;
    __device__ __forceinline__ void operator()(const pg8::f32x4 (&acc)[2][2][4][2], const pg8::Unit& u, int wr, int wc, int fr_in, int fq_in) const {
        const int ln_ = lane_id(), fr = ln_ & 15, fq = ln_ >> 4; (void)fr_in; (void)fq_in;
#pragma unroll
        for (int ai = 0; ai < 2; ++ai)
#pragma unroll
            for (int m = 0; m < 4; ++m) store_rows128((unsigned char*)(O + (size_t)(u.pm * 256 + ai * 128 + wr * 64 + m * 16) * ldc + u.pn * 256 + wc * 64), ldc * 2, fr, 16 * fq, 64 + 16 * fq,
                                                      pack8(acc[ai][0][m][0], acc[ai][0][m][1]), pack8(acc[ai][1][m][0], acc[ai][1][m][1]));
    }
};
struct SchedInaQK {
    pg8::GridOrder go; const char* h0; const char* w;
    __device__ __forceinline__ bool next(int i, pg8::Unit& u) const { int pm, pv; if (!go.tile(i, pm, pv)) return false; pm = rfl(pm); pv = rfl(pv); const int g = pv >> 3, pn = pv & 7;
        const char* hg = h0 + (size_t)g * (WS_H1 - WS_H0); u.a = uptr(hg + (size_t)pm * TSTEP8); u.b = uptr(w + (size_t)(g * 2048 + pn * 256) * 1024); u.pm = pm; u.pn = pn; u.aux = g; return true; }
};
struct EpiRopeA {
    static constexpr bool PERM = true;
    bf16* QA; bf16* KA;
    __device__ __forceinline__ void operator()(const pg8::f32x4 (&acc)[2][2][4][2], const pg8::Unit& u, int wr, int wc, int fr_in, int fq_in) const {
        const int ln_ = lane_id(), fr = ln_ & 15, fq = ln_ >> 4; (void)fr_in; (void)fq_in;
        const int g = u.aux, j = u.pn >> 2, head = (u.pn & 3) * 4 + wc, sh = g == 0 ? 0 : (g == 1 ? 2 : 4);
        bf16* dst = (j == 0 ? QA : KA);
        const float sc = j == 0 ? C2F : 1.0f;
        float invr[2][4];
#pragma unroll
        for (int n = 0; n < 2; ++n)
#pragma unroll
            for (int i = 0; i < 4; ++i) invr[n][i] = __builtin_amdgcn_exp2f((float)(8 * fq + 4 * n + i) * (-13.287712379549449f / 32.0f)) * 0.15915494309189535f;
#pragma unroll
        for (int ai = 0; ai < 2; ++ai)
#pragma unroll
            for (int m = 0; m < 4; ++m) { const int p = u.pm * 256 + ai * 128 + wr * 64 + m * 16 + fr; const float pos = (float)(unperm_row(p, sh) & 2047);
                pg8::f32x4 o1[2], o2[2];
#pragma unroll
                for (int n = 0; n < 2; ++n) { pg8::f32x4 c, sn;
#pragma unroll
                    for (int i = 0; i < 4; ++i) { const float rv = __builtin_amdgcn_fractf(pos * invr[n][i]); c[i] = __builtin_amdgcn_cosf(rv); sn[i] = __builtin_amdgcn_sinf(rv); }
                    const pg8::f32x4 x1 = acc[ai][0][m][n], x2 = acc[ai][1][m][n];
                    o1[n] = (x1 * c - x2 * sn) * sc; o2[n] = (x2 * c + x1 * sn) * sc; }
                const int r = p & 31, slot = j == 0 ? r : swap23(r);
                bf16* cp2 = dst + qk_chunk(g, head, p >> 5) + (size_t)(((fq >> 1) * 2 + (fq & 1)) * 32 + slot) * 8;
                *(GAS v4u*)cp2 = pack8(o1[0], o1[1]); *(GAS v4u*)(cp2 + 2 * 2 * 32 * 8) = pack8(o2[0], o2[1]); }
    }
};
struct SchedInaV {
    pg8::GridOrder go; const char* h0; const char* w;
    __device__ __forceinline__ bool next(int i, pg8::Unit& u) const { int pv, pn; if (!go.tile(i, pv, pn)) return false; pv = rfl(pv); pn = rfl(pn); const int g = pv >> 2, pmf = pv & 3;
        const char* hg = h0 + (size_t)g * (WS_H1 - WS_H0); u.a = uptr(w + (size_t)(g * 1024 + pmf * 256) * 1024); u.b = uptr(hg + (size_t)pn * TSTEP8); u.pm = pmf; u.pn = pn; u.aux = g; return true; }
};
struct EpiVt {
    static constexpr bool PERM = true;
    bf16* VT;
    __device__ __forceinline__ void operator()(const pg8::f32x4 (&acc)[2][2][4][2], const pg8::Unit& u, int wr, int wc, int fr_in, int fq_in) const {
        const int ln_ = lane_id(), fr = ln_ & 15, fq = ln_ >> 4; (void)fr_in; (void)fq_in;
#pragma unroll
        for (int ai = 0; ai < 2; ++ai)
#pragma unroll
            for (int m = 0; m < 4; ++m) { const int f = u.pm * 256 + ai * 128 + wr * 64 + m * 16 + fr, h = f >> 6, db = (f >> 5) & 1, dd = f & 31;
                bf16* cp2 = VT + (size_t)((((fq >> 1) * 2 + db) * 2 + (fq & 1)) * 32 + dd) * 8;
#pragma unroll
                for (int bj = 0; bj < 2; ++bj) *(GAS v4u*)(cp2 + qk_chunk(u.aux, h, u.pn * 8 + bj * 4 + wc)) = pack8(acc[ai][bj][m][0], acc[ai][bj][m][1]); }
    }
};
struct EpiInB {
    static constexpr bool PERM = true;
    bf16* QB; bf16* KB; bf16* VB; const float* gq; const float* gk;
    __device__ __forceinline__ void operator()(const pg8::f32x4 (&acc)[2][2][4][2], const pg8::Unit& u, int wr, int wc, int fr_in, int fq_in) const {
        const int ln_ = lane_id(), fr = ln_ & 15, fq = ln_ >> 4; (void)fr_in; (void)fq_in;
        const int pn = u.pn, A = fq >> 1, f8 = 8 * (fq & 1), off0 = 64 * A + 2 * f8;
        const bool isq = pn < 4, isv = pn == 5; const float* gv = isq ? gq : gk; const float sc = isq ? C2F : 1.0f;
        bf16* dst = QB + (pn * 4 + wc) * 64; const size_t pitch = 1024;
        pg8::f32x4 gg[2][2];
#pragma unroll
        for (int bj = 0; bj < 2; ++bj)
#pragma unroll
            for (int n = 0; n < 2; ++n) gg[bj][n] = isv ? (pg8::f32x4){1.f, 1.f, 1.f, 1.f} : *(const pg8::f32x4*)(gv + 32 * A + 16 * bj + f8 + 4 * n);
        float invr[2][4];
#pragma unroll
        for (int n = 0; n < 2; ++n)
#pragma unroll
            for (int i = 0; i < 4; ++i) invr[n][i] = __builtin_amdgcn_exp2f((float)(f8 + 4 * n + i) * (-13.287712379549449f / 16.0f)) * 0.15915494309189535f;
#pragma unroll
        for (int ai = 0; ai < 2; ++ai)
#pragma unroll
            for (int m = 0; m < 4; ++m) { const int t0 = u.pm * 256 + ai * 128 + wr * 64 + m * 16, s = (t0 + fr) & 2047;
                float ss = 0.f;
#pragma unroll
                for (int bj = 0; bj < 2; ++bj)
#pragma unroll
                    for (int n = 0; n < 2; ++n) { const pg8::f32x4 x = acc[ai][bj][m][n]; ss += (x[0] * x[0] + x[1] * x[1]) + (x[2] * x[2] + x[3] * x[3]); }
                ss += __shfl_xor(ss, 16); ss += __shfl_xor(ss, 32);
                const float rstd = isv ? 1.0f : rsqrtf(ss * (1.f / 64.f) + NORM_EPS) * sc;
                const float pos = (float)(A == 0 ? (s >> 6) : (s & 63));
                pg8::f32x4 o1[2], o2[2];
#pragma unroll
                for (int n = 0; n < 2; ++n) { const pg8::f32x4 x1 = acc[ai][0][m][n] * rstd * gg[0][n], x2 = acc[ai][1][m][n] * rstd * gg[1][n];
                    if (isv) { o1[n] = x1; o2[n] = x2; }
                    else { pg8::f32x4 c, sn;
#pragma unroll
                        for (int i = 0; i < 4; ++i) { const float rv = __builtin_amdgcn_fractf(pos * invr[n][i]); c[i] = __builtin_amdgcn_cosf(rv); sn[i] = __builtin_amdgcn_sinf(rv); }
                        o1[n] = x1 * c - x2 * sn; o2[n] = x2 * c + x1 * sn; } }
                if (isq) store_rows128((unsigned char*)(dst + (size_t)t0 * pitch), pitch * 2, fr, off0, off0 + 32, pack8(o1[0], o1[1]), pack8(o2[0], o2[1]));
                else {
                    const int t = t0 + fr, bq = t >> 11, r64 = t & 63; bf16* blk = KB + (isv ? (size_t)((WS_VB - WS_KB) / 2) : (size_t)0) + ((size_t)(bq * 4 + wc) * 32 + ((t & 2047) >> 6)) * 4096;
                    if (!isv) { bf16* kp = blk + (4 * A + (fq & 1)) * 512 + r64 * 8;
                        *(GAS v4u*)kp = pack8(o1[0], o1[1]); *(GAS v4u*)(kp + 2 * 512) = pack8(o2[0], o2[1]); }
                    else { bf16* vp = blk + (A * 4 + (r64 >> 4)) * 512 + (r64 & 15) * 32 + (fq & 1) * 8;
                        *(GAS v4u*)vp = pack8(o1[0], o1[1]); *(GAS v4u*)(vp + 16) = pack8(o2[0], o2[1]); }
                } }
    }
};
struct SchedMoe {
    pg8::GridOrder go; const char* A; const char* W; size_t wstride; const LAS unsigned char* texp;
    __device__ __forceinline__ bool next(int i, pg8::Unit& u) const { int pm, pn; if (!go.tile(i, pm, pn)) return false; pm = rfl(pm); pn = rfl(pn); const int e = rfl((int)texp[pm]);
        u.a = uptr(A + (size_t)pm * TSTEP8); u.b = uptr(W + (size_t)e * wstride + (size_t)pn * TSTEP8); u.pm = pm; u.pn = pn; u.aux = e; return true; }
};
struct EpiSwiglu {
    static constexpr bool PERM = true;
    unsigned char* ACT; const float* bup;
    __device__ __forceinline__ void operator()(const pg8::f32x4 (&acc)[2][2][4][2], const pg8::Unit& u, int wr, int wc, int fr_in, int fq_in) const {
        const int ln_ = lane_id(), fr = ln_ & 15, fq = ln_ >> 4; (void)fr_in; (void)fq_in;
        const int cj = u.pn * 128 + wc * 32 + 8 * fq; const float* bb = bup + (size_t)u.aux * 2048 + cj;
        pg8::f32x4 bg[2], bl[2];
#pragma unroll
        for (int n = 0; n < 2; ++n) { bg[n] = *(const pg8::f32x4*)(bb + 4 * n); bl[n] = *(const pg8::f32x4*)(bb + 1024 + 4 * n); }
#pragma unroll
        for (int ai = 0; ai < 2; ++ai)
#pragma unroll
            for (int m = 0; m < 4; ++m) { pg8::f32x4 a[2];
#pragma unroll
                for (int n = 0; n < 2; ++n) { const pg8::f32x4 gl = acc[ai][0][m][n] + bg[n], li = acc[ai][1][m][n] + bl[n];
#pragma unroll
                    for (int i = 0; i < 4; ++i) { const float gx = fminf(gl[i], 7.0f), lx = fminf(fmaxf(li[i], -7.0f), 7.0f);
                        a[n][i] = gx * __builtin_amdgcn_rcpf(1.0f + __builtin_amdgcn_exp2f(gx * (-1.702f * 1.4426950408889634f))) * (lx + 1.0f); } }
                u32x2v o8; o8.x = pk4_fp8(a[0][0], a[0][1], a[0][2], a[0][3]); o8.y = pk4_fp8(a[1][0], a[1][1], a[1][2], a[1][3]);
                *(GAS u32x2v*)(ACT + (size_t)(u.pm * 256 + ai * 128 + wr * 64 + m * 16 + fr) * 1024 + cj) = o8; }
    }
};
struct EpiDown {
    static constexpr bool PERM = true;
    bf16* OUTS; const float* bdn; const float* gsort;
    __device__ __forceinline__ void operator()(const pg8::f32x4 (&acc)[2][2][4][2], const pg8::Unit& u, int wr, int wc, int fr_in, int fq_in) const {
        const int ln_ = lane_id(), fr = ln_ & 15, fq = ln_ >> 4; (void)fr_in; (void)fq_in;
        const int c0 = u.pn * 256 + wc * 64 + 8 * fq; const float* bb = bdn + (size_t)u.aux * 1024 + c0;
        pg8::f32x4 bv[2][2];
#pragma unroll
        for (int bj = 0; bj < 2; ++bj)
#pragma unroll
            for (int n = 0; n < 2; ++n) bv[bj][n] = *(const pg8::f32x4*)(bb + 32 * bj + 4 * n);
#pragma unroll
        for (int ai = 0; ai < 2; ++ai)
#pragma unroll
            for (int m = 0; m < 4; ++m) { const int row0 = u.pm * 256 + ai * 128 + wr * 64 + m * 16; const float gt = gsort[row0 + fr];
                store_rows128((unsigned char*)(OUTS + (size_t)row0 * 1024 + u.pn * 256 + wc * 64), 2048, fr, 16 * fq, 64 + 16 * fq,
                              pack8((acc[ai][0][m][0] + bv[0][0]) * gt, (acc[ai][0][m][1] + bv[0][1]) * gt), pack8((acc[ai][1][m][0] + bv[1][0]) * gt, (acc[ai][1][m][1] + bv[1][1]) * gt)); }
    }
};

__device__ __forceinline__ unsigned p3_swz(int row, int byte) { return (unsigned)(row * 128 + ((((byte >> 4) ^ (row ^ (row >> 4))) & 7) << 4) + (byte & 15)); }
struct P3Out { f32x16 O0, O1; float lse; };
__device__ __forceinline__ P3Out p3_wave_unit(const bf16* QA, const bf16* KA, const bf16* VTA, int g, int h, int p0, int lane) {
    const int r32 = lane & 31, hi = lane >> 5;
    const int sh = g == 0 ? 0 : (g == 1 ? 2 : 4), Lsh = 11 - sh;
    const int seqbase = p0 & ~((1 << Lsh) - 1), jq = (p0 & ((1 << Lsh) - 1)) >> 5, nch = 1 << (Lsh - 5);
    const int lo8 = (hi * 32 + r32) * 8;
    const bf16* Qg = QA + qk_chunk(g, h, p0 >> 5) + lo8;
    const bf16* Kg = KA + qk_chunk(g, h, seqbase >> 5) + lo8;
    const bf16* Vg = VTA + qk_chunk(g, h, seqbase >> 5) + lo8;
    bf16x8 qf[4], kf[5][4]; int cc[5]; bool ok[5];
#pragma unroll
    for (int d0 = 0; d0 < 4; ++d0) qf[d0] = *(const GAS bf16x8*)(Qg + d0 * 512);
#pragma unroll
    for (int ci = 0; ci < 5; ++ci) { const int c = jq - 2 + ci; ok[ci] = (c >= 0) && (c < nch); cc[ci] = c < 0 ? 0 : (c >= nch ? nch - 1 : c);
        const bf16* kp = Kg + (size_t)cc[ci] * 2048;
#pragma unroll
        for (int d0 = 0; d0 < 4; ++d0) kf[ci][d0] = *(const GAS bf16x8*)(kp + d0 * 512); }
    f32x16 S[5];
#pragma unroll
    for (int ci = 0; ci < 5; ++ci) { f32x16 a = {};
#pragma unroll
        for (int d0 = 0; d0 < 4; ++d0) a = __builtin_amdgcn_mfma_f32_32x32x16_bf16(kf[ci][d0], qf[d0], a, 0, 0, 0);
        S[ci] = a; }
    bf16x8 vf[5][2][2];
#pragma unroll
    for (int ci = 0; ci < 5; ++ci)
#pragma unroll
        for (int s2 = 0; s2 < 2; ++s2) { const bf16* vp = Vg + (size_t)cc[ci] * 2048 + s2 * 1024; vf[ci][s2][0] = *(const GAS bf16x8*)vp; vf[ci][s2][1] = *(const GAS bf16x8*)(vp + 512); }
#pragma unroll
    for (int ci = 0; ci < 5; ++ci)
#pragma unroll
        for (int i = 0; i < 16; ++i) { const int kk = 16 * (i >> 3) + 8 * hi + (i & 7);
            bool keep = ok[ci]; if (ci == 0) keep = keep && (kk >= r32); if (ci == 4) keep = keep && (kk <= r32);
            S[ci][i] = keep ? S[ci][i] : -INFINITY; }
    float mx = -INFINITY;
#pragma unroll
    for (int ci = 0; ci < 5; ++ci)
#pragma unroll
        for (int i = 0; i < 16; ++i) mx = fmaxf(mx, S[ci][i]);
    mx = fmaxf(mx, __shfl_xor(mx, 32));
    float sum = 0.f;
#pragma unroll
    for (int ci = 0; ci < 5; ++ci)
#pragma unroll
        for (int i = 0; i < 16; ++i) { const float p = __builtin_amdgcn_exp2f(S[ci][i] - mx); S[ci][i] = p; sum += p; }
    sum += __shfl_xor(sum, 32);
    P3Out R; R.O0 = f32x16{}; R.O1 = f32x16{};
#pragma unroll
    for (int ci = 0; ci < 5; ++ci)
#pragma unroll
        for (int s2 = 0; s2 < 2; ++s2) { v4u pw; pw.x = pkbf(S[ci][8 * s2 + 0], S[ci][8 * s2 + 1]); pw.y = pkbf(S[ci][8 * s2 + 2], S[ci][8 * s2 + 3]); pw.z = pkbf(S[ci][8 * s2 + 4], S[ci][8 * s2 + 5]); pw.w = pkbf(S[ci][8 * s2 + 6], S[ci][8 * s2 + 7]);
            const bf16x8 pf = __builtin_bit_cast(bf16x8, pw);
            R.O0 = __builtin_amdgcn_mfma_f32_32x32x16_bf16(vf[ci][s2][0], pf, R.O0, 0, 0, 0); R.O1 = __builtin_amdgcn_mfma_f32_32x32x16_bf16(vf[ci][s2][1], pf, R.O1, 0, 0, 0); }
    const float inv = 1.0f / sum;
#pragma unroll
    for (int i = 0; i < 16; ++i) { R.O0[i] *= inv; R.O1[i] *= inv; }
    R.lse = (mx + __builtin_amdgcn_logf(sum)) * LN2F;
    return R;
}
__device__ __forceinline__ void p3_attn_a(Frame& F) {
    unsigned char* const wsl = opaque_ptr(F.ws);
    const int lane = lane_id(); const int r32 = lane & 31, hi = lane >> 5, w = F.wave;
    const bf16* QA = (const bf16*)(wsl + WS_QA); const bf16* KA = (const bf16*)(wsl + WS_KA); const bf16* VTA = (const bf16*)(wsl + WS_VTA);
    bf16* O = (bf16*)(wsl + WS_O);
    LAS unsigned char* OL = F.lds;
    LAS float* LL = (LAS float*)(F.lds + 131072);
    for (int bu = blockIdx.x; bu < 512; bu += F.G) {
        const int b = bu >> 6, h = (bu >> 2) & 15, ch = bu & 3, tok0 = b * 2048 + 512 * ch;
#pragma unroll 1
        for (int k = 0; k < 4; ++k) { const int g = 2 - (k >> 1), wu = w + 8 * (k & 1), sh = g == 1 ? 2 : 4;
            const int p0 = b * 2048 + (wu & ((1 << sh) - 1)) * (2048 >> sh) + ((512 * ch) >> sh) + 32 * (wu >> sh);
            const P3Out R = p3_wave_unit(QA, KA, VTA, g, h, p0, lane);
            const int x = unperm_row(p0 + r32, sh) - tok0;
            LAS unsigned char* og = OL + (g - 1) * 65536;
#pragma unroll
            for (int i4 = 0; i4 < 4; ++i4) { u32x2v w0, w1; w0.x = pkbf(R.O0[4 * i4], R.O0[4 * i4 + 1]); w0.y = pkbf(R.O0[4 * i4 + 2], R.O0[4 * i4 + 3]); w1.x = pkbf(R.O1[4 * i4], R.O1[4 * i4 + 1]); w1.y = pkbf(R.O1[4 * i4 + 2], R.O1[4 * i4 + 3]);
                *(LAS u32x2v*)(og + p3_swz(x, 16 * i4 + 8 * hi)) = w0; *(LAS u32x2v*)(og + p3_swz(x, 64 + 16 * i4 + 8 * hi)) = w1; }
            if (hi == 0) LL[(g - 1) * 512 + x] = R.lse;
        }
        __syncthreads();
#pragma unroll 1
        for (int k = 0; k < 2; ++k) { const int wu = w + 8 * k, p0 = tok0 + 32 * wu, x = 32 * wu + r32;
            const P3Out R = p3_wave_unit(QA, KA, VTA, 0, h, p0, lane);
            const float l0 = R.lse, l1 = LL[x], l2 = LL[512 + x], m = fmaxf(l0, fmaxf(l1, l2));
            float w0f = __expf(l0 - m), w1f = __expf(l1 - m), w2f = __expf(l2 - m); const float iw = 1.0f / (w0f + w1f + w2f); w0f *= iw; w1f *= iw; w2f *= iw;
#pragma unroll
            for (int i4 = 0; i4 < 4; ++i4)
#pragma unroll
                for (int db = 0; db < 2; ++db) { const unsigned off = p3_swz(x, 64 * db + 16 * i4 + 8 * hi);
                    const u32x2v a1 = *(const LAS u32x2v*)(OL + off), a2 = *(const LAS u32x2v*)(OL + 65536 + off);
                    const f32x16& Og = db == 0 ? R.O0 : R.O1; u32x2v o;
                    o.x = pkbf(Og[4 * i4] * w0f + bflo(a1.x) * w1f + bflo(a2.x) * w2f, Og[4 * i4 + 1] * w0f + bfhi(a1.x) * w1f + bfhi(a2.x) * w2f);
                    o.y = pkbf(Og[4 * i4 + 2] * w0f + bflo(a1.y) * w1f + bflo(a2.y) * w2f, Og[4 * i4 + 3] * w0f + bfhi(a1.y) * w1f + bfhi(a2.y) * w2f);
                    *(LAS u32x2v*)(OL + off) = o; }
            LDS_WAIT(); asm volatile("" ::: "memory");
#pragma unroll
            for (int s4 = 0; s4 < 4; ++s4) { const int q = 8 * s4 + (lane >> 3), xr = 32 * wu + q; const v4u o = *(const LAS v4u*)(OL + p3_swz(xr, 16 * (lane & 7)));
                *(GAS v4u*)(O + (size_t)(tok0 + xr) * 1024 + h * 64 + 8 * (lane & 7)) = o; }
        }
        __syncthreads();
    }
}
__device__ __forceinline__ void p6a(Frame& F, const Args& args, int layer, const float* xin) {
    unsigned char* const wsl = opaque_ptr(F.ws);
    const int lane = lane_id(); const int w = F.wave;
    const int tokb = blockIdx.x * 64, b = tokb >> 11;
    const float* MOD = (const float*)(wsl + WS_MOD);
    const float* m0 = MOD + (size_t)((layer * 2 + 0) * 8 + b) * 3072; const float* m1 = MOD + (size_t)((layer * 2 + 1) * 8 + b) * 3072;
    const bf16* Y = (const bf16*)(wsl + WS_Y); bf16* XA = (bf16*)(wsl + WS_XA); unsigned char* H2N8 = wsl + WS_H1;
    const bf16* WH = (const bf16*)(wsl + WS_WRT) + (size_t)layer * 32 * 1024; const bf16* WL = WH + 65536;
    const float* br = args.in[IN_BROUTER] + layer * 32;
    LAS int* SEL = (LAS int*)(F.lds + T_SEL); LAS float* GTE = (LAS float*)(F.lds + T_GTE); LAS int* RNK = (LAS int*)(F.lds + T_RNK); LAS float* LG = (LAS float*)(F.lds + T_LG);
    for (int rnd = 0; rnd < 2; ++rnd) {
        SEC_BEGIN(1);
#pragma unroll
        for (int tt = 0; tt < 4; ++tt) { const int row = w * 4 + tt, rl = rnd * 32 + row, t = tokb + rl;
            f32x4 y[4], x[4]; float ss = 0.f;
#pragma unroll
            for (int j = 0; j < 4; ++j) { const u32x2v yy = *(const GAS u32x2v*)(Y + (size_t)t * D + 4 * lane + 256 * j); y[j] = (f32x4){bflo(yy.x), bfhi(yy.x), bflo(yy.y), bfhi(yy.y)};
                if (layer == 0) x[j] = *(const GAS f32x4*)(xin + (size_t)t * D + 4 * lane + 256 * j);
                else { const u32x2v xx = *(const GAS u32x2v*)((const bf16*)xin + (size_t)t * D + 4 * lane + 256 * j); x[j] = (f32x4){bflo(xx.x), bfhi(xx.x), bflo(xx.y), bfhi(xx.y)}; }
                ss += dot4(y[j], y[j]); }
            const float rstd1 = rsqrtf(wave_sum(ss) * (1.f / D) + NORM_EPS);
            float ss2 = 0.f;
#pragma unroll
            for (int j = 0; j < 4; ++j) { const int c = 4 * lane + 256 * j; const f32x4 A1 = *(const f32x4*)(m0 + 2048 + c) * *(const f32x4*)(args.in[IN_GPOSTMIX] + layer * 1024 + c);
                x[j] = x[j] + A1 * (y[j] * rstd1); { u32x2v px; px.x = pkbf(x[j][0], x[j][1]); px.y = pkbf(x[j][2], x[j][3]); *(GAS u32x2v*)(XA + (size_t)t * D + c) = px; } ss2 += dot4(x[j], x[j]); }
            const float rstd2 = rsqrtf(wave_sum(ss2) * (1.f / D) + NORM_EPS);
#pragma unroll
            for (int j = 0; j < 4; ++j) { const int c = 4 * lane + 256 * j; const f32x4 A2 = *(const f32x4*)(args.in[IN_GPREFFN] + layer * 1024 + c) * (*(const f32x4*)(m1 + 1024 + c) + 1.0f), S2 = *(const f32x4*)(m1 + c);
                const f32x4 hh = x[j] * rstd2 * A2 + S2; u32x2v ph, pl; ph.x = pkbf(hh[0], hh[1]); ph.y = pkbf(hh[2], hh[3]);
                pl.x = pkbf(hh[0] - bflo(ph.x), hh[1] - bfhi(ph.x)); pl.y = pkbf(hh[2] - bflo(ph.y), hh[3] - bfhi(ph.y));
                *(GAS unsigned*)(H2N8 + (size_t)t * D + c) = pk4_fp8(hh[0], hh[1], hh[2], hh[3]);
                *(LAS u32x2v*)(F.lds + row * RT_PITCH + c * 2) = ph; *(LAS u32x2v*)(F.lds + RT_LO + row * RT_PITCH + c * 2) = pl; }
        }
        __syncthreads();
        SEC_END(1); SEC_BEGIN(2);
        {
            const int th = w & 1, eh = (w >> 1) & 1, kh = w >> 2, l16 = lane & 15, kg = lane >> 4;
            const LAS unsigned char* ah = F.lds + (16 * th + l16) * RT_PITCH + kg * 16 + kh * 1024; const LAS unsigned char* al = ah + RT_LO;
            const bf16* bh = WH + (size_t)(16 * eh + l16) * 1024 + kg * 8 + kh * 512; const bf16* bl = WL + (size_t)(16 * eh + l16) * 1024 + kg * 8 + kh * 512;
            bf16x8 b_h[16], b_l[16];
#pragma unroll
            for (int ks = 0; ks < 16; ++ks) { b_h[ks] = *(const GAS bf16x8*)(bh + ks * 32); b_l[ks] = *(const GAS bf16x8*)(bl + ks * 32); }
            f32x4 acc = {0.f, 0.f, 0.f, 0.f};
#pragma unroll
            for (int ks = 0; ks < 16; ++ks) { const bf16x8 a_h = *(const LAS bf16x8*)(ah + ks * 64), a_l = *(const LAS bf16x8*)(al + ks * 64);
                acc = __builtin_amdgcn_mfma_f32_16x16x32_bf16(a_l, b_h[ks], acc, 0, 0, 0); acc = __builtin_amdgcn_mfma_f32_16x16x32_bf16(a_h, b_l[ks], acc, 0, 0, 0); acc = __builtin_amdgcn_mfma_f32_16x16x32_bf16(a_h, b_h[ks], acc, 0, 0, 0); }
            LAS float* lgp = kh == 0 ? LG : (LAS float*)(F.lds + T_LG2);
#pragma unroll
            for (int i = 0; i < 4; ++i) lgp[(16 * th + 4 * kg + i) * 32 + 16 * eh + l16] = acc[i];
        }
        __syncthreads();
        SEC_END(2); SEC_BEGIN(3);
        { const int l16 = lane & 15, row = w * 4 + (lane >> 4);
            const LAS float* LG2 = (const LAS float*)(F.lds + T_LG2);
            float v0 = (LG[row * 32 + l16] + LG2[row * 32 + l16]) + br[l16], v1 = (LG[row * 32 + 16 + l16] + LG2[row * 32 + 16 + l16]) + br[16 + l16]; const int i0 = l16, i1 = l16 + 16;
            float selv[4]; int seli[4];
#pragma unroll
            for (int kk = 0; kk < 4; ++kk) { float bv = v0; int bi = i0; if (v1 > bv) { bv = v1; bi = i1; }
#pragma unroll
                for (int off = 8; off > 0; off >>= 1) { const float ov = __shfl_xor(bv, off); const int oi = __shfl_xor(bi, off); if (ov > bv || (ov == bv && oi < bi)) { bv = ov; bi = oi; } }
                selv[kk] = bv; seli[kk] = bi; if (bi == i0) v0 = -INFINITY; if (bi == i1) v1 = -INFINITY; }
            const float p1 = __expf(selv[1] - selv[0]), p2 = __expf(selv[2] - selv[0]), p3 = __expf(selv[3] - selv[0]), ip = 1.0f / (1.0f + p1 + p2 + p3);
            if (l16 == 0) { const int rl = rnd * 32 + row;
                SEL[rl * 4 + 0] = seli[0]; SEL[rl * 4 + 1] = seli[1]; SEL[rl * 4 + 2] = seli[2]; SEL[rl * 4 + 3] = seli[3];
                GTE[rl * 4 + 0] = ip; GTE[rl * 4 + 1] = p1 * ip; GTE[rl * 4 + 2] = p2 * ip; GTE[rl * 4 + 3] = p3 * ip; }
        }
        SEC_END(3);
    }
    SEC_BEGIN(4);
    __syncthreads();
    if (w == 0) {
        const int s0 = SEL[lane * 4 + 0], s1 = SEL[lane * 4 + 1], s2 = SEL[lane * 4 + 2], s3 = SEL[lane * 4 + 3];
        int r0 = 0, r1 = 0, r2 = 0, r3 = 0, cnt = 0;
        const unsigned long long below = (1ull << lane) - 1ull;
        for (int e = 0; e < 32; ++e) { const bool has = (s0 == e) | (s1 == e) | (s2 == e) | (s3 == e); const unsigned long long mk = __ballot(has); const int rk = __popcll(mk & below);
            if (s0 == e) r0 = rk; if (s1 == e) r1 = rk; if (s2 == e) r2 = rk; if (s3 == e) r3 = rk; if (lane == e) cnt = __popcll(mk); }
        RNK[lane * 4 + 0] = r0; RNK[lane * 4 + 1] = r1; RNK[lane * 4 + 2] = r2; RNK[lane * 4 + 3] = r3;
        if (lane < 32) ((int*)(wsl + WS_HIST))[blockIdx.x * 32 + lane] = cnt;
    }
    SEC_END(4);
}
__device__ __forceinline__ void moe_tile_table(Frame& F, const int* tot  ) {
    if (F.wave == 0) { const int lane = lane_id(); LAS unsigned char* TEXP = (LAS unsigned char*)(F.lds + T_TEXP);
        const int nt = lane < 32 ? ((tot[lane & 31] + 255) >> 8) : 0; int inc = nt;
#pragma unroll
        for (int o = 1; o < 32; o <<= 1) { const int v = __shfl_up(inc, o); if ((lane & 31) >= o) inc += v; }
        const int first = inc - nt;
        for (int q = 0; q < nt; ++q) TEXP[first + q] = (unsigned char)lane;
        if (lane == 31) *(LAS int*)(F.lds + T_MT) = inc; }
}
__device__ __forceinline__ void p6b(Frame& F) {
    unsigned char* const wsl = opaque_ptr(F.ws);
    const int lane = lane_id(); const int w = F.wave, tokb = blockIdx.x * 64;
    LAS int* SEL = (LAS int*)(F.lds + T_SEL); LAS float* GTE = (LAS float*)(F.lds + T_GTE); LAS int* RNK = (LAS int*)(F.lds + T_RNK);
    LAS int* TOT = (LAS int*)(F.lds + T_TOT); LAS int* BEF = (LAS int*)(F.lds + T_BEF); LAS int* MYOFF = (LAS int*)(F.lds + T_MYOFF);
    const int* HIST = (const int*)(wsl + WS_HIST);
    const int tid = F.wave * 64 + lane;
    SEC_BEGIN(5);
    {
        LAS int* PT = (LAS int*)(F.lds + 65536); LAS int* PB = PT + 512;
        const int e = tid & 31, part = tid >> 5; int c[16];
#pragma unroll
        for (int k = 0; k < 16; ++k) c[k] = HIST[(part * 16 + k) * 32 + e];
        int tot = 0, bef = 0;
#pragma unroll
        for (int k = 0; k < 16; ++k) { tot += c[k]; bef += (part * 16 + k < (int)blockIdx.x) ? c[k] : 0; }
        PT[part * 32 + e] = tot; PB[part * 32 + e] = bef;
        __syncthreads();
        if (tid < 32) { int t2 = 0, b2 = 0;
#pragma unroll
            for (int k = 0; k < 16; ++k) { t2 += PT[k * 32 + tid]; b2 += PB[k * 32 + tid]; }
            TOT[tid] = t2; BEF[tid] = b2; if (blockIdx.x == 0) ((int*)(wsl + WS_TOT))[tid] = t2; }
    }
    __syncthreads();
    if (w == 0) { const int nt = lane < 32 ? ((TOT[lane & 31] + 255) >> 8) : 0; int inc = nt;
#pragma unroll
        for (int o = 1; o < 32; o <<= 1) { const int v = __shfl_up(inc, o); if ((lane & 31) >= o) inc += v; }
        if (lane < 32) MYOFF[lane] = (inc - nt) * 256 + BEF[lane];
        LAS unsigned char* TEXP = (LAS unsigned char*)(F.lds + T_TEXP); const int first = inc - nt;
        for (int q = 0; q < nt; ++q) TEXP[first + q] = (unsigned char)lane;
        if (lane == 31) *(LAS int*)(F.lds + T_MT) = inc; }
    __syncthreads();
    unsigned char* XS = wsl + WS_XS; float* GS = (float*)(wsl + WS_GSORT); int* POSOF = (int*)(wsl + WS_POSOF);
    const unsigned char* H2N8 = wsl + WS_H1;
    SEC_END(5); SEC_BEGIN(6);
    v4u o8[8];
#pragma unroll
    for (int i = 0; i < 8; ++i) o8[i] = *((const GAS v4u*)(H2N8 + (size_t)(tokb + w * 8 + i) * 1024) + lane);
#pragma unroll
    for (int i = 0; i < 8; ++i) { const int rl = w * 8 + i;
#pragma unroll
        for (int k = 0; k < 4; ++k) { const int e = SEL[rl * 4 + k]; const int pos = MYOFF[e] + RNK[rl * 4 + k];
            *((GAS v4u*)(XS + (size_t)pos * 1024) + lane) = o8[i];
            if (lane == 0) { GS[pos] = GTE[rl * 4 + k]; POSOF[(tokb + rl) * 4 + k] = pos; } }
    }
    asm volatile("s_waitcnt vmcnt(0)" ::: "memory");
    SEC_END(6);
}
__device__ __forceinline__ void p9_post(Frame& F, const Args& args, int layer) {
    unsigned char* const wsl = opaque_ptr(F.ws);
    const int lane = lane_id(); const int gw = blockIdx.x * NWAVES + F.wave, NGW = F.G * NWAVES;
    const bool last = layer == 1;
    const float* MOD = (const float*)(wsl + WS_MOD);
    const bf16* OUTS = (const bf16*)(wsl + WS_OUTS); const int* POSOF = (const int*)(wsl + WS_POSOF); bf16* XA = (bf16*)(wsl + WS_XA); bf16* H0 = (bf16*)(wsl + WS_H0);
    for (int t0 = gw * 8; t0 < T; t0 += NGW * 8) {
        const int b = t0 >> 11;
        const float* m1 = MOD + (size_t)((layer * 2 + 1) * 8 + b) * 3072; const float* mn = MOD + (size_t)((1 * 2 + 0) * 8 + b) * 3072;
        f32x4 A3[4], A4[4], S4[4];
#pragma unroll
        for (int j = 0; j < 4; ++j) { const int c = 4 * lane + 256 * j;
            A3[j] = *(const f32x4*)(m1 + 2048 + c) * *(const f32x4*)(args.in[IN_GPOSTFFN] + layer * 1024 + c);
            A4[j] = *(const f32x4*)(args.in[IN_GPREMIX] + 1024 + c) * (*(const f32x4*)(mn + 1024 + c) + 1.0f); S4[j] = *(const f32x4*)(mn + c); }
        const int posv = POSOF[t0 * 4 + (lane & 31)];
        for (int i0 = 0; i0 < 8; i0 += 2) {
            u32x2v q[2][4][4], xr[2][4];
#pragma unroll
            for (int u = 0; u < 2; ++u) { const int t = t0 + i0 + u;
#pragma unroll
                for (int k = 0; k < 4; ++k) { const int p = __builtin_amdgcn_readlane(posv, (i0 + u) * 4 + k);
#pragma unroll
                    for (int j = 0; j < 4; ++j) q[u][k][j] = *(const GAS u32x2v*)(OUTS + (size_t)p * 1024 + 4 * lane + 256 * j); }
#pragma unroll
                for (int j = 0; j < 4; ++j) xr[u][j] = *(const GAS u32x2v*)(XA + (size_t)t * D + 4 * lane + 256 * j); }
#pragma unroll
            for (int u = 0; u < 2; ++u) { const int t = t0 + i0 + u;
                f32x4 y[4]; float ss = 0.f;
#pragma unroll
                for (int j = 0; j < 4; ++j) { const u32x2v a = q[u][0][j], bq = q[u][1][j], cq = q[u][2][j], dq = q[u][3][j];
                    y[j] = (f32x4){((bflo(a.x) + bflo(bq.x)) + bflo(cq.x)) + bflo(dq.x), ((bfhi(a.x) + bfhi(bq.x)) + bfhi(cq.x)) + bfhi(dq.x), ((bflo(a.y) + bflo(bq.y)) + bflo(cq.y)) + bflo(dq.y), ((bfhi(a.y) + bfhi(bq.y)) + bfhi(cq.y)) + bfhi(dq.y)};
                    ss += dot4(y[j], y[j]); }
                const float rstd = rsqrtf(wave_sum(ss) * (1.f / D) + NORM_EPS);
                f32x4 x[4]; float ss2 = 0.f;
#pragma unroll
                for (int j = 0; j < 4; ++j) { const u32x2v xx = xr[u][j]; x[j] = (f32x4){bflo(xx.x), bfhi(xx.x), bflo(xx.y), bfhi(xx.y)} + A3[j] * (y[j] * rstd); ss2 += dot4(x[j], x[j]); }
                if (last) {
#pragma unroll
                    for (int j = 0; j < 4; ++j) *(GAS f32x4*)(F.out + (size_t)t * D + 4 * lane + 256 * j) = x[j];
                } else {
                    const float rstd2 = rsqrtf(wave_sum(ss2) * (1.f / D) + NORM_EPS);
#pragma unroll
                    for (int j = 0; j < 4; ++j) { const int c = 4 * lane + 256 * j; { u32x2v px; px.x = pkbf(x[j][0], x[j][1]); px.y = pkbf(x[j][2], x[j][3]); *(GAS u32x2v*)(XA + (size_t)t * D + c) = px; }
                        const f32x4 hh = x[j] * rstd2 * A4[j] + S4[j]; u32x2v pw; pw.x = pkbf(hh[0], hh[1]); pw.y = pkbf(hh[2], hh[3]); *(GAS u32x2v*)(H0 + (size_t)t * D + c) = pw; }
                }
            }
        }
    }
}
constexpr int N_PHASES = 19;
#define COMMON_PHASES(layer, pb) \
    const int P_OUT = pb + 3, P_T1 = pb + 4, P_T2 = pb + 5, P_UP = pb + 6, P_DN = pb + 7, P_POST = pb + 8; \
    if (IN(P_OUT)) for (int rep_ = 0; rep_ < 1 + DUPF(P_OUT); ++rep_) { if (rep_) __syncthreads(); \
        SchedPlain S; S.go.init(64, 4, F.G, (int)blockIdx.x); S.A = (const char*)(ws + WS_O); S.B = (const char*)(ws + (layer == 0 ? WS_WOUTA : WS_WOUTB)); \
        EpiPlain E{(bf16*)(ws + WS_Y), 1024}; \
        pg8::gemm_phase<EpiPlain, SchedPlain, true, true>(F.lds, (const char*)ws, 1024, S, E, F.wave); \
    } SEAM(P_OUT); \
    if (IN(P_T1)) for (int rep_ = 0; rep_ < 1 + DUPF(P_T1); ++rep_) { if (rep_) __syncthreads(); p6a(F, args, layer, layer == 0 ? args.in[IN_X] : (const float*)(ws + WS_XA)); } SEAM(P_T1); \
    if (IN(P_T2)) for (int rep_ = 0; rep_ < 1 + DUPF(P_T2); ++rep_) { if (rep_) __syncthreads(); p6b(F); } SEAM(P_T2); \
    if (IN(P_UP)) for (int rep_ = 0; rep_ < 1 + DUPF(P_UP); ++rep_) { if (rep_) __syncthreads(); \
        SchedMoe S; S.go.init(*(LAS int*)(F.lds + T_MT), 8, F.G, (int)blockIdx.x); S.A = (const char*)(ws + WS_XS); S.W = (const char*)(ws + WS_WUP) + (size_t)layer * 32 * 2048 * 1024; S.wstride = (size_t)2048 * 1024; \
        S.texp = (const LAS unsigned char*)(F.lds + T_TEXP); \
        EpiSwiglu E{ws + WS_ACT, args.in[IN_BUP] + (size_t)layer * 32 * 2048}; \
        pg8::gemm_phase<EpiSwiglu, SchedMoe, true, true, true>(F.lds, (const char*)ws, 512, S, E, F.wave); \
    } SEAM(P_UP); \
    if (IN(P_DN)) for (int rep_ = 0; rep_ < 1 + DUPF(P_DN); ++rep_) { if (rep_) __syncthreads(); \
        SchedMoe S; S.go.init(*(LAS int*)(F.lds + T_MT), 4, F.G, (int)blockIdx.x); S.A = (const char*)(ws + WS_ACT); S.W = (const char*)(ws + WS_WDOWN) + (size_t)layer * 32 * 1024 * 1024; S.wstride = (size_t)1024 * 1024; \
        S.texp = (const LAS unsigned char*)(F.lds + T_TEXP); \
        EpiDown E{(bf16*)(ws + WS_OUTS), args.in[IN_BDOWN] + (size_t)layer * 32 * 1024, (const float*)(ws + WS_GSORT)}; \
        pg8::gemm_phase<EpiDown, SchedMoe, true, true, true>(F.lds, (const char*)ws, 512, S, E, F.wave); \
    } SEAM(P_DN); \
    if (IN(P_POST)) for (int rep_ = 0; rep_ < 1 + (DUPF(10) && layer == 1); ++rep_) { if (rep_) __syncthreads(); p9_post(F, args, layer); }
__global__ void __launch_bounds__(NWAVES * 64, 2) mega_fwd(Args args) {
    extern __shared__ __attribute__((aligned(16))) unsigned char lds[];
    Frame F;
    F.lds = (LAS unsigned char*)lds;
    F.MISC = (volatile LAS unsigned*)(F.lds + MISC_OFF);
    F.wave = __builtin_amdgcn_readfirstlane((int)threadIdx.x >> 6);
    F.G = gridDim.x; { const int bx = blockIdx.x; F.vcu = (bx % 8) * (F.G / 8) + bx / 8; }
    F.out = args.out; F.ws = args.ws; F.ctl = (gu32*)(args.ws + WS_CTL);
    for (int u = threadIdx.x; u < (LDS_BYTES - LDSCTL_OFF) / 4; u += NWAVES * 64) ((LAS unsigned*)(F.lds + LDSCTL_OFF))[u] = 0u;
    __syncthreads();
    XcdBarrier bar = xcd_barrier_post((unsigned*)(F.ctl + CW_BAR) + args.li * XCD_BAR_WORDS, F.MISC + 8);
    const int lo = args.ph_lo, hi = args.ph_hi;
#ifndef DUP_MASK
#define DUP_MASK 0u
#endif
#define DUPF(k) ((int)((DUP_MASK >> (k)) & 1u))
#ifndef PHMASK
#define PHMASK 0xFFFFFFFFu
#endif
#define IN(k) (((PHMASK >> ((k) > 10 ? (k) - 8 : (k))) & 1u) && lo <= (k) && (k) < hi)
#define SEAM(k) do { if (IN(k) && IN((k) + 1)) { xcd_barrier(bar); if (DUPF(20)) xcd_barrier(bar); } } while (0)

    if (IN(0)) for (int rep_ = 0; rep_ < 1 + DUPF(0); ++rep_) { if (rep_) __syncthreads(); p0_prologue(F, args); } SEAM(0);
    if (IN(1)) for (int rep_ = 0; rep_ < 1 + DUPF(1); ++rep_) { if (rep_) __syncthreads(); p1_prenorm0(F, args); } SEAM(1);

    { unsigned char* ws = opaque_ptr(args.ws);
        if (IN(2)) for (int rep_ = 0; rep_ < 1 + DUPF(2); ++rep_) { if (rep_) __syncthreads();
            { SchedInaQK S; S.go.init(64, 24, F.G, (int)blockIdx.x); S.h0 = (const char*)(ws + WS_H0); S.w = (const char*)(ws + WS_WINA_QK);
              EpiRopeA E{(bf16*)(ws + WS_QA), (bf16*)(ws + WS_KA)};
              pg8::gemm_phase<EpiRopeA, SchedInaQK, true, true, true>(F.lds, (const char*)ws, 512, S, E, F.wave); }
            { SchedInaV S; S.go.init(12, 64, F.G, (int)blockIdx.x); S.h0 = (const char*)(ws + WS_H0); S.w = (const char*)(ws + WS_WINA_V);
              EpiVt E{(bf16*)(ws + WS_VTA)};
              pg8::gemm_phase<EpiVt, SchedInaV, true, true, true>(F.lds, (const char*)ws, 512, S, E, F.wave); }
        } SEAM(2);
        if (IN(3)) for (int rep_ = 0; rep_ < 1 + DUPF(3); ++rep_) { if (rep_) __syncthreads(); p3_attn_a(F); } do { if (IN(3) && IN(5)) xcd_barrier(bar); } while (0);
    }
    { unsigned char* ws = opaque_ptr(args.ws); COMMON_PHASES(0, 2) }
    SEAM(10);
    { unsigned char* ws = opaque_ptr(args.ws);
        if (IN(11)) for (int rep_ = 0; rep_ < 1 + DUPF(11); ++rep_) { if (rep_) __syncthreads();
            SchedPlain S; S.go.init(64, 6, F.G, (int)blockIdx.x); S.A = (const char*)(ws + WS_H0); S.B = (const char*)(ws + WS_WINB);
            EpiInB E{(bf16*)(ws + WS_QB), (bf16*)(ws + WS_KB), (bf16*)(ws + WS_VB), args.in[IN_GQB], args.in[IN_GKB]};
            pg8::gemm_phase<EpiInB, SchedPlain, true, true>(F.lds, (const char*)ws, 1024, S, E, F.wave);
        } SEAM(11);
        if (IN(12)) for (int rep_ = 0; rep_ < 1 + DUPF(12); ++rep_) { if (rep_) __syncthreads();
            const int xcd = F.vcu >> 5, j = F.vcu & 31;
            for (int i = 0; i < 4; ++i) { const int pair = xcd * 4 + i, b = pair >> 2, kvh = pair & 3, hq = kvh * 4 + (j >> 3), qb = j & 7;
                attn_body::attn_unit<8>(b, hq, kvh, qb, (const attn_body::bf16*)(ws + WS_QB), (const attn_body::bf16*)(ws + WS_KB), (const attn_body::bf16*)(ws + WS_VB), (attn_body::bf16*)(ws + WS_O), (char*)lds, F.wave); }
        } SEAM(12);
    }
    { unsigned char* ws = opaque_ptr(args.ws); COMMON_PHASES(1, 10) }
    if (PSEC > 0) { __syncthreads(); const unsigned long long te_ = __builtin_amdgcn_s_memrealtime(); const unsigned dd_ = F.MISC[16]; while (__builtin_amdgcn_s_memrealtime() - te_ < dd_) __builtin_amdgcn_s_sleep(8); }
#undef IN
#undef SEAM
#undef COMMON_PHASES
}
static int g_grid = 0;
static bool mega_setup() {
    if (g_grid == 0) {
        int dev = 0, cus = 0;
        if (hipGetDevice(&dev) != hipSuccess || hipDeviceGetAttribute(&cus, hipDeviceAttributeMultiprocessorCount, dev) != hipSuccess) { g_grid = -1; return false; }
        if (hipFuncSetAttribute((const void*)mega_fwd, hipFuncAttributeMaxDynamicSharedMemorySize, LDS_BYTES) != hipSuccess) { fprintf(stderr, "hipFuncSetAttribute failed\n"); g_grid = -1; return false; }
        int per_cu = 0;
        if (hipOccupancyMaxActiveBlocksPerMultiprocessor(&per_cu, (const void*)mega_fwd, NWAVES * 64, LDS_BYTES) != hipSuccess || per_cu < 1) { fprintf(stderr, "occupancy query: %d\n", per_cu); }
        (void)hipGetLastError();
        if (cus != 256) { fprintf(stderr, "built for 256 CUs, found %d\n", cus); g_grid = -1; return false; }
        g_grid = 256;
    }
    return g_grid > 0;
}
static void mega_launch(void* const* d_in, float* out, unsigned char* ws, int lo, int hi, int li, hipStream_t stream) {
    Args a{};
    for (int i = 0; i < 20; ++i) a.in[i] = (const float*)d_in[i];
    a.out = out; a.ws = ws; a.ph_lo = lo; a.ph_hi = hi; a.li = li; a.pad = 0;
    hipLaunchKernelGGL(mega_fwd, dim3(g_grid), dim3(NWAVES * 64), LDS_BYTES, stream, a);
}
extern "C" void kernel_launch(void* const* d_in, const int* in_sizes, int n_in, void* d_out, int out_size, void* d_ws, size_t ws_size, hipStream_t stream) {
    if (n_in != 20 || ws_size < WS_END || out_size != T * D) { fprintf(stderr, "kernel_launch: unexpected n_in %d / ws %zu / out %d\n", n_in, ws_size, out_size); return; }
    if (!mega_setup()) return;
    unsigned char* ws = (unsigned char*)d_ws;
    (void)hipMemsetAsync(ws + WS_CTL, 0, CTL_ZERO_BYTES, stream);
    mega_launch(d_in, (float*)d_out, ws, 0, N_PHASES, 0, stream);
}
```

```cpp
#include <hip/hip_runtime.h>
#include <cstdio>
#include <cstdint>
#include <cmath>
#define GAS __attribute__((address_space(1)))
#define LAS __attribute__((address_space(3)))
typedef unsigned short bf16;
typedef unsigned v4u __attribute__((ext_vector_type(4)));
typedef float f32x4 __attribute__((ext_vector_type(4)));
typedef short bf16x8 __attribute__((ext_vector_type(8)));
typedef GAS unsigned gu32;
typedef GAS unsigned long long gu64;
#define RLX_AGENT __ATOMIC_RELAXED, __HIP_MEMORY_SCOPE_AGENT
#define LDS_WAIT() asm volatile("s_waitcnt lgkmcnt(0)" ::: "memory")
#define VM_WAIT() asm volatile("s_waitcnt vmcnt(0)" ::: "memory")
__device__ __forceinline__ unsigned long long rt() { return __builtin_amdgcn_s_memrealtime(); }
__device__ __forceinline__ unsigned f2bf(float f) { unsigned u = __builtin_bit_cast(unsigned, f); return (u + 0x7fffu + ((u >> 16) & 1u)) >> 16; }
__device__ __forceinline__ unsigned pk2(float lo, float hi) { return f2bf(lo) | (f2bf(hi) << 16); }

#define XB_TMO      128
#define XB_XCNT(j)  (256  + 64 * (j))
#define XB_XSUB(j)  (1280 + 64 * (j))
#define XB_XGEN(j)  (2304 + 64 * (j))
#define XB_TOP      3328
#define XB_TOPGEN   3392
#define XCD_BAR_WORDS 3456
#define XB_SPIN_CAP (1u << 18)

__device__ __forceinline__ unsigned xb_ld(unsigned* p)              { return __hip_atomic_load(p, __ATOMIC_RELAXED, __HIP_MEMORY_SCOPE_AGENT); }
__device__ __forceinline__ unsigned xb_add(unsigned* p, unsigned v) { return __hip_atomic_fetch_add(p, v, __ATOMIC_RELAXED, __HIP_MEMORY_SCOPE_AGENT); }
__device__ __forceinline__ unsigned xb_xcc_id() { return (unsigned)__builtin_amdgcn_s_getreg((3 << 11) | 20) & 0xFu; }
#define XB_SPIN(cond, bar) do { unsigned _sp = 0; while (cond) { __builtin_amdgcn_s_sleep(1); \
    if ((++_sp & 255u) == 0u) { if (xb_ld(&(bar)[XB_TMO])) break; if (_sp > XB_SPIN_CAP) { atomicAdd(&(bar)[XB_TMO], 1u); break; } } } } while (0)

struct XcdBarrier {
    unsigned* bar; unsigned x;
    volatile LAS unsigned* st;
};

__device__ __forceinline__ XcdBarrier xcd_barrier_post(unsigned* bar, volatile LAS unsigned* st) {
    XcdBarrier b; b.bar = bar; b.x = xb_xcc_id(); b.st = st;
    if (threadIdx.x == 0) (void)xb_add(&bar[XB_XCNT(b.x)], 1u);
    return b;
}
__device__ __forceinline__ void xcd_barrier_complete(unsigned* bar, unsigned x, unsigned& nloc, unsigned& nx) {
    const unsigned G = gridDim.x * gridDim.y * gridDim.z;
    unsigned sum, cnt, mine, sp = 0u;
    for (;;) {
        sum = 0u; cnt = 0u; mine = 0u;
#pragma unroll
        for (unsigned j = 0; j < 16; ++j) { const unsigned c = xb_ld(&bar[XB_XCNT(j)]); sum += c; cnt += (c > 0u) ? 1u : 0u; mine = (j == x) ? c : mine; }
        if (sum == G) break;
        __builtin_amdgcn_s_sleep(1);
        if ((++sp & 255u) == 0u) { if (xb_ld(&bar[XB_TMO])) break; if (sp > XB_SPIN_CAP) { atomicAdd(&bar[XB_TMO], 1u); break; } }
    }
    nloc = mine > 0u ? mine : 1u; nx = cnt > 0u ? cnt : 1u;
}

__device__ __forceinline__ void xcd_barrier(const XcdBarrier& b) {
    asm volatile("s_waitcnt vmcnt(0)" ::: "memory");
    __syncthreads();
    if (threadIdx.x == 0) {
        unsigned* bar = b.bar;
        __builtin_amdgcn_s_waitcnt(0);
        unsigned nloc = b.st[0], nx = b.st[1];
        if (nloc == 0u) { xcd_barrier_complete(bar, b.x, nloc, nx); b.st[0] = nloc; b.st[1] = nx; }
        const unsigned old = xb_add(&bar[XB_XSUB(b.x)], 1u);
        const unsigned gen = old / nloc;
        if (old + 1u == (gen + 1u) * nloc) {
            __builtin_amdgcn_fence(__ATOMIC_RELEASE, "agent");
            asm volatile("s_waitcnt vmcnt(0)" ::: "memory");
            const unsigned og = xb_add(&bar[XB_TOP], 1u);
            const unsigned tg = og / nx;
            if (og + 1u == (tg + 1u) * nx) xb_add(&bar[XB_TOPGEN], 1u);
            else XB_SPIN(xb_ld(&bar[XB_TOPGEN]) == tg, bar);
            __builtin_amdgcn_fence(__ATOMIC_ACQUIRE, "agent");
            xb_add(&bar[XB_XGEN(b.x)], 1u);
            asm volatile("s_waitcnt vmcnt(0)" ::: "memory");
        } else {
            XB_SPIN(xb_ld(&bar[XB_XGEN(b.x)]) == gen, bar);
            __builtin_amdgcn_fence(__ATOMIC_ACQUIRE, "agent");
            asm volatile("s_waitcnt vmcnt(0)" ::: "memory");
        }
    }
    __syncthreads();
}
namespace pg8 {
#define PG8_LAS __attribute__((address_space(3)))
typedef unsigned short bf16_t;
typedef short bf16x8 __attribute__((ext_vector_type(8)));
typedef float f32x4 __attribute__((ext_vector_type(4)));
typedef unsigned u32x4 __attribute__((ext_vector_type(4)));
typedef int v4i_t __attribute__((ext_vector_type(4)));
typedef int v8i_t __attribute__((ext_vector_type(8)));
constexpr int BM = 256, BK = 64, HALF = 128, HTB = HALF * BK * 2  , STAGE_BYTES = 8 * HTB, NXCD = 8, WGM = 8;

__host__ __device__ __forceinline__ int lds_byte(int r, int c) { const int st = (r >> 4) * 2 + (c >> 5), rr = r & 15, cc = c & 31, ob = rr * 64 + cc * 2; return st * 1024 + (ob ^ (((ob >> 9) & 1) << 5)); }
__host__ __device__ __forceinline__ void stage_rc(int b, int& R, int& C) { const int st = b / 1024, sb = b % 1024, swz = sb ^ (((sb >> 9) & 1) << 5); R = (st >> 1) * 16 + swz / 64; C = (st & 1) * 32 + (swz % 64) / 2; }
__host__ __device__ __forceinline__ int perm32(int rho) { const int n = rho >> 4, i = rho & 15; return 8 * (i >> 2) + 4 * n + (i & 3); }

struct Unit { const char* a; const char* b; int pm, pn, aux; };
typedef unsigned u32x2 __attribute__((ext_vector_type(2)));
__device__ __forceinline__ unsigned cvt_pk_bf16(float lo, float hi) { unsigned r; asm volatile("v_cvt_pk_bf16_f32 %0, %1, %2" : "=v"(r) : "v"(lo), "v"(hi)); return r; }
struct GridOrder {
    int nM, nN, nwg, G, c;
    __device__ __forceinline__ void init(int nM_, int nN_, int G_, int c_) { nM = nM_; nN = nN_; nwg = nM * nN; G = G_; c = c_; }
    __device__ __forceinline__ bool tile(int i, int& pm, int& pn) const {
        const int L = i * G + c; if (L >= nwg) return false;
        int wgid = L; { const int q = nwg / NXCD, r = nwg % NXCD, xcd = wgid % NXCD, off = wgid / NXCD; wgid = (xcd < r ? xcd * (q + 1) : r * (q + 1) + (xcd - r) * q) + off; }
        const int nig = WGM * nN, gid = wgid / nig, fm = gid * WGM, gsz = (nM - fm) < WGM ? (nM - fm) : WGM;
        pm = fm + ((wgid % nig) % gsz); pn = (wgid % nig) / gsz; return true;
    }
};

template <class Epi, class Sched, bool ALIGN_EPI = false, bool SP2 = false, bool F8 = false>
__device__ __forceinline__ void gemm_phase(PG8_LAS unsigned char* lds, const char* rbase  , const int K, const Sched& S, const Epi& E, const int wid_in  ) {
    int lane; asm volatile("v_mbcnt_lo_u32_b32 %0, -1, 0\n\tv_mbcnt_hi_u32_b32 %0, -1, %0" : "=v"(lane));
    const int wid = wid_in, tid = wid * 64 + lane, wr = wid >> 2, wc = wid & 3, fr = lane & 15, fq = lane >> 4;
    const int nt = K / BK;
    int sc_ab = 122 | (127 << 8); asm volatile("" : "+v"(sc_ab));
    const __amdgpu_buffer_rsrc_t rsrc = __builtin_amdgcn_make_buffer_rsrc((void*)rbase, 0, 0xffffffff, 0x00020000);
    unsigned voffA[2], voffB[2];
#pragma unroll
    for (int i = 0; i < 2; ++i) { int R, C; stage_rc(tid * 16 + i * 8192, R, C); const int Rb = Epi::PERM ? ((R & ~31) + perm32(R & 31)) : R;
        voffA[i] = (unsigned)(R * K + C) * 2u; voffB[i] = (unsigned)(Rb * K + C) * 2u; }
    const size_t kstep = (size_t)(BK * 2);
    const size_t hstep = (size_t)HALF * K * 2;
    const unsigned ldsw = (unsigned)wid * 1024u;
    const int aoff = lds_byte(wr * 64 + fr, fq * 8), boff = lds_byte(wc * 32 + fr, fq * 8);
#define PG8_SA(b, h) (((b) * 2 + (h)) * HTB)
#define PG8_SB(b, h) ((4 + (b) * 2 + (h)) * HTB)
#define PG8_STAGE(bufoff, gbase, voff) do { const unsigned _so = (unsigned)((const char*)(gbase) - rbase); _Pragma("unroll") for (int _i = 0; _i < 2; ++_i) \
        __builtin_amdgcn_raw_ptr_buffer_load_lds(rsrc, (PG8_LAS unsigned*)(lds + (bufoff) + ldsw + _i * 8192), 16, (voff)[_i], _so, 0, 0); } while (0)
#define PG8_LD8(p) __builtin_shufflevector(*(const PG8_LAS v4i_t*)(p), *(const PG8_LAS v4i_t*)((p) + 1024), 0, 1, 2, 3, 4, 5, 6, 7)
#define PG8_LDA(dst, b, h) do { if constexpr (F8) { _Pragma("unroll") for (int m = 0; m < 4; ++m) dst##8[m] = PG8_LD8(lds + PG8_SA(b, h) + aoff + m * 2048); } else { \
        _Pragma("unroll") for (int m = 0; m < 4; ++m) _Pragma("unroll") for (int k = 0; k < 2; ++k) dst[m][k] = *(const PG8_LAS bf16x8*)(lds + PG8_SA(b, h) + aoff + m * 2048 + k * 1024); } } while (0)
#define PG8_LDB(dst, b, h) do { if constexpr (F8) { _Pragma("unroll") for (int n = 0; n < 2; ++n) dst##8[n] = PG8_LD8(lds + PG8_SB(b, h) + boff + n * 2048); } else { \
        _Pragma("unroll") for (int n = 0; n < 2; ++n) _Pragma("unroll") for (int k = 0; k < 2; ++k) dst[n][k] = *(const PG8_LAS bf16x8*)(lds + PG8_SB(b, h) + boff + n * 2048 + k * 1024); } } while (0)
#define PG8_MMA(ai, bj, At, Bt) do { __builtin_amdgcn_s_setprio(1); if constexpr (F8) { _Pragma("unroll") for (int m = 0; m < 4; ++m) _Pragma("unroll") for (int n = 0; n < 2; ++n) \
        acc[ai][bj][m][n] = __builtin_amdgcn_mfma_scale_f32_16x16x128_f8f6f4(Bt##8[n], At##8[m], acc[ai][bj][m][n], 0, 0, 0, sc_ab, 1, sc_ab); } else { \
        _Pragma("unroll") for (int m = 0; m < 4; ++m) _Pragma("unroll") for (int n = 0; n < 2; ++n) _Pragma("unroll") for (int k = 0; k < 2; ++k) \
        acc[ai][bj][m][n] = __builtin_amdgcn_mfma_f32_16x16x32_bf16(Bt[n][k], At[m][k], acc[ai][bj][m][n], 0, 0, 0); } __builtin_amdgcn_s_setprio(0); } while (0)
#define PG8_WAIT_V(n) asm volatile("s_waitcnt vmcnt(" #n ")" ::: "memory")
#define PG8_WAIT_L(n) asm volatile("s_waitcnt lgkmcnt(" #n ")" ::: "memory")
#define PG8_BAR __builtin_amdgcn_s_barrier()
#define PG8_SCHED __builtin_amdgcn_sched_barrier(0)
    Unit cur, nxt; int ui = 0;
    if (!S.next(0, cur)) return;
    f32x4 acc[2][2][4][2];
#pragma unroll
    for (int a = 0; a < 2; ++a)
#pragma unroll
        for (int b = 0; b < 2; ++b)
#pragma unroll
            for (int m = 0; m < 4; ++m)
#pragma unroll
                for (int n = 0; n < 2; ++n) acc[a][b][m][n] = (f32x4){0.f, 0.f, 0.f, 0.f};
    bf16x8 At[4][2], B0[2][2], B1[2][2]; v8i_t At8[4], B08[2], B18[2];
    const char* cA = cur.a; const char* cB = cur.b;
    if constexpr (SP2) {
        PG8_STAGE(PG8_SB(0, 0), cB, voffB); PG8_STAGE(PG8_SB(0, 1), cB + hstep, voffB); PG8_STAGE(PG8_SA(0, 0), cA, voffA); PG8_STAGE(PG8_SA(0, 1), cA + hstep, voffA);
        if (wr == 1) PG8_BAR;
        PG8_WAIT_V(2); PG8_BAR;
        PG8_STAGE(PG8_SB(1, 0), cB + kstep, voffB); PG8_STAGE(PG8_SA(1, 0), cA + kstep, voffA); PG8_STAGE(PG8_SB(1, 1), cB + hstep + kstep, voffB);
        PG8_WAIT_V(6); PG8_BAR;
    } else {
        PG8_STAGE(PG8_SB(0, 0), cB, voffB); PG8_STAGE(PG8_SA(0, 0), cA, voffA); PG8_STAGE(PG8_SB(0, 1), cB + hstep, voffB); PG8_STAGE(PG8_SA(0, 1), cA + hstep, voffA);
        if (wr == 1) PG8_BAR;
        PG8_WAIT_V(4); PG8_BAR;
        PG8_STAGE(PG8_SB(1, 0), cB + kstep, voffB); PG8_STAGE(PG8_SA(1, 0), cA + kstep, voffA); PG8_STAGE(PG8_SB(1, 1), cB + hstep + kstep, voffB);
        PG8_WAIT_V(6); PG8_BAR;
    }
    for (;;) {
        const bool has_next = S.next(ui + 1, nxt);
        const char* nA = has_next ? nxt.a : cA; const char* nB = has_next ? nxt.b : cB;
#pragma nounroll
        for (int t = 0; t < nt; t += 2) {
            const bool last = (t == nt - 2);
            const char* a1 = cA + (size_t)(t + 1) * kstep;
            const char* a2 = last ? nA : cA + (size_t)(t + 2) * kstep; const char* b2 = last ? nB : cB + (size_t)(t + 2) * kstep;
            const char* a3 = a2 + kstep; const char* b3 = b2 + kstep;
            if constexpr (SP2) {
            PG8_LDB(B0, 0, 0); PG8_LDB(B1, 0, 1); PG8_SCHED; PG8_LDA(At, 0, 0); PG8_STAGE(PG8_SA(1, 1), a1 + hstep, voffA);
            PG8_WAIT_V(8); PG8_WAIT_L(0); PG8_BAR; PG8_MMA(0, 0, At, B0); PG8_MMA(0, 1, At, B1); PG8_BAR; PG8_SCHED;
            PG8_LDA(At, 0, 1); PG8_STAGE(PG8_SB(0, 0), b2, voffB); PG8_STAGE(PG8_SB(0, 1), b2 + hstep, voffB); PG8_STAGE(PG8_SA(0, 0), a2, voffA);
            PG8_WAIT_V(8); PG8_WAIT_L(0); PG8_BAR; PG8_MMA(1, 0, At, B0); PG8_MMA(1, 1, At, B1); PG8_BAR; PG8_SCHED;
            PG8_LDB(B0, 1, 0); PG8_LDB(B1, 1, 1); PG8_SCHED; PG8_LDA(At, 1, 0); PG8_STAGE(PG8_SA(0, 1), a2 + hstep, voffA);
            PG8_WAIT_V(8); PG8_WAIT_L(0); PG8_BAR; PG8_MMA(0, 0, At, B0); PG8_MMA(0, 1, At, B1); PG8_BAR; PG8_SCHED;
            PG8_LDA(At, 1, 1); PG8_STAGE(PG8_SB(1, 0), b3, voffB); PG8_STAGE(PG8_SB(1, 1), b3 + hstep, voffB); PG8_STAGE(PG8_SA(1, 0), a3, voffA);
            PG8_WAIT_V(8); PG8_WAIT_L(0); PG8_BAR; PG8_MMA(1, 0, At, B0); PG8_MMA(1, 1, At, B1); PG8_BAR; PG8_SCHED;
            } else {
            PG8_LDB(B0, 0, 0); PG8_SCHED; PG8_LDA(At, 0, 0); PG8_STAGE(PG8_SA(1, 1), a1 + hstep, voffA);
            PG8_WAIT_L(8); PG8_BAR; PG8_WAIT_L(0); PG8_MMA(0, 0, At, B0); PG8_BAR; PG8_SCHED;
            PG8_LDB(B1, 0, 1); PG8_STAGE(PG8_SB(0, 0), b2, voffB);
            PG8_BAR; PG8_WAIT_L(0); PG8_MMA(0, 1, At, B1); PG8_BAR;
            PG8_LDA(At, 0, 1); PG8_STAGE(PG8_SA(0, 0), a2, voffA);
            PG8_BAR; PG8_WAIT_L(0); PG8_MMA(1, 0, At, B0); PG8_BAR; PG8_SCHED;
            PG8_STAGE(PG8_SB(0, 1), b2 + hstep, voffB);
            PG8_WAIT_V(6); PG8_BAR; PG8_MMA(1, 1, At, B1); PG8_BAR;
            PG8_LDB(B0, 1, 0); PG8_SCHED; PG8_LDA(At, 1, 0); PG8_STAGE(PG8_SA(0, 1), a2 + hstep, voffA);
            PG8_WAIT_L(8); PG8_BAR; PG8_WAIT_L(0); PG8_MMA(0, 0, At, B0); PG8_BAR; PG8_SCHED;
            PG8_LDB(B1, 1, 1); PG8_STAGE(PG8_SB(1, 0), b3, voffB);
            PG8_BAR; PG8_WAIT_L(0); PG8_MMA(0, 1, At, B1); PG8_BAR;
            PG8_LDA(At, 1, 1); PG8_STAGE(PG8_SA(1, 0), a3, voffA);
            PG8_BAR; PG8_WAIT_L(0); PG8_MMA(1, 0, At, B0); PG8_BAR; PG8_SCHED;
            PG8_STAGE(PG8_SB(1, 1), b3 + hstep, voffB);
            PG8_WAIT_V(6); PG8_BAR; PG8_MMA(1, 1, At, B1); PG8_BAR;
            }
        }
        if constexpr (ALIGN_EPI) { if (wr == 0) PG8_BAR; }
        E(acc, cur, wr, wc, fr, fq);
        if (!has_next) break;
#pragma unroll
        for (int a = 0; a < 2; ++a)
#pragma unroll
            for (int b = 0; b < 2; ++b)
#pragma unroll
                for (int m = 0; m < 4; ++m)
#pragma unroll
                    for (int n = 0; n < 2; ++n) acc[a][b][m][n] = (f32x4){0.f, 0.f, 0.f, 0.f};
        cur = nxt; cA = nA; cB = nB; ++ui;
        if constexpr (ALIGN_EPI) { if (wr == 1) PG8_BAR; }
    }
    PG8_WAIT_V(0);
    if constexpr (!ALIGN_EPI) { if (wr == 0) PG8_BAR; }
    PG8_BAR;
#undef PG8_SA
#undef PG8_SB
#undef PG8_STAGE
#undef PG8_LDA
#undef PG8_LDB
#undef PG8_MMA
#undef PG8_LD8
#undef PG8_WAIT_V
#undef PG8_WAIT_L
#undef PG8_BAR
#undef PG8_SCHED
}
}

#include <hip/hip_bf16.h>
namespace attn_body {
using bf16=__hip_bfloat16;
using bf16x8=__attribute__((ext_vector_type(8)))short;
using s16x4=__attribute__((ext_vector_type(4)))short;
using f32x16=__attribute__((ext_vector_type(16)))float;
using u32x4=__attribute__((ext_vector_type(4)))unsigned;
constexpr int BATCH=8,NHEAD=16,SEQ=2048,D=64,QP=1024,KVP=256;
constexpr int NW=8,QBLK=32,QB=QBLK*NW,KVBLK=64,NQB=SEQ/QB;
constexpr int ATTN_UNIT_ROWS=QB;
__device__ __forceinline__ int crow(int r,int hi){return (r&3)+8*(r>>2)+4*hi;}
#define SBAR() __builtin_amdgcn_sched_barrier(0)
__device__ __forceinline__ void cmask(f32x16&p0,f32x16&p1,int jb,int qrel,int hi){
  const float NEG=-INFINITY; int kb=64*jb+4*hi;
  #pragma unroll
  for(int r=0;r<16;++r){int kv=kb+(r&3)+8*(r>>2); if(kv>qrel)p0[r]=NEG; if(kv+32>qrel)p1[r]=NEG;}
}

constexpr int NSLOT=3, SLOTB=8192;
constexpr int LDS_K=0, LDS_V=NSLOT*SLOTB, LDS_WS=2*NSLOT*SLOTB, LDS_OST=LDS_WS+NW*64*4, LDS_BYTES=LDS_OST+NW*4096;
constexpr float C2=0.125f*1.4426950408889634f;
__device__ __forceinline__ void glds16(const void*gsrc,unsigned lds_dst){unsigned keep;
  asm volatile("s_mov_b32 %0, m0\n\ts_mov_b32 m0, %2\n\ts_nop 0\n\tglobal_load_lds_dwordx4 %1, off\n\ts_mov_b32 m0, %0":"=&s"(keep):"v"(gsrc),"s"(lds_dst):"memory");}
__device__ __forceinline__ float max3f(float a,float b,float c){float r;asm("v_max3_f32 %0, %1, %2, %3":"=v"(r):"v"(a),"v"(b),"v"(c));return r;}
__device__ __forceinline__ float max2f(float a,float b){float r;asm("v_max_f32_e32 %0, %1, %2":"=v"(r):"v"(a),"v"(b));return r;}
__device__ __forceinline__ float fadd_s(float a,float b){float r;asm("v_add_f32_e32 %0, %1, %2":"=v"(r):"v"(a),"v"(b));return r;}
__device__ __forceinline__ float fsub_s(float a,float b){float r;asm("v_sub_f32_e32 %0, %1, %2":"=v"(r):"v"(a),"v"(b));return r;}
typedef float f32x2_t __attribute__((ext_vector_type(2))); typedef __bf16 bf16x2_t __attribute__((ext_vector_type(2)));
__device__ __forceinline__ unsigned cvtpk_s(float lo,float hi){f32x2_t v={lo,hi};bf16x2_t b=__builtin_convertvector(v,bf16x2_t);return __builtin_bit_cast(unsigned,b);}
#define WAIT_BAR(N) asm volatile("s_waitcnt vmcnt(" #N ") lgkmcnt(0)\n\ts_barrier":::"memory")

__device__ __forceinline__ void qkt(f32x16&p0,f32x16&p1,const char*Kslot,const bf16x8*qr,const f32x16&negm,int r32,int hi){
  const char*kb=Kslot+hi*1024+r32*16;
  #pragma unroll
  for(int d0=0;d0<4;++d0){
    const bf16x8 b0=*reinterpret_cast<const bf16x8*>(kb+d0*2048);
    const bf16x8 b1=*reinterpret_cast<const bf16x8*>(kb+d0*2048+512);
    if(d0==0){p0=__builtin_amdgcn_mfma_f32_32x32x16_bf16(b0,qr[0],negm,0,0,0);p1=__builtin_amdgcn_mfma_f32_32x32x16_bf16(b1,qr[0],negm,0,0,0);}
    else{p0=__builtin_amdgcn_mfma_f32_32x32x16_bf16(b0,qr[d0],p0,0,0,0);p1=__builtin_amdgcn_mfma_f32_32x32x16_bf16(b1,qr[d0],p1,0,0,0);}}
}
typedef __attribute__((address_space(3))) const char* lds_cptr;
typedef short v4i16_t __attribute__((ext_vector_type(4)));
__device__ __forceinline__ void kload8(bf16x8*kf,lds_cptr kp){
  kf[0]=*(const __attribute__((address_space(3))) bf16x8*)(kp);      kf[1]=*(const __attribute__((address_space(3))) bf16x8*)(kp+512);
  kf[2]=*(const __attribute__((address_space(3))) bf16x8*)(kp+2048); kf[3]=*(const __attribute__((address_space(3))) bf16x8*)(kp+2560);
  kf[4]=*(const __attribute__((address_space(3))) bf16x8*)(kp+4096); kf[5]=*(const __attribute__((address_space(3))) bf16x8*)(kp+4608);
  kf[6]=*(const __attribute__((address_space(3))) bf16x8*)(kp+6144); kf[7]=*(const __attribute__((address_space(3))) bf16x8*)(kp+6656);
}
__device__ __forceinline__ void kload2(bf16x8*kf,lds_cptr kp,int j){ kf[2*j]=*(const __attribute__((address_space(3))) bf16x8*)(kp+j*2048); kf[2*j+1]=*(const __attribute__((address_space(3))) bf16x8*)(kp+j*2048+512); }
__device__ __forceinline__ s16x4 vtr(lds_cptr p){ return __builtin_bit_cast(s16x4,__builtin_amdgcn_ds_read_tr16_b64_v4i16((__attribute__((address_space(3))) v4i16_t*)p)); }
__device__ __forceinline__ float rowmax(const f32x16&p0,const f32x16&p1){
  float a=max3f(p0[0],p0[1],p1[0]),b=max3f(p0[2],p0[3],p1[1]);a=max3f(a,p1[2],p1[3]);
  #pragma unroll
  for(int r=4;r<16;r+=4){a=max3f(a,p0[r],p0[r+1]);b=max3f(b,p0[r+2],p0[r+3]);a=max3f(a,p1[r],p1[r+1]);b=max3f(b,p1[r+2],p1[r+3]);}
  const float m=max2f(a,b);
  auto rr=__builtin_amdgcn_permlane32_swap(__float_as_uint(m),__float_as_uint(m),false,false);
  return max2f(__uint_as_float(rr[0]),__uint_as_float(rr[1]));
}
__device__ __forceinline__ void pv(f32x16*o,int vb,bf16x8 pa0,bf16x8 pa1,bf16x8 pa2,bf16x8 pa3){
  #pragma unroll
  for(int d0=0;d0<2;++d0){s16x4 lo[4],hi[4];
    #pragma unroll
    for(int ks=0;ks<4;++ks){
      asm volatile("ds_read_b64_tr_b16 %0,%1 offset:%c2":"=&v"(lo[ks]):"v"(vb),"i"(d0*4096+ks*1024):"memory");
      asm volatile("ds_read_b64_tr_b16 %0,%1 offset:%c2":"=&v"(hi[ks]):"v"(vb),"i"(d0*4096+ks*1024+512):"memory");}
    asm volatile("s_waitcnt lgkmcnt(0)":::"memory");SBAR();
    #define PK(k) (bf16x8){lo[k][0],lo[k][1],lo[k][2],lo[k][3],hi[k][0],hi[k][1],hi[k][2],hi[k][3]}
    o[d0]=__builtin_amdgcn_mfma_f32_32x32x16_bf16(pa0,PK(0),o[d0],0,0,0);
    o[d0]=__builtin_amdgcn_mfma_f32_32x32x16_bf16(pa1,PK(1),o[d0],0,0,0);
    o[d0]=__builtin_amdgcn_mfma_f32_32x32x16_bf16(pa2,PK(2),o[d0],0,0,0);
    o[d0]=__builtin_amdgcn_mfma_f32_32x32x16_bf16(pa3,PK(3),o[d0],0,0,0);
    #undef PK
  }
}

#ifndef ATTN_STORE16
#define ATTN_STORE16(p,v) (*(u32x4*)(p)=(v))
#endif
template<int THRL> __device__ __forceinline__ void attn_unit(int b,int h,int kvh,int qb,const bf16*Q,const bf16*__restrict__ K,const bf16*__restrict__ V,bf16*O,char*shm,const int wid_in){
  int lane; asm volatile("v_mbcnt_lo_u32_b32 %0, -1, 0\n\tv_mbcnt_hi_u32_b32 %0, -1, %0":"=v"(lane)); const int r32=lane&31,hi=lane>>5; const int wid=wid_in;
  const long rowbase=(long)b*SEQ; const int q0=qb*QB;
  const bf16*Qw=Q+(rowbase+q0+wid*QBLK)*QP+h*D;
  const bf16*Kh=K+((long)(b*4+kvh)*(SEQ/KVBLK))*4096,*Vh=V+((long)(b*4+kvh)*(SEQ/KVBLK))*4096;
  const unsigned lds0=(unsigned)(uintptr_t)shm;
  float*wsf=(float*)(shm+LDS_WS)+wid*64;
  const bf16*ksrc=Kh+wid*512+lane*8;
  const bf16*vsrc=Vh+wid*512+lane*8;
  const unsigned kdst=lds0+LDS_K+wid*1024, vdst=lds0+LDS_V+wid*1024;
  #define DMA_K(t,slot) glds16(ksrc+(long)(t)*4096,(unsigned)__builtin_amdgcn_readfirstlane(kdst+(slot)))
  #define DMA_V(t,slot) glds16(vsrc+(long)(t)*4096,(unsigned)__builtin_amdgcn_readfirstlane(vdst+(slot)))
  const int vb0=(int)(lds0+LDS_V)+((lane>>4)&1)*32+(lane&3)*8+(4*hi+((lane&15)>>2))*64;
  const char*Kbase=shm+LDS_K; bf16x8 kf[8];
  const lds_cptr shm3=(lds_cptr)shm; const lds_cptr kp0=shm3+LDS_K+hi*1024+r32*16; const lds_cptr vp0=shm3+LDS_V+((lane>>4)&1)*32+(lane&3)*8+(4*hi+((lane&15)>>2))*64;
  constexpr int NT=SEQ/KVBLK;
  DMA_K(0,0);DMA_V(0,0);DMA_K(1,SLOTB);
  bf16x8 qr[4];
  #pragma unroll
  for(int d0=0;d0<4;++d0)qr[d0]=*reinterpret_cast<const bf16x8*>(&Qw[(long)r32*QP+d0*16+hi*8]);
  float mhat=0.f,l_reg=0.f;f32x16 o[2];o[0]=f32x16{};o[1]=f32x16{};f32x16 negm=f32x16{};asm volatile("":"+v"(negm));
  #define CMASK(P0,P1,t) do{}while(0)
  bool resc=false;
  #define START(P0,P1) do{ const float rm=rowmax(P0,P1); resc=false; \
    { const float dl=rm; mhat=fadd_s(mhat,dl); \
      _Pragma("unroll") for(int r=0;r<16;++r){P0[r]=fsub_s(P0[r],dl);P1[r]=fsub_s(P1[r],dl);} \
      _Pragma("unroll") for(int r=0;r<16;++r)negm[r]=-mhat; asm volatile("":"+v"(negm)); } \
    _Pragma("unroll") for(int r=0;r<16;++r)P0[r]=__builtin_amdgcn_exp2f(P0[r]); }while(0)
  #define RESC() do{ if(resc){ asm volatile("s_waitcnt lgkmcnt(0)":::"memory"); \
      _Pragma("unroll") for(int d_=0;d_<2;++d_) _Pragma("unroll") for(int r=0;r<16;++r)o[d_][r]*=wsf[crow(r,hi)]; } }while(0)
  f32x16 pA0,pA1,pB0,pB1;
  int sl_prev=0,sl_cur=0,sl_next=SLOTB;
  #define ROT() do{sl_prev=sl_cur;sl_cur=sl_next;sl_next=(sl_next==(NSLOT-1)*SLOTB)?0:sl_next+SLOTB;}while(0)
  DMA_K(2,2*SLOTB);
  WAIT_BAR(3);
  qkt(pA0,pA1,Kbase,qr,negm,r32,hi);asm volatile("s_nop 15\n\ts_nop 7":"+v"(pA0),"+v"(pA1));CMASK(pA0,pA1,0);
  START(pA0,pA1);
  _Pragma("unroll") for(int r=0;r<16;++r)pA1[r]=__builtin_amdgcn_exp2f(pA1[r]);
  WAIT_BAR(0);
  DMA_K(3,0);DMA_V(1,SLOTB);
  ROT();
  kload8(kf,kp0+sl_cur);
  WAIT_BAR(2);
  s16x4 vlo[8],vhi[8]; u32x4 pw0,pw1,pw2,pw3;
  #define PKW(P,B) cvtpk_s(P[B],P[B+1])
  #define PAF(k) __builtin_bit_cast(bf16x8,pw##k)
  #define VFR(i) (bf16x8){vlo[i][0],vlo[i][1],vlo[i][2],vlo[i][3],vhi[i][0],vhi[i][1],vhi[i][2],vhi[i][3]}
  #define PIN(x) asm volatile("":"+v"(x))
  #define MX3(a,b,c) __builtin_fmaxf(__builtin_fmaxf((a),(b)),(c))
  #define GAPA(MF,A0,A1,A2,A3,W0,W1,PW) do{ MF; sacc+=A0; sacc+=A1; sacc+=A2; sacc+=A3; PIN(sacc); W0; W1; PIN(PW); SBAR(); }while(0)
  #define EX(v) __builtin_amdgcn_exp2f(v)
  #define GAPB(MF,X,B) do{ MF; X[B]=EX(X[B]); X[B+1]=EX(X[B+1]); X[B+2]=EX(X[B+2]); X[B+3]=EX(X[B+3]); PIN(X); SBAR(); }while(0)
  #define VRD(i) do{ vlo[i]=vtr(vp_+(((i)>>2)*4096+((i)&3)*1024)); vhi[i]=vtr(vp_+(((i)>>2)*4096+((i)&3)*1024+512)); }while(0)
  #define KRD(G,j) do{ if(G){ kload2(kf,kp0+sl_next,j); SBAR(); } }while(0)
  #define STEP(C0,C1,P0,P1,t,GK,GV,GL) do{ SBAR(); \
    const lds_cptr vp_=vp0+sl_prev; \
    VRD(0); SBAR(); float sacc=(P0[0]+P0[1]); \
    GAPA(C0=__builtin_amdgcn_mfma_f32_32x32x16_bf16(kf[0],qr[0],negm,0,0,0), P0[2],P0[3],P0[4],P0[5],     pw0[0]=PKW(P0,0), pw0[1]=PKW(P0,2), pw0); \
    VRD(4); SBAR(); GAPA(C1=__builtin_amdgcn_mfma_f32_32x32x16_bf16(kf[1],qr[0],negm,0,0,0), P0[6],P0[7],P0[8],P0[9],     pw0[2]=PKW(P0,4), pw0[3]=PKW(P0,6), pw0); \
    VRD(1); SBAR(); GAPA(C0=__builtin_amdgcn_mfma_f32_32x32x16_bf16(kf[2],qr[1],C0,0,0,0),   P0[10],P0[11],P0[12],P0[13], pw1[0]=PKW(P0,8), pw1[1]=PKW(P0,10), pw1); \
    VRD(5); SBAR(); GAPA(C1=__builtin_amdgcn_mfma_f32_32x32x16_bf16(kf[3],qr[1],C1,0,0,0),   P0[14],P0[15],P1[0],P1[1],   pw1[2]=PKW(P0,12),pw1[3]=PKW(P0,14), pw1); \
    VRD(2); SBAR(); GAPA(C0=__builtin_amdgcn_mfma_f32_32x32x16_bf16(kf[4],qr[2],C0,0,0,0),   P1[2],P1[3],P1[4],P1[5],     pw2[0]=PKW(P1,0), pw2[1]=PKW(P1,2), pw2); \
    VRD(6); SBAR(); GAPA(C1=__builtin_amdgcn_mfma_f32_32x32x16_bf16(kf[5],qr[2],C1,0,0,0),   P1[6],P1[7],P1[8],P1[9],     pw2[2]=PKW(P1,4), pw2[3]=PKW(P1,6), pw2); \
    VRD(3); SBAR(); GAPA(C0=__builtin_amdgcn_mfma_f32_32x32x16_bf16(kf[6],qr[3],C0,0,0,0),   P1[10],P1[11],P1[12],P1[13], pw3[0]=PKW(P1,8), pw3[1]=PKW(P1,10), pw3); \
    VRD(7); SBAR(); GAPA(C1=__builtin_amdgcn_mfma_f32_32x32x16_bf16(kf[7],qr[3],C1,0,0,0),   P1[14],P1[15],0.f,0.f,       pw3[2]=PKW(P1,12),pw3[3]=PKW(P1,14), pw3); \
    l_reg+=sacc; \
    if(GK){DMA_K((t)+3,sl_cur);} if(GV){DMA_V((t)+1,sl_next);} \
    CMASK(C0,C1,t); \
    { float a=MX3(C0[0],C0[1],C1[0]),b=MX3(C0[2],C0[3],C1[1]); a=MX3(a,C1[2],C1[3]); \
      _Pragma("unroll") for(int r=4;r<16;r+=4){a=MX3(a,C0[r],C0[r+1]);b=MX3(b,C0[r+2],C0[r+3]);a=MX3(a,C1[r],C1[r+1]);b=MX3(b,C1[r+2],C1[r+3]);} \
      float rm=__builtin_fmaxf(a,b); { auto rr=__builtin_amdgcn_permlane32_swap(__float_as_uint(rm),__float_as_uint(rm),false,false); rm=__builtin_fmaxf(__uint_as_float(rr[0]),__uint_as_float(rr[1])); } \
      resc=false; \
      if(__builtin_expect(__any(rm>(float)THRL),0)){ const float dl=__builtin_fmaxf(rm,0.f); mhat+=dl; \
        _Pragma("unroll") for(int r=0;r<16;++r){C0[r]-=dl;C1[r]-=dl;} \
        _Pragma("unroll") for(int r=0;r<16;++r)negm[r]=-mhat; asm volatile("":"+v"(negm)); \
        const float f=__builtin_amdgcn_exp2f(-dl); l_reg*=f; if(hi==0)wsf[r32]=f; resc=true; } } \
    SBAR(); \
    GAPB(o[0]=__builtin_amdgcn_mfma_f32_32x32x16_bf16(PAF(0),VFR(0),o[0],0,0,0), C0,0); \
    GAPB(o[1]=__builtin_amdgcn_mfma_f32_32x32x16_bf16(PAF(0),VFR(4),o[1],0,0,0), C0,4); \
    KRD(GL,0); GAPB(o[0]=__builtin_amdgcn_mfma_f32_32x32x16_bf16(PAF(1),VFR(1),o[0],0,0,0), C0,8); \
    KRD(GL,1); GAPB(o[1]=__builtin_amdgcn_mfma_f32_32x32x16_bf16(PAF(1),VFR(5),o[1],0,0,0), C0,12); \
    KRD(GL,2); GAPB(o[0]=__builtin_amdgcn_mfma_f32_32x32x16_bf16(PAF(2),VFR(2),o[0],0,0,0), C1,0); \
    KRD(GL,3); GAPB(o[1]=__builtin_amdgcn_mfma_f32_32x32x16_bf16(PAF(2),VFR(6),o[1],0,0,0), C1,4); \
    GAPB(o[0]=__builtin_amdgcn_mfma_f32_32x32x16_bf16(PAF(3),VFR(3),o[0],0,0,0), C1,8); \
    GAPB(o[1]=__builtin_amdgcn_mfma_f32_32x32x16_bf16(PAF(3),VFR(7),o[1],0,0,0), C1,12); \
    }while(0)
  int t=1;
  #undef CMASK
  #define CMASK(P0,P1,t) do{}while(0)
  for(;t+5<NT;t+=2){
    STEP(pB0,pB1,pA0,pA1,t,true,true,true);     WAIT_BAR(2); RESC(); ROT();
    STEP(pA0,pA1,pB0,pB1,t+1,true,true,true);   WAIT_BAR(2); RESC(); ROT();
  }
  #undef CMASK
  #define CMASK(P0,P1,t) do{}while(0)
  #define ENDW(tt) do{ if((tt)+3<NT){WAIT_BAR(2);} else if((tt)+2<NT){WAIT_BAR(1);} else {WAIT_BAR(0);} }while(0)
  for(;t+1<NT;t+=2){
    STEP(pB0,pB1,pA0,pA1,t,(t+3<NT),(t+1<NT),(t+1<NT));       ENDW(t);   RESC(); ROT();
    STEP(pA0,pA1,pB0,pB1,t+1,(t+4<NT),(t+2<NT),(t+2<NT));     ENDW(t+1); RESC(); ROT();
  }
  STEP(pB0,pB1,pA0,pA1,NT-1,false,false,false); RESC();
  { float sacc=pB0[0]+pB0[1]; _Pragma("unroll") for(int r=2;r<16;++r)sacc+=pB0[r]; _Pragma("unroll") for(int r=0;r<16;++r)sacc+=pB1[r]; l_reg+=sacc;
    pw0=(u32x4){PKW(pB0,0),PKW(pB0,2),PKW(pB0,4),PKW(pB0,6)};pw1=(u32x4){PKW(pB0,8),PKW(pB0,10),PKW(pB0,12),PKW(pB0,14)};pw2=(u32x4){PKW(pB1,0),PKW(pB1,2),PKW(pB1,4),PKW(pB1,6)};pw3=(u32x4){PKW(pB1,8),PKW(pB1,10),PKW(pB1,12),PKW(pB1,14)};
    SBAR(); pv(o,vb0+sl_cur,PAF(0),PAF(1),PAF(2),PAF(3)); }
  #undef PKW
  #undef PAF
  #undef VFR
  #undef PIN
  #undef MX3
  #undef GAPA
  #undef GAPB
  #undef EX
  #undef VRD
  #undef KRD
  #undef STEP
  #undef ENDW
  {auto rr=__builtin_amdgcn_permlane32_swap(__float_as_uint(l_reg),__float_as_uint(l_reg),false,false);l_reg=__uint_as_float(rr[0])+__uint_as_float(rr[1]);}
  if(hi==0)wsf[32+r32]=l_reg;asm volatile("s_waitcnt lgkmcnt(0)":::"memory");
  float rli[16];
  #pragma unroll
  for(int r=0;r<16;++r)rli[r]=__builtin_amdgcn_rcpf(wsf[32+crow(r,hi)]);
  bf16*Ow=O+(rowbase+q0+wid*QBLK)*QP+h*D;
  { bf16*stg=(bf16*)(shm+LDS_OST)+wid*2048;
    #pragma unroll
    for(int r=0;r<16;++r){const int orow=crow(r,hi);
      #pragma unroll
      for(int d0=0;d0<2;++d0)stg[orow*64+d0*32+r32]=__float2bfloat16(o[d0][r]*rli[r]);}
    asm volatile("s_waitcnt lgkmcnt(0)":::"memory");
    #pragma unroll
    for(int i=0;i<4;++i){const int row=i*8+(lane>>3),ch=lane&7; const u32x4 v=*(const u32x4*)(stg+row*64+ch*8); ATTN_STORE16(Ow+(long)row*QP+ch*8,v);} }
  asm volatile("s_waitcnt lgkmcnt(0)\n\ts_barrier":::"memory");
  #undef DMA_K
  #undef DMA_V
  #undef CMASK
  #undef START
  #undef RESC
  #undef ROT
}
constexpr int ATTN_LDS_BYTES=LDS_BYTES;

#undef SBAR
#undef WAIT_BAR
}
constexpr int T = 16384, D = 1024, SEQ = 2048, NBATCH = 8, NEXP = 32;
constexpr float C2F = 0.125f * 1.4426950408889634f;
constexpr float LN2F = 0.6931471805599453f;
constexpr float NORM_EPS = 1e-6f;
constexpr size_t MiB = 1u << 20;
constexpr size_t WS_CTL = 0, CTL_ZERO_BYTES = 1 * MiB;
constexpr size_t WS_MOD = 1 * MiB;
constexpr size_t WS_ROPEA = 2 * MiB;
constexpr size_t WS_ROPEB = 3 * MiB;
constexpr size_t WS_WRT = 3 * MiB + 65536;
constexpr size_t WS_HIST = 4 * MiB;
constexpr size_t WS_TOT = 4 * MiB + 65536;
constexpr size_t WS_GSORT = 5 * MiB;
constexpr size_t WS_POSOF = 5 * MiB + 524288;
constexpr size_t WS_LSE = 6 * MiB;
constexpr size_t WS_WINA_QK = 16 * MiB, WS_WINA_V = 28 * MiB, WS_WOUTA = 34 * MiB, WS_WINB = 36 * MiB, WS_WOUTB = 39 * MiB;
constexpr size_t WS_WUP = 48 * MiB, WS_WDOWN = 304 * MiB;
constexpr size_t WS_XA = 432 * MiB;
constexpr size_t WS_H0 = 496 * MiB, WS_H1 = 528 * MiB, WS_H2 = 560 * MiB;
constexpr size_t WS_QA = 592 * MiB, WS_KA = 688 * MiB, WS_VTA = 784 * MiB;
constexpr size_t WS_OG = 880 * MiB;
constexpr size_t WS_O = 976 * MiB, WS_Y = 1008 * MiB;
constexpr size_t WS_XS = 592 * MiB, WS_ACT = 736 * MiB, WS_OUTS = 880 * MiB;
constexpr size_t WS_QB = 880 * MiB, WS_KB = 912 * MiB, WS_VB = 920 * MiB;
constexpr size_t WS_END = 1040 * MiB;
static_assert(WS_H2 - WS_H1 == WS_H1 - WS_H0, "H0/H1/H2 equally spaced");
constexpr int MAXROWS = 73728, MAXTILES = 288;
constexpr size_t TSTEP = (size_t)256 * 1024 * 2;
constexpr size_t TSTEP8 = (size_t)256 * 1024;
constexpr float W8_SCALE = 32.0f;
constexpr int CW_TMO = 0, CW_CODE = 1, CW_BAR = 4096, CW_CMP = 200000;
constexpr int RING_BYTES = 131072;
constexpr int TBL_OFF = 135168;
constexpr int RT_PITCH = 2064, RT_LO = 32 * RT_PITCH, T_LG = 139264;
constexpr int T_SEL = TBL_OFF, T_GTE = TBL_OFF + 1024, T_RNK = TBL_OFF + 2048, T_TOT = TBL_OFF + 3072, T_BEF = T_TOT + 128, T_PBASE = T_BEF + 128, T_MYOFF = T_PBASE + 128, T_TEXP = T_MYOFF + 128, T_MT = T_TEXP + 512;
constexpr int LDSCTL_OFF = 143360, MISC_OFF = LDSCTL_OFF + 320;
constexpr int LDS_BYTES = 151552;
constexpr int T_LG2 = 147456;
constexpr int NWAVES = 8;

typedef unsigned u32x2v __attribute__((ext_vector_type(2)));
typedef float f32x2v __attribute__((ext_vector_type(2)));
typedef float f32x16 __attribute__((ext_vector_type(16)));
typedef float f32x2t __attribute__((ext_vector_type(2)));
typedef __bf16 bf16x2t __attribute__((ext_vector_type(2)));
__device__ __forceinline__ unsigned pkbf(float lo, float hi) { f32x2t v = {lo, hi}; bf16x2t b = __builtin_convertvector(v, bf16x2t); return __builtin_bit_cast(unsigned, b); }
constexpr float OUTS_SCALE = 8.0f;
__device__ __forceinline__ unsigned pk4_fp8(float a, float b, float c, float d) { unsigned w = 0; w = __builtin_amdgcn_cvt_pk_fp8_f32(a, b, w, false); w = __builtin_amdgcn_cvt_pk_fp8_f32(c, d, w, true); return w; }
__device__ __forceinline__ float bflo(unsigned u) { return __builtin_bit_cast(float, u << 16); }
__device__ __forceinline__ float bfhi(unsigned u) { return __builtin_bit_cast(float, u & 0xffff0000u); }
__device__ __forceinline__ v4u pack8(f32x4 a, f32x4 b) { v4u w; w.x = pkbf(a[0], a[1]); w.y = pkbf(a[2], a[3]); w.z = pkbf(b[0], b[1]); w.w = pkbf(b[2], b[3]); return w; }
__device__ __forceinline__ float wave_sum(float v) {
#pragma unroll
    for (int o = 1; o < 64; o <<= 1) v += __shfl_xor(v, o);
    return v;
}
__device__ __forceinline__ float hsum4(f32x4 v) { return (v[0] + v[1]) + (v[2] + v[3]); }
__device__ __forceinline__ float dot4(f32x4 a, f32x4 b) { return (a[0] * b[0] + a[1] * b[1]) + (a[2] * b[2] + a[3] * b[3]); }
__device__ __forceinline__ int perm_row(int t, int sh) { const int s = t & 2047; return (t & ~2047) + ((s & ((1 << sh) - 1)) << (11 - sh)) + (s >> sh); }
__device__ __forceinline__ int unperm_row(int p, int sh) { const int pp = p & 2047, Lsh = 11 - sh; return (p & ~2047) + ((pp & ((1 << Lsh) - 1)) << sh) + (pp >> Lsh); }

__host__ __device__ __forceinline__ int swap23(int r) { return (r & 0x13) | ((r & 4) << 1) | ((r & 8) >> 1); }
__host__ __device__ __forceinline__ size_t qk_chunk(int g, int h, int blk) { return ((size_t)(g * 16 + h) * 512 + blk) * 2048; }
struct Args { const float* in[20]; float* out; unsigned char* ws; int ph_lo, ph_hi, li, pad; };
__device__ __forceinline__ int lane_id() { int l; asm volatile("v_mbcnt_lo_u32_b32 %0, -1, 0\n\tv_mbcnt_hi_u32_b32 %0, -1, %0" : "=v"(l)); return l; }
__device__ __forceinline__ unsigned char* opaque_ptr(unsigned char* p) { asm volatile("" : "+s"(p)); return p; }
#ifndef PSEC
#define PSEC 0
#endif
#define SEC_BEGIN(id) unsigned long long tsec_##id = 0; if ((id) == PSEC) tsec_##id = __builtin_amdgcn_s_memrealtime()
#define SEC_END(id) do { if ((id) == PSEC && F.wave == 0 && lane_id() == 0) F.MISC[16] += (unsigned)(__builtin_amdgcn_s_memrealtime() - tsec_##id); } while (0)
struct Frame {
    LAS unsigned char* lds;
    volatile LAS unsigned* MISC;
    gu32* ctl;
    int wave, G, vcu;
    float* out; unsigned char* ws;
};
enum { IN_X = 0, IN_C, IN_WMOD, IN_BMOD, IN_GPREMIX, IN_GPOSTMIX, IN_GPREFFN, IN_GPOSTFFN, IN_WINA, IN_WOUTA, IN_WINB, IN_GQB, IN_GKB, IN_WOUTB, IN_WROUTER, IN_BROUTER, IN_WUP, IN_BUP, IN_WDOWN, IN_BDOWN };

struct RmNat { __device__ __forceinline__ int operator()(int c) const { return c; } };
struct RmInA { unsigned char* qk; unsigned char* v;
    __device__ __forceinline__ unsigned char* row(int c) const { const int g = c / 3072, rem = c - g * 3072, j = rem >> 10, cc = rem & 1023;
        if (j < 2) { const int hq4 = cc >> 8, wc = (cc >> 6) & 3, bj = (cc >> 5) & 1, t = cc & 31; return qk + (size_t)(g * 2048 + (j * 4 + hq4) * 256 + 128 * bj + 32 * wc + t) * 1024; }
        return v + (size_t)(g * 1024 + cc) * 1024; } };
__device__ __forceinline__ int rm_inb(int c) { const int pn = c >> 8, cc = c & 255, wc = cc >> 6, dm = cc & 63, bj = (dm >> 4) & 1, fq = 2 * (dm >> 5) + ((dm >> 3) & 1), n = (dm >> 2) & 1, i = dm & 3; return pn * 256 + 128 * bj + 32 * wc + 8 * fq + 4 * n + i; }
__device__ __forceinline__ int rm_lin(int c) { const int pn = c >> 8, cc = c & 255, wc = cc >> 6, bj = (cc >> 5) & 1, t = cc & 31; return pn * 256 + 128 * bj + 32 * wc + t; }
__device__ __forceinline__ int rm_dn(int c) { const int pn = c >> 8, cc = c & 255, wc = cc >> 6, fq = (cc >> 4) & 3, bj = (cc >> 3) & 1, r = cc & 7; return pn * 256 + 128 * bj + 32 * wc + 8 * fq + r; }
__device__ __forceinline__ int rm_up(int c) { const int bj = c >> 10, pn = (c & 1023) >> 7, jj = c & 127; return pn * 256 + 128 * bj + jj; }
constexpr int I_UP = 64 * 32 * 8, I_DN = 64 * 16 * 8, I_INA = 144 * 8, I_OUT = 16 * 16, I_INB = 24 * 16;
constexpr int NITEMS = I_UP + I_DN + I_INA + 2 * I_OUT + I_INB;
struct CvtItem { const float* src; int ldw; int kind, le, k0, n0; };
__device__ __forceinline__ CvtItem cvt_decode(const Args& args, int it) {
    CvtItem c; int r = it;
    if (r < I_UP) { c.kind = 0; c.le = r >> 8; const int q = r & 255; c.k0 = (q >> 5) * 128; c.n0 = (q & 31) * 64; c.ldw = 2048; c.src = args.in[IN_WUP] + (size_t)c.le * 1024 * 2048; }
    else if ((r -= I_UP) < I_DN) { c.kind = 1; c.le = r >> 7; const int q = r & 127; c.k0 = (q >> 4) * 128; c.n0 = (q & 15) * 64; c.ldw = 1024; c.src = args.in[IN_WDOWN] + (size_t)c.le * 1024 * 1024; }
    else if ((r -= I_DN) < I_INA) { c.kind = 2; c.le = 0; c.k0 = (r / 144) * 128; c.n0 = (r % 144) * 64; c.ldw = 9216; c.src = args.in[IN_WINA]; }
    else if ((r -= I_INA) < I_OUT) { c.kind = 3; c.le = 0; c.k0 = (r >> 4) * 64; c.n0 = (r & 15) * 64; c.ldw = 1024; c.src = args.in[IN_WOUTA]; }
    else if ((r -= I_OUT) < I_OUT) { c.kind = 4; c.le = 0; c.k0 = (r >> 4) * 64; c.n0 = (r & 15) * 64; c.ldw = 1024; c.src = args.in[IN_WOUTB]; }
    else { r -= I_OUT; c.kind = 5; c.le = 0; c.k0 = (r / 24) * 64; c.n0 = (r % 24) * 64; c.ldw = 1536; c.src = args.in[IN_WINB]; }
    return c;
}
__device__ __forceinline__ void cvt_load(const CvtItem& c, int half, f32x4 (&v)[16], int lane) {
    const float* p = c.src + (size_t)(c.k0 + 64 * half + 4 * (lane >> 4)) * c.ldw + c.n0 + 4 * (lane & 15);
#pragma unroll
    for (int i = 0; i < 16; ++i) v[i] = __builtin_nontemporal_load((const GAS f32x4*)(p + (size_t)(16 * (i >> 2) + (i & 3)) * c.ldw));
}
__device__ __forceinline__ unsigned char* cvt_row(const CvtItem& c, unsigned char* ws, int cidx) {
    switch (c.kind) {
    case 0: return ws + WS_WUP + ((size_t)c.le * 2048 + rm_up(cidx)) * 1024;
    case 1: return ws + WS_WDOWN + ((size_t)c.le * 1024 + rm_dn(cidx)) * 1024;
    case 2: { const RmInA rm{ws + WS_WINA_QK, ws + WS_WINA_V}; return rm.row(cidx); }
    case 3: return ws + WS_WOUTA + (size_t)rm_lin(cidx) * 2048;
    case 4: return ws + WS_WOUTB + (size_t)rm_lin(cidx) * 2048;
    default: return ws + WS_WINB + (size_t)rm_inb(cidx) * 2048;
    }
}
__device__ __forceinline__ void cvt_pack8(const f32x4 (&v)[16], int half, LAS unsigned* scr, int lane) {
    const int lr = lane >> 4, lc = 4 * (lane & 15);
#pragma unroll
    for (int j = 0; j < 4; ++j)
#pragma unroll
        for (int q = 0; q < 4; ++q) scr[(lc + q) * 33 + 16 * half + 4 * j + lr] = pk4_fp8(v[4 * j][q] * W8_SCALE, v[4 * j + 1][q] * W8_SCALE, v[4 * j + 2][q] * W8_SCALE, v[4 * j + 3][q] * W8_SCALE);
}
__device__ __forceinline__ void cvt_store8(const CvtItem& c, unsigned char* ws, LAS unsigned* scr, int lane) {
    LDS_WAIT(); asm volatile("" ::: "memory");
    const int cq = lane & 7;
#pragma unroll
    for (int s = 0; s < 8; ++s) { const int nl = 8 * s + (lane >> 3); const LAS unsigned* q = scr + nl * 33 + 4 * cq;
        v4u o; o.x = q[0]; o.y = q[1]; o.z = q[2]; o.w = q[3];
        *(GAS v4u*)(cvt_row(c, ws, c.n0 + nl) + c.k0 + 16 * cq) = o; }
    LDS_WAIT(); asm volatile("" ::: "memory");
}
__device__ __forceinline__ void cvt_finish16(const CvtItem& c, const f32x4 (&v)[16], unsigned char* ws, LAS float* scr, int lane) {
    const int lr = lane >> 4, lc = 4 * (lane & 15);
#pragma unroll
    for (int i = 0; i < 16; ++i) { LAS float* p = scr + (16 * (i >> 2) + 4 * lr + (i & 3)) * 65 + lc; p[0] = v[i][0]; p[1] = v[i][1]; p[2] = v[i][2]; p[3] = v[i][3]; }
    LDS_WAIT(); asm volatile("" ::: "memory");
    const int cq = lane & 7;
#pragma unroll
    for (int s = 0; s < 8; ++s) { const int nl = 8 * s + (lane >> 3); const LAS float* q = scr + (8 * cq) * 65 + nl;
        v4u o; o.x = pkbf(q[0], q[65]); o.y = pkbf(q[2 * 65], q[3 * 65]); o.z = pkbf(q[4 * 65], q[5 * 65]); o.w = pkbf(q[6 * 65], q[7 * 65]);
        *(GAS v4u*)(cvt_row(c, ws, c.n0 + nl) + (size_t)(c.k0 + 8 * cq) * 2) = o; }
    LDS_WAIT(); asm volatile("" ::: "memory");
}
__device__ __forceinline__ void p0_prologue(Frame& F, const Args& args) {
    unsigned char* const wsl = opaque_ptr(F.ws);
    unsigned char* ws = wsl;
    const int gtid = blockIdx.x * 512 + (F.wave * 64 + lane_id());
    if (gtid < 65536) { const int l = gtid >> 15, e = (gtid >> 10) & 31, k = gtid & 1023; const float wv = args.in[IN_WROUTER][((size_t)l * 1024 + k) * 32 + e];
        const unsigned hb = pkbf(wv, 0.f) & 0xffffu; const float hf_ = __builtin_bit_cast(float, hb << 16); const unsigned lb = pkbf(wv - hf_, 0.f) & 0xffffu;
        ((bf16*)(ws + WS_WRT))[gtid] = (bf16)hb; ((bf16*)(ws + WS_WRT + 131072))[gtid] = (bf16)lb; }
    if (blockIdx.x < 192) {
        const int is = blockIdx.x / 48, n0 = (blockIdx.x % 48) * 64;
        LAS float* sil = (LAS float*)F.lds;
        LAS float* red = (LAS float*)(F.lds + 32768);
        const int w = F.wave, lane = lane_id();
#pragma unroll
        for (int b = 0; b < 8; ++b)
#pragma unroll
            for (int q = 0; q < 2; ++q) { const int kk = lane * 2 + q; const float cv = args.in[IN_C][b * 1024 + 128 * w + kk]; sil[(w * 8 + b) * 128 + kk] = cv / (1.f + expf(-cv)); }
        LDS_WAIT(); asm volatile("" ::: "memory");
        const float* wm = args.in[IN_WMOD] + (size_t)is * 1024 * 3072 + (size_t)(128 * w) * 3072 + n0 + lane;
        float acc[8] = {0.f, 0.f, 0.f, 0.f, 0.f, 0.f, 0.f, 0.f};
#pragma unroll 8
        for (int kk = 0; kk < 128; ++kk) { const float wv = wm[(size_t)kk * 3072];
#pragma unroll
            for (int b = 0; b < 8; ++b) acc[b] += sil[(w * 8 + b) * 128 + kk] * wv; }
#pragma unroll
        for (int b = 0; b < 8; ++b) red[(w * 8 + b) * 64 + lane] = acc[b];
        __syncthreads();
        { const int b = (F.wave * 64 + lane_id()) >> 6, col = (F.wave * 64 + lane_id()) & 63; float s = 0.f;
#pragma unroll
          for (int ww = 0; ww < 8; ++ww) s += red[(ww * 8 + b) * 64 + col];
          ((float*)(ws + WS_MOD))[(size_t)(is * 8 + b) * 3072 + n0 + col] = s + args.in[IN_BMOD][is * 3072 + n0 + col]; }
        __syncthreads();
    }
    LAS float* scr = (LAS float*)(F.lds + F.wave * 16640);
    const int gw = blockIdx.x * NWAVES + F.wave, NGW = F.G * NWAVES, lane = lane_id();
    {
        f32x4 va[16], vb[16];
        int it = gw; if (it >= NITEMS) return;
        CvtItem ca = cvt_decode(args, it); int ha = 0;
        cvt_load(ca, ha, va, lane);
        for (;;) {
            CvtItem cb = ca; int hb = ha + 1; bool haveb = true;
            if (!(ca.kind < 3 && ha == 0)) { it += NGW; hb = 0; haveb = it < NITEMS; if (haveb) cb = cvt_decode(args, it); }
            if (haveb) cvt_load(cb, hb, vb, lane);
            if (ca.kind < 3) { cvt_pack8(va, ha, (LAS unsigned*)scr, lane); if (ha == 1) cvt_store8(ca, ws, (LAS unsigned*)scr, lane); } else cvt_finish16(ca, va, ws, scr, lane);
            if (!haveb) break;
            CvtItem cc = cb; int hc = hb + 1; bool havec = true;
            if (!(cb.kind < 3 && hb == 0)) { it += NGW; hc = 0; havec = it < NITEMS; if (havec) cc = cvt_decode(args, it); }
            if (havec) cvt_load(cc, hc, va, lane);
            if (cb.kind < 3) { cvt_pack8(vb, hb, (LAS unsigned*)scr, lane); if (hb == 1) cvt_store8(cb, ws, (LAS unsigned*)scr, lane); } else cvt_finish16(cb, vb, ws, scr, lane);
            if (!havec) break;
            ca = cc; ha = hc;
        }
    }
}

__device__ __forceinline__ void p1_prenorm0(Frame& F, const Args& args) {
    unsigned char* const wsl = opaque_ptr(F.ws);
    const int lane = lane_id(); const int gw = blockIdx.x * NWAVES + F.wave, NGW = F.G * NWAVES;
    unsigned char* H0 = wsl + WS_H0; unsigned char* H1 = wsl + WS_H1; unsigned char* H2 = wsl + WS_H2;
    for (int t0 = gw * 8; t0 < T; t0 += NGW * 8) {
        const int b = t0 >> 11;
        const float* m0 = (const float*)(wsl + WS_MOD) + (size_t)(0 * 8 + b) * 3072;
        f32x4 gs[4], sh[4];
#pragma unroll
        for (int j = 0; j < 4; ++j) { const int c = 16 * lane + 4 * j; const f32x4 g = *(const f32x4*)(args.in[IN_GPREMIX] + c), sc = *(const f32x4*)(m0 + 1024 + c); gs[j] = g * (sc + 1.0f); sh[j] = *(const f32x4*)(m0 + c); }
        for (int i0 = 0; i0 < 8; i0 += 4) {
            f32x4 v[4][4];
#pragma unroll
            for (int u = 0; u < 4; ++u)
#pragma unroll
                for (int j = 0; j < 4; ++j) v[u][j] = *(const GAS f32x4*)(args.in[IN_X] + (size_t)(t0 + i0 + u) * D + 16 * lane + 4 * j);
#pragma unroll
            for (int u = 0; u < 4; ++u) { const int t = t0 + i0 + u; float ss = 0.f;
#pragma unroll
                for (int j = 0; j < 4; ++j) ss += dot4(v[u][j], v[u][j]);
                const float rstd = rsqrtf(wave_sum(ss) * (1.f / D) + NORM_EPS);
                v4u w;
#pragma unroll
                for (int j = 0; j < 4; ++j) { const f32x4 h = v[u][j] * rstd * gs[j] + sh[j]; w[j] = pk4_fp8(h[0], h[1], h[2], h[3]); }
                *(GAS v4u*)(H0 + (size_t)t * 1024 + 16 * lane) = w; *(GAS v4u*)(H1 + (size_t)perm_row(t, 2) * 1024 + 16 * lane) = w; *(GAS v4u*)(H2 + (size_t)perm_row(t, 4) * 1024 + 16 * lane) = w; }
        }
    }
}

__device__ __forceinline__ int rfl(int v) { return __builtin_amdgcn_readfirstlane(v); }
__device__ __forceinline__ const char* uptr(const char* p) { const unsigned long long v = (unsigned long long)p; const unsigned lo = __builtin_amdgcn_readfirstlane((unsigned)v), hi = __builtin_amdgcn_readfirstlane((unsigned)(v >> 32)); return (const char*)(((unsigned long long)hi << 32) | lo); }
__device__ __forceinline__ void store_rows128(unsigned char* seg0  , size_t pitch, int fr, int off0  , int off1  , v4u p0, v4u p1) {
    const bool odd = fr & 1; const v4u snd = odd ? p0 : p1; v4u rcv;
#pragma unroll
    for (int e = 0; e < 4; ++e) rcv[e] = (unsigned)__builtin_amdgcn_update_dpp(0, (int)snd[e], 0xB1  , 0xF, 0xF, false);
    const v4u a = odd ? rcv : p0, b = odd ? p1 : rcv;
    const int off = odd ? off1 : off0;
    *(GAS v4u*)(seg0 + (size_t)(odd ? fr - 1 : fr) * pitch + off) = a; *(GAS v4u*)(seg0 + (size_t)(odd ? fr : fr + 1) * pitch + off) = b;
}
typedef pg8::f32x4 (&AccRef)[2][2][4][2];
struct SchedPlain {
    pg8::GridOrder go; const char* A; const char* B;
    __device__ __forceinline__ bool next(int i, pg8::Unit& u) const { int pm, pn; if (!go.tile(i, pm, pn)) return false; pm = rfl(pm); pn = rfl(pn); u.a = uptr(A + (size_t)pm * TSTEP); u.b = uptr(B + (size_t)pn * TSTEP); u.pm = pm; u.pn = pn; u.aux = 0; return true; }
};
struct EpiPlain {
    static constexpr bool PERM = true;
    bf16* O; size_t ldc;
    __device__ __forceinline__ void operator()(const pg8::f32x4 (&acc)[2][2][4][2], const pg8::Unit& u, int wr, int wc, int fr_in, int fq_in) const {
        const int ln_ = lane_id(), fr = ln_ & 15, fq = ln_ >> 4; (void)fr_in; (void)fq_in;
#pragma unroll
        for (int ai = 0; ai < 2; ++ai)
#pragma unroll
            for (int m = 0; m < 4; ++m) store_rows128((unsigned char*)(O + (size_t)(u.pm * 256 + ai * 128 + wr * 64 + m * 16) * ldc + u.pn * 256 + wc * 64), ldc * 2, fr, 16 * fq, 64 + 16 * fq,
                                                      pack8(acc[ai][0][m][0], acc[ai][0][m][1]), pack8(acc[ai][1][m][0], acc[ai][1][m][1]));
    }
};
struct SchedInaQK {
    pg8::GridOrder go; const char* h0; const char* w;
    __device__ __forceinline__ bool next(int i, pg8::Unit& u) const { int pm, pv; if (!go.tile(i, pm, pv)) return false; pm = rfl(pm); pv = rfl(pv); const int g = pv >> 3, pn = pv & 7;
        const char* hg = h0 + (size_t)g * (WS_H1 - WS_H0); u.a = uptr(hg + (size_t)pm * TSTEP8); u.b = uptr(w + (size_t)(g * 2048 + pn * 256) * 1024); u.pm = pm; u.pn = pn; u.aux = g; return true; }
};
struct EpiRopeA {
    static constexpr bool PERM = true;
    bf16* QA; bf16* KA;
    __device__ __forceinline__ void operator()(const pg8::f32x4 (&acc)[2][2][4][2], const pg8::Unit& u, int wr, int wc, int fr_in, int fq_in) const {
        const int ln_ = lane_id(), fr = ln_ & 15, fq = ln_ >> 4; (void)fr_in; (void)fq_in;
        const int g = u.aux, j = u.pn >> 2, head = (u.pn & 3) * 4 + wc, sh = g == 0 ? 0 : (g == 1 ? 2 : 4);
        bf16* dst = (j == 0 ? QA : KA);
        const float sc = j == 0 ? C2F : 1.0f;
        float invr[2][4];
#pragma unroll
        for (int n = 0; n < 2; ++n)
#pragma unroll
            for (int i = 0; i < 4; ++i) invr[n][i] = __builtin_amdgcn_exp2f((float)(8 * fq + 4 * n + i) * (-13.287712379549449f / 32.0f)) * 0.15915494309189535f;
#pragma unroll
        for (int ai = 0; ai < 2; ++ai)
#pragma unroll
            for (int m = 0; m < 4; ++m) { const int p = u.pm * 256 + ai * 128 + wr * 64 + m * 16 + fr; const float pos = (float)(unperm_row(p, sh) & 2047);
                pg8::f32x4 o1[2], o2[2];
#pragma unroll
                for (int n = 0; n < 2; ++n) { pg8::f32x4 c, sn;
#pragma unroll
                    for (int i = 0; i < 4; ++i) { const float rv = __builtin_amdgcn_fractf(pos * invr[n][i]); c[i] = __builtin_amdgcn_cosf(rv); sn[i] = __builtin_amdgcn_sinf(rv); }
                    const pg8::f32x4 x1 = acc[ai][0][m][n], x2 = acc[ai][1][m][n];
                    o1[n] = (x1 * c - x2 * sn) * sc; o2[n] = (x2 * c + x1 * sn) * sc; }
                const int r = p & 31, slot = j == 0 ? r : swap23(r);
                bf16* cp2 = dst + qk_chunk(g, head, p >> 5) + (size_t)(((fq >> 1) * 2 + (fq & 1)) * 32 + slot) * 8;
                *(GAS v4u*)cp2 = pack8(o1[0], o1[1]); *(GAS v4u*)(cp2 + 2 * 2 * 32 * 8) = pack8(o2[0], o2[1]); }
    }
};
struct SchedInaV {
    pg8::GridOrder go; const char* h0; const char* w;
    __device__ __forceinline__ bool next(int i, pg8::Unit& u) const { int pv, pn; if (!go.tile(i, pv, pn)) return false; pv = rfl(pv); pn = rfl(pn); const int g = pv >> 2, pmf = pv & 3;
        const char* hg = h0 + (size_t)g * (WS_H1 - WS_H0); u.a = uptr(w + (size_t)(g * 1024 + pmf * 256) * 1024); u.b = uptr(hg + (size_t)pn * TSTEP8); u.pm = pmf; u.pn = pn; u.aux = g; return true; }
};
struct EpiVt {
    static constexpr bool PERM = true;
    bf16* VT;
    __device__ __forceinline__ void operator()(const pg8::f32x4 (&acc)[2][2][4][2], const pg8::Unit& u, int wr, int wc, int fr_in, int fq_in) const {
        const int ln_ = lane_id(), fr = ln_ & 15, fq = ln_ >> 4; (void)fr_in; (void)fq_in;
#pragma unroll
        for (int ai = 0; ai < 2; ++ai)
#pragma unroll
            for (int m = 0; m < 4; ++m) { const int f = u.pm * 256 + ai * 128 + wr * 64 + m * 16 + fr, h = f >> 6, db = (f >> 5) & 1, dd = f & 31;
                bf16* cp2 = VT + (size_t)((((fq >> 1) * 2 + db) * 2 + (fq & 1)) * 32 + dd) * 8;
#pragma unroll
                for (int bj = 0; bj < 2; ++bj) *(GAS v4u*)(cp2 + qk_chunk(u.aux, h, u.pn * 8 + bj * 4 + wc)) = pack8(acc[ai][bj][m][0], acc[ai][bj][m][1]); }
    }
};
struct EpiInB {
    static constexpr bool PERM = true;
    bf16* QB; bf16* KB; bf16* VB; const float* gq; const float* gk;
    __device__ __forceinline__ void operator()(const pg8::f32x4 (&acc)[2][2][4][2], const pg8::Unit& u, int wr, int wc, int fr_in, int fq_in) const {
        const int ln_ = lane_id(), fr = ln_ & 15, fq = ln_ >> 4; (void)fr_in; (void)fq_in;
        const int pn = u.pn, A = fq >> 1, f8 = 8 * (fq & 1), off0 = 64 * A + 2 * f8;
        const bool isq = pn < 4, isv = pn == 5; const float* gv = isq ? gq : gk; const float sc = isq ? C2F : 1.0f;
        bf16* dst = QB + (pn * 4 + wc) * 64; const size_t pitch = 1024;
        pg8::f32x4 gg[2][2];
#pragma unroll
        for (int bj = 0; bj < 2; ++bj)
#pragma unroll
            for (int n = 0; n < 2; ++n) gg[bj][n] = isv ? (pg8::f32x4){1.f, 1.f, 1.f, 1.f} : *(const pg8::f32x4*)(gv + 32 * A + 16 * bj + f8 + 4 * n);
        float invr[2][4];
#pragma unroll
        for (int n = 0; n < 2; ++n)
#pragma unroll
            for (int i = 0; i < 4; ++i) invr[n][i] = __builtin_amdgcn_exp2f((float)(f8 + 4 * n + i) * (-13.287712379549449f / 16.0f)) * 0.15915494309189535f;
#pragma unroll
        for (int ai = 0; ai < 2; ++ai)
#pragma unroll
            for (int m = 0; m < 4; ++m) { const int t0 = u.pm * 256 + ai * 128 + wr * 64 + m * 16, s = (t0 + fr) & 2047;
                float ss = 0.f;
#pragma unroll
                for (int bj = 0; bj < 2; ++bj)
#pragma unroll
                    for (int n = 0; n < 2; ++n) { const pg8::f32x4 x = acc[ai][bj][m][n]; ss += (x[0] * x[0] + x[1] * x[1]) + (x[2] * x[2] + x[3] * x[3]); }
                ss += __shfl_xor(ss, 16); ss += __shfl_xor(ss, 32);
                const float rstd = isv ? 1.0f : rsqrtf(ss * (1.f / 64.f) + NORM_EPS) * sc;
                const float pos = (float)(A == 0 ? (s >> 6) : (s & 63));
                pg8::f32x4 o1[2], o2[2];
#pragma unroll
                for (int n = 0; n < 2; ++n) { const pg8::f32x4 x1 = acc[ai][0][m][n] * rstd * gg[0][n], x2 = acc[ai][1][m][n] * rstd * gg[1][n];
                    if (isv) { o1[n] = x1; o2[n] = x2; }
                    else { pg8::f32x4 c, sn;
#pragma unroll
                        for (int i = 0; i < 4; ++i) { const float rv = __builtin_amdgcn_fractf(pos * invr[n][i]); c[i] = __builtin_amdgcn_cosf(rv); sn[i] = __builtin_amdgcn_sinf(rv); }
                        o1[n] = x1 * c - x2 * sn; o2[n] = x2 * c + x1 * sn; } }
                if (isq) store_rows128((unsigned char*)(dst + (size_t)t0 * pitch), pitch * 2, fr, off0, off0 + 32, pack8(o1[0], o1[1]), pack8(o2[0], o2[1]));
                else {
                    const int t = t0 + fr, bq = t >> 11, r64 = t & 63; bf16* blk = KB + (isv ? (size_t)((WS_VB - WS_KB) / 2) : (size_t)0) + ((size_t)(bq * 4 + wc) * 32 + ((t & 2047) >> 6)) * 4096;
                    if (!isv) { bf16* kp = blk + (4 * A + (fq & 1)) * 512 + r64 * 8;
                        *(GAS v4u*)kp = pack8(o1[0], o1[1]); *(GAS v4u*)(kp + 2 * 512) = pack8(o2[0], o2[1]); }
                    else { bf16* vp = blk + (A * 4 + (r64 >> 4)) * 512 + (r64 & 15) * 32 + (fq & 1) * 8;
                        *(GAS v4u*)vp = pack8(o1[0], o1[1]); *(GAS v4u*)(vp + 16) = pack8(o2[0], o2[1]); }
                } }
    }
};
struct SchedMoe {
    pg8::GridOrder go; const char* A; const char* W; size_t wstride; const LAS unsigned char* texp;
    __device__ __forceinline__ bool next(int i, pg8::Unit& u) const { int pm, pn; if (!go.tile(i, pm, pn)) return false; pm = rfl(pm); pn = rfl(pn); const int e = rfl((int)texp[pm]);
        u.a = uptr(A + (size_t)pm * TSTEP8); u.b = uptr(W + (size_t)e * wstride + (size_t)pn * TSTEP8); u.pm = pm; u.pn = pn; u.aux = e; return true; }
};
struct EpiSwiglu {
    static constexpr bool PERM = true;
    unsigned char* ACT; const float* bup;
    __device__ __forceinline__ void operator()(const pg8::f32x4 (&acc)[2][2][4][2], const pg8::Unit& u, int wr, int wc, int fr_in, int fq_in) const {
        const int ln_ = lane_id(), fr = ln_ & 15, fq = ln_ >> 4; (void)fr_in; (void)fq_in;
        const int cj = u.pn * 128 + wc * 32 + 8 * fq; const float* bb = bup + (size_t)u.aux * 2048 + cj;
        pg8::f32x4 bg[2], bl[2];
#pragma unroll
        for (int n = 0; n < 2; ++n) { bg[n] = *(const pg8::f32x4*)(bb + 4 * n); bl[n] = *(const pg8::f32x4*)(bb + 1024 + 4 * n); }
#pragma unroll
        for (int ai = 0; ai < 2; ++ai)
#pragma unroll
            for (int m = 0; m < 4; ++m) { pg8::f32x4 a[2];
#pragma unroll
                for (int n = 0; n < 2; ++n) { const pg8::f32x4 gl = acc[ai][0][m][n] + bg[n], li = acc[ai][1][m][n] + bl[n];
#pragma unroll
                    for (int i = 0; i < 4; ++i) { const float gx = fminf(gl[i], 7.0f), lx = fminf(fmaxf(li[i], -7.0f), 7.0f);
                        a[n][i] = gx * __builtin_amdgcn_rcpf(1.0f + __builtin_amdgcn_exp2f(gx * (-1.702f * 1.4426950408889634f))) * (lx + 1.0f); } }
                u32x2v o8; o8.x = pk4_fp8(a[0][0], a[0][1], a[0][2], a[0][3]); o8.y = pk4_fp8(a[1][0], a[1][1], a[1][2], a[1][3]);
                *(GAS u32x2v*)(ACT + (size_t)(u.pm * 256 + ai * 128 + wr * 64 + m * 16 + fr) * 1024 + cj) = o8; }
    }
};
struct EpiDown {
    static constexpr bool PERM = true;
    unsigned char* OUTS; const float* bdn; const float* gsort;
    __device__ __forceinline__ void operator()(const pg8::f32x4 (&acc)[2][2][4][2], const pg8::Unit& u, int wr, int wc, int fr_in, int fq_in) const {
        const int ln_ = lane_id(), fr = ln_ & 15, fq = ln_ >> 4; (void)fr_in; (void)fq_in;
        const int c0 = u.pn * 256 + wc * 64 + 16 * fq; const float* bb = bdn + (size_t)u.aux * 1024 + c0;
        pg8::f32x4 bv[2][2];
#pragma unroll
        for (int bj = 0; bj < 2; ++bj)
#pragma unroll
            for (int n = 0; n < 2; ++n) bv[bj][n] = *(const pg8::f32x4*)(bb + 8 * bj + 4 * n);
#pragma unroll
        for (int ai = 0; ai < 2; ++ai)
#pragma unroll
            for (int m = 0; m < 4; ++m) { const int row0 = u.pm * 256 + ai * 128 + wr * 64 + m * 16; const float gt = gsort[row0 + fr] * OUTS_SCALE; v4u o;
#pragma unroll
                for (int bj = 0; bj < 2; ++bj)
#pragma unroll
                    for (int n = 0; n < 2; ++n) { const pg8::f32x4 v = (acc[ai][bj][m][n] + bv[bj][n]) * gt;
                        o[bj * 2 + n] = pk4_fp8(__builtin_amdgcn_fmed3f(v[0], -448.f, 448.f), __builtin_amdgcn_fmed3f(v[1], -448.f, 448.f), __builtin_amdgcn_fmed3f(v[2], -448.f, 448.f), __builtin_amdgcn_fmed3f(v[3], -448.f, 448.f)); }
                *(GAS v4u*)(OUTS + (size_t)(row0 + fr) * 1024 + c0) = o; }
    }
};

__device__ __forceinline__ unsigned p3_swz(int row, int byte) { return (unsigned)(row * 128 + ((((byte >> 4) ^ (row ^ (row >> 4))) & 7) << 4) + (byte & 15)); }
struct P3Out { f32x16 O0, O1; float lse; };
__device__ __forceinline__ P3Out p3_wave_unit(const bf16* QA, const bf16* KA, const bf16* VTA, int g, int h, int p0, int lane) {
    const int r32 = lane & 31, hi = lane >> 5;
    const int sh = g == 0 ? 0 : (g == 1 ? 2 : 4), Lsh = 11 - sh;
    const int seqbase = p0 & ~((1 << Lsh) - 1), jq = (p0 & ((1 << Lsh) - 1)) >> 5, nch = 1 << (Lsh - 5);
    const int lo8 = (hi * 32 + r32) * 8;
    const bf16* Qg = QA + qk_chunk(g, h, p0 >> 5) + lo8;
    const bf16* Kg = KA + qk_chunk(g, h, seqbase >> 5) + lo8;
    const bf16* Vg = VTA + qk_chunk(g, h, seqbase >> 5) + lo8;
    bf16x8 qf[4], kf[5][4]; int cc[5]; bool ok[5];
#pragma unroll
    for (int d0 = 0; d0 < 4; ++d0) qf[d0] = *(const GAS bf16x8*)(Qg + d0 * 512);
#pragma unroll
    for (int ci = 0; ci < 5; ++ci) { const int c = jq - 2 + ci; ok[ci] = (c >= 0) && (c < nch); cc[ci] = c < 0 ? 0 : (c >= nch ? nch - 1 : c);
        const bf16* kp = Kg + (size_t)cc[ci] * 2048;
#pragma unroll
        for (int d0 = 0; d0 < 4; ++d0) kf[ci][d0] = *(const GAS bf16x8*)(kp + d0 * 512); }
    f32x16 S[5];
#pragma unroll
    for (int ci = 0; ci < 5; ++ci) { f32x16 a = {};
#pragma unroll
        for (int d0 = 0; d0 < 4; ++d0) a = __builtin_amdgcn_mfma_f32_32x32x16_bf16(kf[ci][d0], qf[d0], a, 0, 0, 0);
        S[ci] = a; }
    bf16x8 vf[5][2][2];
#pragma unroll
    for (int ci = 0; ci < 5; ++ci)
#pragma unroll
        for (int s2 = 0; s2 < 2; ++s2) { const bf16* vp = Vg + (size_t)cc[ci] * 2048 + s2 * 1024; vf[ci][s2][0] = *(const GAS bf16x8*)vp; vf[ci][s2][1] = *(const GAS bf16x8*)(vp + 512); }
#pragma unroll
    for (int ci = 0; ci < 5; ++ci)
#pragma unroll
        for (int i = 0; i < 16; ++i) { const int kk = 16 * (i >> 3) + 8 * hi + (i & 7);
            bool keep = ok[ci]; if (ci == 0) keep = keep && (kk >= r32); if (ci == 4) keep = keep && (kk <= r32);
            S[ci][i] = keep ? S[ci][i] : -INFINITY; }
    float mx = -INFINITY;
#pragma unroll
    for (int ci = 0; ci < 5; ++ci)
#pragma unroll
        for (int i = 0; i < 16; ++i) mx = fmaxf(mx, S[ci][i]);
    mx = fmaxf(mx, __shfl_xor(mx, 32));
    float sum = 0.f;
#pragma unroll
    for (int ci = 0; ci < 5; ++ci)
#pragma unroll
        for (int i = 0; i < 16; ++i) { const float p = __builtin_amdgcn_exp2f(S[ci][i] - mx); S[ci][i] = p; sum += p; }
    sum += __shfl_xor(sum, 32);
    P3Out R; R.O0 = f32x16{}; R.O1 = f32x16{};
#pragma unroll
    for (int ci = 0; ci < 5; ++ci)
#pragma unroll
        for (int s2 = 0; s2 < 2; ++s2) { v4u pw; pw.x = pkbf(S[ci][8 * s2 + 0], S[ci][8 * s2 + 1]); pw.y = pkbf(S[ci][8 * s2 + 2], S[ci][8 * s2 + 3]); pw.z = pkbf(S[ci][8 * s2 + 4], S[ci][8 * s2 + 5]); pw.w = pkbf(S[ci][8 * s2 + 6], S[ci][8 * s2 + 7]);
            const bf16x8 pf = __builtin_bit_cast(bf16x8, pw);
            R.O0 = __builtin_amdgcn_mfma_f32_32x32x16_bf16(vf[ci][s2][0], pf, R.O0, 0, 0, 0); R.O1 = __builtin_amdgcn_mfma_f32_32x32x16_bf16(vf[ci][s2][1], pf, R.O1, 0, 0, 0); }
    const float inv = 1.0f / sum;
#pragma unroll
    for (int i = 0; i < 16; ++i) { R.O0[i] *= inv; R.O1[i] *= inv; }
    R.lse = (mx + __builtin_amdgcn_logf(sum)) * LN2F;
    return R;
}
__device__ __forceinline__ void p3_attn_a(Frame& F) {
    unsigned char* const wsl = opaque_ptr(F.ws);
    const int lane = lane_id(); const int r32 = lane & 31, hi = lane >> 5, w = F.wave;
    const bf16* QA = (const bf16*)(wsl + WS_QA); const bf16* KA = (const bf16*)(wsl + WS_KA); const bf16* VTA = (const bf16*)(wsl + WS_VTA);
    bf16* O = (bf16*)(wsl + WS_O);
    LAS unsigned char* OL = F.lds;
    LAS float* LL = (LAS float*)(F.lds + 131072);
    for (int bu = blockIdx.x; bu < 512; bu += F.G) {
        const int b = bu >> 6, h = (bu >> 2) & 15, ch = bu & 3, tok0 = b * 2048 + 512 * ch;
#pragma unroll 1
        for (int k = 0; k < 4; ++k) { const int g = 2 - (k >> 1), wu = w + 8 * (k & 1), sh = g == 1 ? 2 : 4;
            const int p0 = b * 2048 + (wu & ((1 << sh) - 1)) * (2048 >> sh) + ((512 * ch) >> sh) + 32 * (wu >> sh);
            const P3Out R = p3_wave_unit(QA, KA, VTA, g, h, p0, lane);
            const int x = unperm_row(p0 + r32, sh) - tok0;
            LAS unsigned char* og = OL + (g - 1) * 65536;
#pragma unroll
            for (int i4 = 0; i4 < 4; ++i4) { u32x2v w0, w1; w0.x = pkbf(R.O0[4 * i4], R.O0[4 * i4 + 1]); w0.y = pkbf(R.O0[4 * i4 + 2], R.O0[4 * i4 + 3]); w1.x = pkbf(R.O1[4 * i4], R.O1[4 * i4 + 1]); w1.y = pkbf(R.O1[4 * i4 + 2], R.O1[4 * i4 + 3]);
                *(LAS u32x2v*)(og + p3_swz(x, 16 * i4 + 8 * hi)) = w0; *(LAS u32x2v*)(og + p3_swz(x, 64 + 16 * i4 + 8 * hi)) = w1; }
            if (hi == 0) LL[(g - 1) * 512 + x] = R.lse;
        }
        __syncthreads();
#pragma unroll 1
        for (int k = 0; k < 2; ++k) { const int wu = w + 8 * k, p0 = tok0 + 32 * wu, x = 32 * wu + r32;
            const P3Out R = p3_wave_unit(QA, KA, VTA, 0, h, p0, lane);
            const float l0 = R.lse, l1 = LL[x], l2 = LL[512 + x], m = fmaxf(l0, fmaxf(l1, l2));
            float w0f = __expf(l0 - m), w1f = __expf(l1 - m), w2f = __expf(l2 - m); const float iw = 1.0f / (w0f + w1f + w2f); w0f *= iw; w1f *= iw; w2f *= iw;
#pragma unroll
            for (int i4 = 0; i4 < 4; ++i4)
#pragma unroll
                for (int db = 0; db < 2; ++db) { const unsigned off = p3_swz(x, 64 * db + 16 * i4 + 8 * hi);
                    const u32x2v a1 = *(const LAS u32x2v*)(OL + off), a2 = *(const LAS u32x2v*)(OL + 65536 + off);
                    const f32x16& Og = db == 0 ? R.O0 : R.O1; u32x2v o;
                    o.x = pkbf(Og[4 * i4] * w0f + bflo(a1.x) * w1f + bflo(a2.x) * w2f, Og[4 * i4 + 1] * w0f + bfhi(a1.x) * w1f + bfhi(a2.x) * w2f);
                    o.y = pkbf(Og[4 * i4 + 2] * w0f + bflo(a1.y) * w1f + bflo(a2.y) * w2f, Og[4 * i4 + 3] * w0f + bfhi(a1.y) * w1f + bfhi(a2.y) * w2f);
                    *(LAS u32x2v*)(OL + off) = o; }
            LDS_WAIT(); asm volatile("" ::: "memory");
#pragma unroll
            for (int s4 = 0; s4 < 4; ++s4) { const int q = 8 * s4 + (lane >> 3), xr = 32 * wu + q; const v4u o = *(const LAS v4u*)(OL + p3_swz(xr, 16 * (lane & 7)));
                *(GAS v4u*)(O + (size_t)(tok0 + xr) * 1024 + h * 64 + 8 * (lane & 7)) = o; }
        }
        __syncthreads();
    }
}
__device__ __forceinline__ void p6a(Frame& F, const Args& args, int layer, const float* xin) {
    unsigned char* const wsl = opaque_ptr(F.ws);
    const int lane = lane_id(); const int w = F.wave;
    const int tokb = blockIdx.x * 64, b = tokb >> 11;
    const float* MOD = (const float*)(wsl + WS_MOD);
    const float* m0 = MOD + (size_t)((layer * 2 + 0) * 8 + b) * 3072; const float* m1 = MOD + (size_t)((layer * 2 + 1) * 8 + b) * 3072;
    const bf16* Y = (const bf16*)(wsl + WS_Y); bf16* XA = (bf16*)(wsl + WS_XA); unsigned char* H2N8 = wsl + WS_H1;
    const bf16* WH = (const bf16*)(wsl + WS_WRT) + (size_t)layer * 32 * 1024; const bf16* WL = WH + 65536;
    const float* br = args.in[IN_BROUTER] + layer * 32;
    LAS int* SEL = (LAS int*)(F.lds + T_SEL); LAS float* GTE = (LAS float*)(F.lds + T_GTE); LAS int* RNK = (LAS int*)(F.lds + T_RNK); LAS float* LG = (LAS float*)(F.lds + T_LG);
    for (int rnd = 0; rnd < 2; ++rnd) {
        SEC_BEGIN(1);
#pragma unroll
        for (int tt = 0; tt < 4; ++tt) { const int row = w * 4 + tt, rl = rnd * 32 + row, t = tokb + rl;
            f32x4 y[4], x[4]; float ss = 0.f;
#pragma unroll
            for (int j = 0; j < 4; ++j) { const u32x2v yy = *(const GAS u32x2v*)(Y + (size_t)t * D + 4 * lane + 256 * j); y[j] = (f32x4){bflo(yy.x), bfhi(yy.x), bflo(yy.y), bfhi(yy.y)};
                if (layer == 0) x[j] = *(const GAS f32x4*)(xin + (size_t)t * D + 4 * lane + 256 * j);
                else { const u32x2v xx = *(const GAS u32x2v*)((const bf16*)xin + (size_t)t * D + 4 * lane + 256 * j); x[j] = (f32x4){bflo(xx.x), bfhi(xx.x), bflo(xx.y), bfhi(xx.y)}; }
                ss += dot4(y[j], y[j]); }
            const float rstd1 = rsqrtf(wave_sum(ss) * (1.f / D) + NORM_EPS);
            float ss2 = 0.f;
#pragma unroll
            for (int j = 0; j < 4; ++j) { const int c = 4 * lane + 256 * j; const f32x4 A1 = *(const f32x4*)(m0 + 2048 + c) * *(const f32x4*)(args.in[IN_GPOSTMIX] + layer * 1024 + c);
                x[j] = x[j] + A1 * (y[j] * rstd1); { u32x2v px; px.x = pkbf(x[j][0], x[j][1]); px.y = pkbf(x[j][2], x[j][3]); *(GAS u32x2v*)(XA + (size_t)t * D + c) = px; } ss2 += dot4(x[j], x[j]); }
            const float rstd2 = rsqrtf(wave_sum(ss2) * (1.f / D) + NORM_EPS);
#pragma unroll
            for (int j = 0; j < 4; ++j) { const int c = 4 * lane + 256 * j; const f32x4 A2 = *(const f32x4*)(args.in[IN_GPREFFN] + layer * 1024 + c) * (*(const f32x4*)(m1 + 1024 + c) + 1.0f), S2 = *(const f32x4*)(m1 + c);
                const f32x4 hh = x[j] * rstd2 * A2 + S2; u32x2v ph, pl; ph.x = pkbf(hh[0], hh[1]); ph.y = pkbf(hh[2], hh[3]);
                pl.x = pkbf(hh[0] - bflo(ph.x), hh[1] - bfhi(ph.x)); pl.y = pkbf(hh[2] - bflo(ph.y), hh[3] - bfhi(ph.y));
                *(GAS unsigned*)(H2N8 + (size_t)t * D + c) = pk4_fp8(hh[0], hh[1], hh[2], hh[3]);
                *(LAS u32x2v*)(F.lds + row * RT_PITCH + c * 2) = ph; *(LAS u32x2v*)(F.lds + RT_LO + row * RT_PITCH + c * 2) = pl; }
        }
        __syncthreads();
        SEC_END(1); SEC_BEGIN(2);
        {
            const int th = w & 1, eh = (w >> 1) & 1, kh = w >> 2, l16 = lane & 15, kg = lane >> 4;
            const LAS unsigned char* ah = F.lds + (16 * th + l16) * RT_PITCH + kg * 16 + kh * 1024; const LAS unsigned char* al = ah + RT_LO;
            const bf16* bh = WH + (size_t)(16 * eh + l16) * 1024 + kg * 8 + kh * 512; const bf16* bl = WL + (size_t)(16 * eh + l16) * 1024 + kg * 8 + kh * 512;
            bf16x8 b_h[16], b_l[16];
#pragma unroll
            for (int ks = 0; ks < 16; ++ks) { b_h[ks] = *(const GAS bf16x8*)(bh + ks * 32); b_l[ks] = *(const GAS bf16x8*)(bl + ks * 32); }
            f32x4 acc = {0.f, 0.f, 0.f, 0.f};
#pragma unroll
            for (int ks = 0; ks < 16; ++ks) { const bf16x8 a_h = *(const LAS bf16x8*)(ah + ks * 64), a_l = *(const LAS bf16x8*)(al + ks * 64);
                acc = __builtin_amdgcn_mfma_f32_16x16x32_bf16(a_l, b_h[ks], acc, 0, 0, 0); acc = __builtin_amdgcn_mfma_f32_16x16x32_bf16(a_h, b_l[ks], acc, 0, 0, 0); acc = __builtin_amdgcn_mfma_f32_16x16x32_bf16(a_h, b_h[ks], acc, 0, 0, 0); }
            LAS float* lgp = kh == 0 ? LG : (LAS float*)(F.lds + T_LG2);
#pragma unroll
            for (int i = 0; i < 4; ++i) lgp[(16 * th + 4 * kg + i) * 32 + 16 * eh + l16] = acc[i];
        }
        __syncthreads();
        SEC_END(2); SEC_BEGIN(3);
        { const int l16 = lane & 15, row = w * 4 + (lane >> 4);
            const LAS float* LG2 = (const LAS float*)(F.lds + T_LG2);
            float v0 = (LG[row * 32 + l16] + LG2[row * 32 + l16]) + br[l16], v1 = (LG[row * 32 + 16 + l16] + LG2[row * 32 + 16 + l16]) + br[16 + l16]; const int i0 = l16, i1 = l16 + 16;
            float selv[4]; int seli[4];
#pragma unroll
            for (int kk = 0; kk < 4; ++kk) { float bv = v0; int bi = i0; if (v1 > bv) { bv = v1; bi = i1; }
#pragma unroll
                for (int off = 8; off > 0; off >>= 1) { const float ov = __shfl_xor(bv, off); const int oi = __shfl_xor(bi, off); if (ov > bv || (ov == bv && oi < bi)) { bv = ov; bi = oi; } }
                selv[kk] = bv; seli[kk] = bi; if (bi == i0) v0 = -INFINITY; if (bi == i1) v1 = -INFINITY; }
            const float p1 = __expf(selv[1] - selv[0]), p2 = __expf(selv[2] - selv[0]), p3 = __expf(selv[3] - selv[0]), ip = 1.0f / (1.0f + p1 + p2 + p3);
            if (l16 == 0) { const int rl = rnd * 32 + row;
                SEL[rl * 4 + 0] = seli[0]; SEL[rl * 4 + 1] = seli[1]; SEL[rl * 4 + 2] = seli[2]; SEL[rl * 4 + 3] = seli[3];
                GTE[rl * 4 + 0] = ip; GTE[rl * 4 + 1] = p1 * ip; GTE[rl * 4 + 2] = p2 * ip; GTE[rl * 4 + 3] = p3 * ip; }
        }
        SEC_END(3);
    }
    SEC_BEGIN(4);
    __syncthreads();
    if (w == 0) {
        const int s0 = SEL[lane * 4 + 0], s1 = SEL[lane * 4 + 1], s2 = SEL[lane * 4 + 2], s3 = SEL[lane * 4 + 3];
        int r0 = 0, r1 = 0, r2 = 0, r3 = 0, cnt = 0;
        const unsigned long long below = (1ull << lane) - 1ull;
        for (int e = 0; e < 32; ++e) { const bool has = (s0 == e) | (s1 == e) | (s2 == e) | (s3 == e); const unsigned long long mk = __ballot(has); const int rk = __popcll(mk & below);
            if (s0 == e) r0 = rk; if (s1 == e) r1 = rk; if (s2 == e) r2 = rk; if (s3 == e) r3 = rk; if (lane == e) cnt = __popcll(mk); }
        RNK[lane * 4 + 0] = r0; RNK[lane * 4 + 1] = r1; RNK[lane * 4 + 2] = r2; RNK[lane * 4 + 3] = r3;
        if (lane < 32) ((int*)(wsl + WS_HIST))[blockIdx.x * 32 + lane] = cnt;
    }
    SEC_END(4);
}
__device__ __forceinline__ void moe_tile_table(Frame& F, const int* tot  ) {
    if (F.wave == 0) { const int lane = lane_id(); LAS unsigned char* TEXP = (LAS unsigned char*)(F.lds + T_TEXP);
        const int nt = lane < 32 ? ((tot[lane & 31] + 255) >> 8) : 0; int inc = nt;
#pragma unroll
        for (int o = 1; o < 32; o <<= 1) { const int v = __shfl_up(inc, o); if ((lane & 31) >= o) inc += v; }
        const int first = inc - nt;
        for (int q = 0; q < nt; ++q) TEXP[first + q] = (unsigned char)lane;
        if (lane == 31) *(LAS int*)(F.lds + T_MT) = inc; }
}
__device__ __forceinline__ void p6b(Frame& F) {
    unsigned char* const wsl = opaque_ptr(F.ws);
    const int lane = lane_id(); const int w = F.wave, tokb = blockIdx.x * 64;
    LAS int* SEL = (LAS int*)(F.lds + T_SEL); LAS float* GTE = (LAS float*)(F.lds + T_GTE); LAS int* RNK = (LAS int*)(F.lds + T_RNK);
    LAS int* TOT = (LAS int*)(F.lds + T_TOT); LAS int* BEF = (LAS int*)(F.lds + T_BEF); LAS int* MYOFF = (LAS int*)(F.lds + T_MYOFF);
    const int* HIST = (const int*)(wsl + WS_HIST);
    const int tid = F.wave * 64 + lane;
    SEC_BEGIN(5);
    {
        LAS int* PT = (LAS int*)(F.lds + 65536); LAS int* PB = PT + 512;
        const int e = tid & 31, part = tid >> 5; int c[16];
#pragma unroll
        for (int k = 0; k < 16; ++k) c[k] = HIST[(part * 16 + k) * 32 + e];
        int tot = 0, bef = 0;
#pragma unroll
        for (int k = 0; k < 16; ++k) { tot += c[k]; bef += (part * 16 + k < (int)blockIdx.x) ? c[k] : 0; }
        PT[part * 32 + e] = tot; PB[part * 32 + e] = bef;
        __syncthreads();
        if (tid < 32) { int t2 = 0, b2 = 0;
#pragma unroll
            for (int k = 0; k < 16; ++k) { t2 += PT[k * 32 + tid]; b2 += PB[k * 32 + tid]; }
            TOT[tid] = t2; BEF[tid] = b2; if (blockIdx.x == 0) ((int*)(wsl + WS_TOT))[tid] = t2; }
    }
    __syncthreads();
    if (w == 0) { const int nt = lane < 32 ? ((TOT[lane & 31] + 255) >> 8) : 0; int inc = nt;
#pragma unroll
        for (int o = 1; o < 32; o <<= 1) { const int v = __shfl_up(inc, o); if ((lane & 31) >= o) inc += v; }
        if (lane < 32) MYOFF[lane] = (inc - nt) * 256 + BEF[lane];
        LAS unsigned char* TEXP = (LAS unsigned char*)(F.lds + T_TEXP); const int first = inc - nt;
        for (int q = 0; q < nt; ++q) TEXP[first + q] = (unsigned char)lane;
        if (lane == 31) *(LAS int*)(F.lds + T_MT) = inc; }
    __syncthreads();
    unsigned char* XS = wsl + WS_XS; float* GS = (float*)(wsl + WS_GSORT); int* POSOF = (int*)(wsl + WS_POSOF);
    const unsigned char* H2N8 = wsl + WS_H1;
    SEC_END(5); SEC_BEGIN(6);
    v4u o8[8];
#pragma unroll
    for (int i = 0; i < 8; ++i) o8[i] = *((const GAS v4u*)(H2N8 + (size_t)(tokb + w * 8 + i) * 1024) + lane);
#pragma unroll
    for (int i = 0; i < 8; ++i) { const int rl = w * 8 + i;
#pragma unroll
        for (int k = 0; k < 4; ++k) { const int e = SEL[rl * 4 + k]; const int pos = MYOFF[e] + RNK[rl * 4 + k];
            *((GAS v4u*)(XS + (size_t)pos * 1024) + lane) = o8[i];
            if (lane == 0) { GS[pos] = GTE[rl * 4 + k]; POSOF[(tokb + rl) * 4 + k] = pos; } }
    }
    asm volatile("s_waitcnt vmcnt(0)" ::: "memory");
    SEC_END(6);
}
__device__ __forceinline__ void p9_post(Frame& F, const Args& args, int layer) {
    unsigned char* const wsl = opaque_ptr(F.ws);
    const int lane = lane_id(); const int gw = blockIdx.x * NWAVES + F.wave, NGW = F.G * NWAVES;
    const bool last = layer == 1;
    const float* MOD = (const float*)(wsl + WS_MOD);
    const unsigned char* OUTS = wsl + WS_OUTS; const int* POSOF = (const int*)(wsl + WS_POSOF); bf16* XA = (bf16*)(wsl + WS_XA); bf16* H0 = (bf16*)(wsl + WS_H0);
    for (int t0 = gw * 8; t0 < T; t0 += NGW * 8) {
        const int b = t0 >> 11;
        const float* m1 = MOD + (size_t)((layer * 2 + 1) * 8 + b) * 3072; const float* mn = MOD + (size_t)((1 * 2 + 0) * 8 + b) * 3072;
        f32x4 A3[4], A4[4], S4[4];
#pragma unroll
        for (int j = 0; j < 4; ++j) { const int c = 4 * lane + 256 * j;
            A3[j] = *(const f32x4*)(m1 + 2048 + c) * *(const f32x4*)(args.in[IN_GPOSTFFN] + layer * 1024 + c);
            A4[j] = *(const f32x4*)(args.in[IN_GPREMIX] + 1024 + c) * (*(const f32x4*)(mn + 1024 + c) + 1.0f); S4[j] = *(const f32x4*)(mn + c); }
        const int posv = POSOF[t0 * 4 + (lane & 31)];
        for (int i0 = 0; i0 < 8; i0 += 2) {
            unsigned q[2][4][4]; u32x2v xr[2][4];
#pragma unroll
            for (int u = 0; u < 2; ++u) { const int t = t0 + i0 + u;
#pragma unroll
                for (int k = 0; k < 4; ++k) { const int p = __builtin_amdgcn_readlane(posv, (i0 + u) * 4 + k);
#pragma unroll
                    for (int j = 0; j < 4; ++j) q[u][k][j] = *(const GAS unsigned*)(OUTS + (size_t)p * 1024 + 4 * lane + 256 * j); }
#pragma unroll
                for (int j = 0; j < 4; ++j) xr[u][j] = *(const GAS u32x2v*)(XA + (size_t)t * D + 4 * lane + 256 * j); }
#pragma unroll
            for (int u = 0; u < 2; ++u) { const int t = t0 + i0 + u;
                f32x4 y[4]; float ss = 0.f;
#pragma unroll
                for (int j = 0; j < 4; ++j) { const unsigned a = q[u][0][j], bq = q[u][1][j], cq = q[u][2][j], dq = q[u][3][j];
                    const f32x2v al = __builtin_amdgcn_cvt_pk_f32_fp8(a, false), ah = __builtin_amdgcn_cvt_pk_f32_fp8(a, true), bl = __builtin_amdgcn_cvt_pk_f32_fp8(bq, false), bh = __builtin_amdgcn_cvt_pk_f32_fp8(bq, true);
                    const f32x2v cl = __builtin_amdgcn_cvt_pk_f32_fp8(cq, false), ch = __builtin_amdgcn_cvt_pk_f32_fp8(cq, true), dl = __builtin_amdgcn_cvt_pk_f32_fp8(dq, false), dh = __builtin_amdgcn_cvt_pk_f32_fp8(dq, true);
                    y[j] = (f32x4){((al[0] + bl[0]) + cl[0]) + dl[0], ((al[1] + bl[1]) + cl[1]) + dl[1], ((ah[0] + bh[0]) + ch[0]) + dh[0], ((ah[1] + bh[1]) + ch[1]) + dh[1]} * (1.0f / OUTS_SCALE);
                    ss += dot4(y[j], y[j]); }
                const float rstd = rsqrtf(wave_sum(ss) * (1.f / D) + NORM_EPS);
                f32x4 x[4]; float ss2 = 0.f;
#pragma unroll
                for (int j = 0; j < 4; ++j) { const u32x2v xx = xr[u][j]; x[j] = (f32x4){bflo(xx.x), bfhi(xx.x), bflo(xx.y), bfhi(xx.y)} + A3[j] * (y[j] * rstd); ss2 += dot4(x[j], x[j]); }
                if (last) {
#pragma unroll
                    for (int j = 0; j < 4; ++j) *(GAS f32x4*)(F.out + (size_t)t * D + 4 * lane + 256 * j) = x[j];
                } else {
                    const float rstd2 = rsqrtf(wave_sum(ss2) * (1.f / D) + NORM_EPS);
#pragma unroll
                    for (int j = 0; j < 4; ++j) { const int c = 4 * lane + 256 * j; { u32x2v px; px.x = pkbf(x[j][0], x[j][1]); px.y = pkbf(x[j][2], x[j][3]); *(GAS u32x2v*)(XA + (size_t)t * D + c) = px; }
                        const f32x4 hh = x[j] * rstd2 * A4[j] + S4[j]; u32x2v pw; pw.x = pkbf(hh[0], hh[1]); pw.y = pkbf(hh[2], hh[3]); *(GAS u32x2v*)(H0 + (size_t)t * D + c) = pw; }
                }
            }
        }
    }
}
constexpr int N_PHASES = 19;
#define COMMON_PHASES(layer, pb) \
    const int P_OUT = pb + 3, P_T1 = pb + 4, P_T2 = pb + 5, P_UP = pb + 6, P_DN = pb + 7, P_POST = pb + 8; \
    if (IN(P_OUT)) for (int rep_ = 0; rep_ < 1 + DUPF(P_OUT); ++rep_) { if (rep_) __syncthreads(); \
        SchedPlain S; S.go.init(64, 4, F.G, (int)blockIdx.x); S.A = (const char*)(ws + WS_O); S.B = (const char*)(ws + (layer == 0 ? WS_WOUTA : WS_WOUTB)); \
        EpiPlain E{(bf16*)(ws + WS_Y), 1024}; \
        pg8::gemm_phase<EpiPlain, SchedPlain, true, true>(F.lds, (const char*)ws, 1024, S, E, F.wave); \
    } SEAM(P_OUT); \
    if (IN(P_T1)) for (int rep_ = 0; rep_ < 1 + DUPF(P_T1); ++rep_) { if (rep_) __syncthreads(); p6a(F, args, layer, layer == 0 ? args.in[IN_X] : (const float*)(ws + WS_XA)); } SEAM(P_T1); \
    if (IN(P_T2)) for (int rep_ = 0; rep_ < 1 + DUPF(P_T2); ++rep_) { if (rep_) __syncthreads(); p6b(F); } SEAM(P_T2); \
    if (IN(P_UP)) for (int rep_ = 0; rep_ < 1 + DUPF(P_UP); ++rep_) { if (rep_) __syncthreads(); \
        SchedMoe S; S.go.init(*(LAS int*)(F.lds + T_MT), 8, F.G, (int)blockIdx.x); S.A = (const char*)(ws + WS_XS); S.W = (const char*)(ws + WS_WUP) + (size_t)layer * 32 * 2048 * 1024; S.wstride = (size_t)2048 * 1024; \
        S.texp = (const LAS unsigned char*)(F.lds + T_TEXP); \
        EpiSwiglu E{ws + WS_ACT, args.in[IN_BUP] + (size_t)layer * 32 * 2048}; \
        pg8::gemm_phase<EpiSwiglu, SchedMoe, true, true, true>(F.lds, (const char*)ws, 512, S, E, F.wave); \
    } SEAM(P_UP); \
    if (IN(P_DN)) for (int rep_ = 0; rep_ < 1 + DUPF(P_DN); ++rep_) { if (rep_) __syncthreads(); \
        SchedMoe S; S.go.init(*(LAS int*)(F.lds + T_MT), 4, F.G, (int)blockIdx.x); S.A = (const char*)(ws + WS_ACT); S.W = (const char*)(ws + WS_WDOWN) + (size_t)layer * 32 * 1024 * 1024; S.wstride = (size_t)1024 * 1024; \
        S.texp = (const LAS unsigned char*)(F.lds + T_TEXP); \
        EpiDown E{ws + WS_OUTS, args.in[IN_BDOWN] + (size_t)layer * 32 * 1024, (const float*)(ws + WS_GSORT)}; \
        pg8::gemm_phase<EpiDown, SchedMoe, true, true, true>(F.lds, (const char*)ws, 512, S, E, F.wave); \
    } SEAM(P_DN); \
    if (IN(P_POST)) for (int rep_ = 0; rep_ < 1 + (DUPF(10) && layer == 1); ++rep_) { if (rep_) __syncthreads(); p9_post(F, args, layer); }
__global__ void __launch_bounds__(NWAVES * 64, 2) mega_fwd(Args args) {
    extern __shared__ __attribute__((aligned(16))) unsigned char lds[];
    Frame F;
    F.lds = (LAS unsigned char*)lds;
    F.MISC = (volatile LAS unsigned*)(F.lds + MISC_OFF);
    F.wave = __builtin_amdgcn_readfirstlane((int)threadIdx.x >> 6);
    F.G = gridDim.x; { const int bx = blockIdx.x; F.vcu = (bx % 8) * (F.G / 8) + bx / 8; }
    F.out = args.out; F.ws = args.ws; F.ctl = (gu32*)(args.ws + WS_CTL);
    for (int u = threadIdx.x; u < (LDS_BYTES - LDSCTL_OFF) / 4; u += NWAVES * 64) ((LAS unsigned*)(F.lds + LDSCTL_OFF))[u] = 0u;
    __syncthreads();
    XcdBarrier bar = xcd_barrier_post((unsigned*)(F.ctl + CW_BAR) + args.li * XCD_BAR_WORDS, F.MISC + 8);
    const int lo = args.ph_lo, hi = args.ph_hi;
#ifndef DUP_MASK
#define DUP_MASK 0u
#endif
#define DUPF(k) ((int)((DUP_MASK >> (k)) & 1u))
#ifndef PHMASK
#define PHMASK 0xFFFFFFFFu
#endif
#define IN(k) (((PHMASK >> ((k) > 10 ? (k) - 8 : (k))) & 1u) && lo <= (k) && (k) < hi)
#define SEAM(k) do { if (IN(k) && IN((k) + 1)) { xcd_barrier(bar); if (DUPF(20)) xcd_barrier(bar); } } while (0)

    if (IN(0)) for (int rep_ = 0; rep_ < 1 + DUPF(0); ++rep_) { if (rep_) __syncthreads(); p0_prologue(F, args); } SEAM(0);
    if (IN(1)) for (int rep_ = 0; rep_ < 1 + DUPF(1); ++rep_) { if (rep_) __syncthreads(); p1_prenorm0(F, args); } SEAM(1);

    { unsigned char* ws = opaque_ptr(args.ws);
        if (IN(2)) for (int rep_ = 0; rep_ < 1 + DUPF(2); ++rep_) { if (rep_) __syncthreads();
            { SchedInaQK S; S.go.init(64, 24, F.G, (int)blockIdx.x); S.h0 = (const char*)(ws + WS_H0); S.w = (const char*)(ws + WS_WINA_QK);
              EpiRopeA E{(bf16*)(ws + WS_QA), (bf16*)(ws + WS_KA)};
              pg8::gemm_phase<EpiRopeA, SchedInaQK, true, true, true>(F.lds, (const char*)ws, 512, S, E, F.wave); }
            { SchedInaV S; S.go.init(12, 64, F.G, (int)blockIdx.x); S.h0 = (const char*)(ws + WS_H0); S.w = (const char*)(ws + WS_WINA_V);
              EpiVt E{(bf16*)(ws + WS_VTA)};
              pg8::gemm_phase<EpiVt, SchedInaV, true, true, true>(F.lds, (const char*)ws, 512, S, E, F.wave); }
        } SEAM(2);
        if (IN(3)) for (int rep_ = 0; rep_ < 1 + DUPF(3); ++rep_) { if (rep_) __syncthreads(); p3_attn_a(F); } do { if (IN(3) && IN(5)) xcd_barrier(bar); } while (0);
    }
    { unsigned char* ws = opaque_ptr(args.ws); COMMON_PHASES(0, 2) }
    SEAM(10);
    { unsigned char* ws = opaque_ptr(args.ws);
        if (IN(11)) for (int rep_ = 0; rep_ < 1 + DUPF(11); ++rep_) { if (rep_) __syncthreads();
            SchedPlain S; S.go.init(64, 6, F.G, (int)blockIdx.x); S.A = (const char*)(ws + WS_H0); S.B = (const char*)(ws + WS_WINB);
            EpiInB E{(bf16*)(ws + WS_QB), (bf16*)(ws + WS_KB), (bf16*)(ws + WS_VB), args.in[IN_GQB], args.in[IN_GKB]};
            pg8::gemm_phase<EpiInB, SchedPlain, true, true>(F.lds, (const char*)ws, 1024, S, E, F.wave);
        } SEAM(11);
        if (IN(12)) for (int rep_ = 0; rep_ < 1 + DUPF(12); ++rep_) { if (rep_) __syncthreads();
            const int xcd = F.vcu >> 5, j = F.vcu & 31;
            for (int i = 0; i < 4; ++i) { const int pair = xcd * 4 + i, b = pair >> 2, kvh = pair & 3, hq = kvh * 4 + (j >> 3), qb = j & 7;
                attn_body::attn_unit<8>(b, hq, kvh, qb, (const attn_body::bf16*)(ws + WS_QB), (const attn_body::bf16*)(ws + WS_KB), (const attn_body::bf16*)(ws + WS_VB), (attn_body::bf16*)(ws + WS_O), (char*)lds, F.wave); }
        } SEAM(12);
    }
    { unsigned char* ws = opaque_ptr(args.ws); COMMON_PHASES(1, 10) }
    if (PSEC > 0) { __syncthreads(); const unsigned long long te_ = __builtin_amdgcn_s_memrealtime(); const unsigned dd_ = F.MISC[16]; while (__builtin_amdgcn_s_memrealtime() - te_ < dd_) __builtin_amdgcn_s_sleep(8); }
#undef IN
#undef SEAM
#undef COMMON_PHASES
}
static int g_grid = 0;
static bool mega_setup() {
    if (g_grid == 0) {
        int dev = 0, cus = 0;
        if (hipGetDevice(&dev) != hipSuccess || hipDeviceGetAttribute(&cus, hipDeviceAttributeMultiprocessorCount, dev) != hipSuccess) { g_grid = -1; return false; }
        if (hipFuncSetAttribute((const void*)mega_fwd, hipFuncAttributeMaxDynamicSharedMemorySize, LDS_BYTES) != hipSuccess) { fprintf(stderr, "hipFuncSetAttribute failed\n"); g_grid = -1; return false; }
        int per_cu = 0;
        if (hipOccupancyMaxActiveBlocksPerMultiprocessor(&per_cu, (const void*)mega_fwd, NWAVES * 64, LDS_BYTES) != hipSuccess || per_cu < 1) { fprintf(stderr, "occupancy query: %d\n", per_cu); }
        (void)hipGetLastError();
        if (cus != 256) { fprintf(stderr, "built for 256 CUs, found %d\n", cus); g_grid = -1; return false; }
        g_grid = 256;
    }
    return g_grid > 0;
}
static void mega_launch(void* const* d_in, float* out, unsigned char* ws, int lo, int hi, int li, hipStream_t stream) {
    Args a{};
    for (int i = 0; i < 20; ++i) a.in[i] = (const float*)d_in[i];
    a.out = out; a.ws = ws; a.ph_lo = lo; a.ph_hi = hi; a.li = li; a.pad = 0;
    hipLaunchKernelGGL(mega_fwd, dim3(g_grid), dim3(NWAVES * 64), LDS_BYTES, stream, a);
}
extern "C" void kernel_launch(void* const* d_in, const int* in_sizes, int n_in, void* d_out, int out_size, void* d_ws, size_t ws_size, hipStream_t stream) {
    if (n_in != 20 || ws_size < WS_END || out_size != T * D) { fprintf(stderr, "kernel_launch: unexpected n_in %d / ws %zu / out %d\n", n_in, ws_size, out_size); return; }
    if (!mega_setup()) return;
    unsigned char* ws = (unsigned char*)d_ws;
    (void)hipMemsetAsync(ws + WS_CTL, 0, CTL_ZERO_BYTES, stream);
    mega_launch(d_in, (float*)d_out, ws, 0, N_PHASES, 0, stream);
}
```

```cpp
#include <hip/hip_runtime.h>
#include <cstdio>
#include <cstdint>
#include <cmath>
#define GAS __attribute__((address_space(1)))
#define LAS __attribute__((address_space(3)))
typedef unsigned short bf16;
typedef unsigned v4u __attribute__((ext_vector_type(4)));
typedef float f32x4 __attribute__((ext_vector_type(4)));
typedef short bf16x8 __attribute__((ext_vector_type(8)));
typedef GAS unsigned gu32;
typedef GAS unsigned long long gu64;
#define RLX_AGENT __ATOMIC_RELAXED, __HIP_MEMORY_SCOPE_AGENT
#define LDS_WAIT() asm volatile("s_waitcnt lgkmcnt(0)" ::: "memory")
#define VM_WAIT() asm volatile("s_waitcnt vmcnt(0)" ::: "memory")
__device__ __forceinline__ unsigned long long rt() { return __builtin_amdgcn_s_memrealtime(); }
__device__ __forceinline__ unsigned f2bf(float f) { unsigned u = __builtin_bit_cast(unsigned, f); return (u + 0x7fffu + ((u >> 16) & 1u)) >> 16; }
__device__ __forceinline__ unsigned pk2(float lo, float hi) { return f2bf(lo) | (f2bf(hi) << 16); }

#define XB_TMO      128
#define XB_XCNT(j)  (256  + 64 * (j))
#define XB_XSUB(j)  (1280 + 64 * (j))
#define XB_XGEN(j)  (2304 + 64 * (j))
#define XB_TOP      3328
#define XB_TOPGEN   3392
#define XCD_BAR_WORDS 3456
#define XB_SPIN_CAP (1u << 18)

__device__ __forceinline__ unsigned xb_ld(unsigned* p)              { return __hip_atomic_load(p, __ATOMIC_RELAXED, __HIP_MEMORY_SCOPE_AGENT); }
__device__ __forceinline__ unsigned xb_add(unsigned* p, unsigned v) { return __hip_atomic_fetch_add(p, v, __ATOMIC_RELAXED, __HIP_MEMORY_SCOPE_AGENT); }
__device__ __forceinline__ unsigned xb_xcc_id() { return (unsigned)__builtin_amdgcn_s_getreg((3 << 11) | 20) & 0xFu; }
#define XB_SPIN(cond, bar) do { unsigned _sp = 0; while (cond) { __builtin_amdgcn_s_sleep(1); \
    if ((++_sp & 255u) == 0u) { if (xb_ld(&(bar)[XB_TMO])) break; if (_sp > XB_SPIN_CAP) { atomicAdd(&(bar)[XB_TMO], 1u); break; } } } } while (0)

struct XcdBarrier {
    unsigned* bar; unsigned x;
    volatile LAS unsigned* st;
};

__device__ __forceinline__ XcdBarrier xcd_barrier_post(unsigned* bar, volatile LAS unsigned* st) {
    XcdBarrier b; b.bar = bar; b.x = xb_xcc_id(); b.st = st;
    if (threadIdx.x == 0) (void)xb_add(&bar[XB_XCNT(b.x)], 1u);
    return b;
}
__device__ __forceinline__ void xcd_barrier_complete(unsigned* bar, unsigned x, unsigned& nloc, unsigned& nx) {
    const unsigned G = gridDim.x * gridDim.y * gridDim.z;
    unsigned sum, cnt, mine, sp = 0u;
    for (;;) {
        sum = 0u; cnt = 0u; mine = 0u;
#pragma unroll
        for (unsigned j = 0; j < 16; ++j) { const unsigned c = xb_ld(&bar[XB_XCNT(j)]); sum += c; cnt += (c > 0u) ? 1u : 0u; mine = (j == x) ? c : mine; }
        if (sum == G) break;
        __builtin_amdgcn_s_sleep(1);
        if ((++sp & 255u) == 0u) { if (xb_ld(&bar[XB_TMO])) break; if (sp > XB_SPIN_CAP) { atomicAdd(&bar[XB_TMO], 1u); break; } }
    }
    nloc = mine > 0u ? mine : 1u; nx = cnt > 0u ? cnt : 1u;
}

__device__ __forceinline__ void xcd_barrier(const XcdBarrier& b) {
    asm volatile("s_waitcnt vmcnt(0)" ::: "memory");
    __syncthreads();
    if (threadIdx.x == 0) {
        unsigned* bar = b.bar;
        __builtin_amdgcn_s_waitcnt(0);
        unsigned nloc = b.st[0], nx = b.st[1];
        if (nloc == 0u) { xcd_barrier_complete(bar, b.x, nloc, nx); b.st[0] = nloc; b.st[1] = nx; }
        const unsigned old = xb_add(&bar[XB_XSUB(b.x)], 1u);
        const unsigned gen = old / nloc;
        if (old + 1u == (gen + 1u) * nloc) {
            __builtin_amdgcn_fence(__ATOMIC_RELEASE, "agent");
            asm volatile("s_waitcnt vmcnt(0)" ::: "memory");
            const unsigned og = xb_add(&bar[XB_TOP], 1u);
            const unsigned tg = og / nx;
            if (og + 1u == (tg + 1u) * nx) xb_add(&bar[XB_TOPGEN], 1u);
            else XB_SPIN(xb_ld(&bar[XB_TOPGEN]) == tg, bar);
            __builtin_amdgcn_fence(__ATOMIC_ACQUIRE, "agent");
            xb_add(&bar[XB_XGEN(b.x)], 1u);
            asm volatile("s_waitcnt vmcnt(0)" ::: "memory");
        } else {
            XB_SPIN(xb_ld(&bar[XB_XGEN(b.x)]) == gen, bar);
            __builtin_amdgcn_fence(__ATOMIC_ACQUIRE, "agent");
            asm volatile("s_waitcnt vmcnt(0)" ::: "memory");
        }
    }
    __syncthreads();
}
namespace pg8 {
#define PG8_LAS __attribute__((address_space(3)))
typedef unsigned short bf16_t;
typedef short bf16x8 __attribute__((ext_vector_type(8)));
typedef float f32x4 __attribute__((ext_vector_type(4)));
typedef unsigned u32x4 __attribute__((ext_vector_type(4)));
typedef int v4i_t __attribute__((ext_vector_type(4)));
typedef int v8i_t __attribute__((ext_vector_type(8)));
constexpr int BM = 256, BK = 64, HALF = 128, HTB = HALF * BK * 2  , STAGE_BYTES = 8 * HTB, NXCD = 8, WGM = 8;

__host__ __device__ __forceinline__ int lds_byte(int r, int c) { const int st = (r >> 4) * 2 + (c >> 5), rr = r & 15, cc = c & 31, ob = rr * 64 + cc * 2; return st * 1024 + (ob ^ (((ob >> 9) & 1) << 5)); }
__host__ __device__ __forceinline__ void stage_rc(int b, int& R, int& C) { const int st = b / 1024, sb = b % 1024, swz = sb ^ (((sb >> 9) & 1) << 5); R = (st >> 1) * 16 + swz / 64; C = (st & 1) * 32 + (swz % 64) / 2; }
__host__ __device__ __forceinline__ int perm32(int rho) { const int n = rho >> 4, i = rho & 15; return 8 * (i >> 2) + 4 * n + (i & 3); }

constexpr int GATHER_LDS = 147456;
typedef unsigned v4u_t __attribute__((ext_vector_type(4)));
struct Unit { const char* a; const char* b; int pm, pn, aux; };
typedef unsigned u32x2 __attribute__((ext_vector_type(2)));
__device__ __forceinline__ unsigned cvt_pk_bf16(float lo, float hi) { unsigned r; asm volatile("v_cvt_pk_bf16_f32 %0, %1, %2" : "=v"(r) : "v"(lo), "v"(hi)); return r; }
struct GridOrder {
    int nM, nN, nwg, G, c;
    __device__ __forceinline__ void init(int nM_, int nN_, int G_, int c_) { nM = nM_; nN = nN_; nwg = nM * nN; G = G_; c = c_; }
    __device__ __forceinline__ bool tile(int i, int& pm, int& pn) const {
        const int L = i * G + c; if (L >= nwg) return false;
        int wgid = L; { const int q = nwg / NXCD, r = nwg % NXCD, xcd = wgid % NXCD, off = wgid / NXCD; wgid = (xcd < r ? xcd * (q + 1) : r * (q + 1) + (xcd - r) * q) + off; }
        const int nig = WGM * nN, gid = wgid / nig, fm = gid * WGM, gsz = (nM - fm) < WGM ? (nM - fm) : WGM;
        pm = fm + ((wgid % nig) % gsz); pn = (wgid % nig) / gsz; return true;
    }
};

template <class Epi, class Sched, bool ALIGN_EPI = false, bool SP2 = false, bool F8 = false, bool GATHER = false>
__device__ __forceinline__ void gemm_phase(PG8_LAS unsigned char* lds, const char* rbase  , const int K, const Sched& S, const Epi& E, const int wid_in  ) {
    static_assert(!GATHER || SP2, "the gathered A tile is wired into the SP2 schedule only");
    int lane; asm volatile("v_mbcnt_lo_u32_b32 %0, -1, 0\n\tv_mbcnt_hi_u32_b32 %0, -1, %0" : "=v"(lane));
    const int wid = wid_in, tid = wid * 64 + lane, wr = wid >> 2, wc = wid & 3, fr = lane & 15, fq = lane >> 4;
    const int nt = K / BK;
    int sc_ab = 122 | (127 << 8); asm volatile("" : "+v"(sc_ab));
    const __amdgpu_buffer_rsrc_t rsrc = __builtin_amdgcn_make_buffer_rsrc((void*)rbase, 0, 0xffffffff, 0x00020000);
    unsigned voffA[2], voffB[2];
#pragma unroll
    for (int i = 0; i < 2; ++i) { int R, C; stage_rc(tid * 16 + i * 8192, R, C); const int Rb = Epi::PERM ? ((R & ~31) + perm32(R & 31)) : R;
        voffA[i] = (unsigned)(R * K + C) * 2u; voffB[i] = (unsigned)(Rb * K + C) * 2u; }
    const size_t kstep = (size_t)(BK * 2);
    const size_t hstep = (size_t)HALF * K * 2;
    const size_t hstepA = GATHER ? (size_t)0 : hstep;
    const unsigned ldsw = (unsigned)wid * 1024u;
    const int aoff = lds_byte(wr * 64 + fr, fq * 8), boff = lds_byte(wc * 32 + fr, fq * 8);
#define PG8_SA(b, h) (((b) * 2 + (h)) * HTB)
#define PG8_SB(b, h) ((4 + (b) * 2 + (h)) * HTB)
#define PG8_STAGE(bufoff, gbase, voff) do { const unsigned _so = (unsigned)((const char*)(gbase) - rbase); _Pragma("unroll") for (int _i = 0; _i < 2; ++_i) \
        __builtin_amdgcn_raw_ptr_buffer_load_lds(rsrc, (PG8_LAS unsigned*)(lds + (bufoff) + ldsw + _i * 8192), 16, (voff)[_i], _so, 0, 0); } while (0)
#define PG8_GSLOT(set_, h_) (lds + GATHER_LDS + (set_) * 8192 + tid * 16 + (h_) * 8)
#define PG8_GQ(q_, h_, nx_) u32x2 q_; if constexpr (GATHER) q_ = *(const PG8_LAS u32x2*)PG8_GSLOT((ui & 1) ^ ((nx_) ? 1 : 0), h_); else q_ = (u32x2){voffA[0], voffA[1]}
#define PG8_STAGE_Q(bufoff, gbase, q_) do { const unsigned _so = (unsigned)((const char*)(gbase) - rbase); \
        __builtin_amdgcn_raw_ptr_buffer_load_lds(rsrc, (PG8_LAS unsigned*)(lds + (bufoff) + ldsw), 16, (q_).x, _so, 0, 0); \
        __builtin_amdgcn_raw_ptr_buffer_load_lds(rsrc, (PG8_LAS unsigned*)(lds + (bufoff) + ldsw + 8192), 16, (q_).y, _so, 0, 0); } while (0)
#define PG8_GCALC(dst, pm_) do { int l2_; asm volatile("v_mbcnt_lo_u32_b32 %0, -1, 0\n\tv_mbcnt_hi_u32_b32 %0, -1, %0" : "=v"(l2_)); const int t2_ = wid * 64 + l2_;     \
        const __attribute__((address_space(1))) int* tk_ = (const __attribute__((address_space(1))) int*)S.tokof + (pm_) * 256; \
        _Pragma("unroll") for (int _h = 0; _h < 2; ++_h) _Pragma("unroll") for (int _i = 0; _i < 2; ++_i) { int R_, C_; stage_rc(t2_ * 16 + _i * 8192, R_, C_); \
        dst[_h * 2 + _i] = (unsigned)tk_[_h * 128 + R_] * (unsigned)(K * 2) + (unsigned)C_ * 2u; } } while (0)
#define PG8_LD8(p) __builtin_shufflevector(*(const PG8_LAS v4i_t*)(p), *(const PG8_LAS v4i_t*)((p) + 1024), 0, 1, 2, 3, 4, 5, 6, 7)
#define PG8_LDA(dst, b, h) do { if constexpr (F8) { _Pragma("unroll") for (int m = 0; m < 4; ++m) dst##8[m] = PG8_LD8(lds + PG8_SA(b, h) + aoff + m * 2048); } else { \
        _Pragma("unroll") for (int m = 0; m < 4; ++m) _Pragma("unroll") for (int k = 0; k < 2; ++k) dst[m][k] = *(const PG8_LAS bf16x8*)(lds + PG8_SA(b, h) + aoff + m * 2048 + k * 1024); } } while (0)
#define PG8_LDB(dst, b, h) do { if constexpr (F8) { _Pragma("unroll") for (int n = 0; n < 2; ++n) dst##8[n] = PG8_LD8(lds + PG8_SB(b, h) + boff + n * 2048); } else { \
        _Pragma("unroll") for (int n = 0; n < 2; ++n) _Pragma("unroll") for (int k = 0; k < 2; ++k) dst[n][k] = *(const PG8_LAS bf16x8*)(lds + PG8_SB(b, h) + boff + n * 2048 + k * 1024); } } while (0)
#define PG8_MMA(ai, bj, At, Bt) do { __builtin_amdgcn_s_setprio(1); if constexpr (F8) { _Pragma("unroll") for (int m = 0; m < 4; ++m) _Pragma("unroll") for (int n = 0; n < 2; ++n) \
        acc[ai][bj][m][n] = __builtin_amdgcn_mfma_scale_f32_16x16x128_f8f6f4(Bt##8[n], At##8[m], acc[ai][bj][m][n], 0, 0, 0, sc_ab, 1, sc_ab); } else { \
        _Pragma("unroll") for (int m = 0; m < 4; ++m) _Pragma("unroll") for (int n = 0; n < 2; ++n) _Pragma("unroll") for (int k = 0; k < 2; ++k) \
        acc[ai][bj][m][n] = __builtin_amdgcn_mfma_f32_16x16x32_bf16(Bt[n][k], At[m][k], acc[ai][bj][m][n], 0, 0, 0); } __builtin_amdgcn_s_setprio(0); } while (0)
#define PG8_WAIT_V(n) asm volatile("s_waitcnt vmcnt(" #n ")" ::: "memory")
#define PG8_WAIT_L(n) asm volatile("s_waitcnt lgkmcnt(" #n ")" ::: "memory")
#define PG8_BAR __builtin_amdgcn_s_barrier()
#define PG8_SCHED __builtin_amdgcn_sched_barrier(0)
    Unit cur, nxt; int ui = 0;
    if (!S.next(0, cur)) return;
    f32x4 acc[2][2][4][2];
#pragma unroll
    for (int a = 0; a < 2; ++a)
#pragma unroll
        for (int b = 0; b < 2; ++b)
#pragma unroll
            for (int m = 0; m < 4; ++m)
#pragma unroll
                for (int n = 0; n < 2; ++n) acc[a][b][m][n] = (f32x4){0.f, 0.f, 0.f, 0.f};
    bf16x8 At[4][2], B0[2][2], B1[2][2]; v8i_t At8[4], B08[2], B18[2];
    const char* cA = cur.a; const char* cB = cur.b;
    if constexpr (SP2) {
        u32x2 p0 = (u32x2){voffA[0], voffA[1]}, p1 = p0;
        if constexpr (GATHER) { v4u_t g4; PG8_GCALC(g4, cur.pm); *(PG8_LAS v4u_t*)PG8_GSLOT(0, 0) = g4; p0 = (u32x2){g4[0], g4[1]}; p1 = (u32x2){g4[2], g4[3]}; }
        PG8_STAGE(PG8_SB(0, 0), cB, voffB); PG8_STAGE(PG8_SB(0, 1), cB + hstep, voffB); PG8_STAGE_Q(PG8_SA(0, 0), cA, p0); PG8_STAGE_Q(PG8_SA(0, 1), cA + hstepA, p1);
        if (wr == 1) PG8_BAR;
        PG8_WAIT_V(2); PG8_BAR;
        PG8_STAGE(PG8_SB(1, 0), cB + kstep, voffB); PG8_STAGE_Q(PG8_SA(1, 0), cA + kstep, p0); PG8_STAGE(PG8_SB(1, 1), cB + hstep + kstep, voffB);
        PG8_WAIT_V(6); PG8_BAR;
    } else {
        PG8_STAGE(PG8_SB(0, 0), cB, voffB); PG8_STAGE(PG8_SA(0, 0), cA, voffA); PG8_STAGE(PG8_SB(0, 1), cB + hstep, voffB); PG8_STAGE(PG8_SA(0, 1), cA + hstep, voffA);
        if (wr == 1) PG8_BAR;
        PG8_WAIT_V(4); PG8_BAR;
        PG8_STAGE(PG8_SB(1, 0), cB + kstep, voffB); PG8_STAGE(PG8_SA(1, 0), cA + kstep, voffA); PG8_STAGE(PG8_SB(1, 1), cB + hstep + kstep, voffB);
        PG8_WAIT_V(6); PG8_BAR;
    }
    for (;;) {
        const bool has_next = S.next(ui + 1, nxt);
        if constexpr (GATHER) { v4u_t g4 = *(const PG8_LAS v4u_t*)PG8_GSLOT(ui & 1, 0); if (has_next) PG8_GCALC(g4, nxt.pm); *(PG8_LAS v4u_t*)PG8_GSLOT((ui & 1) ^ 1, 0) = g4; }
        const char* nA = has_next ? nxt.a : cA; const char* nB = has_next ? nxt.b : cB;
#pragma nounroll
        for (int t = 0; t < nt; t += 2) {
            const bool last = (t == nt - 2);
            const char* a1 = cA + (size_t)(t + 1) * kstep;
            const char* a2 = last ? nA : cA + (size_t)(t + 2) * kstep; const char* b2 = last ? nB : cB + (size_t)(t + 2) * kstep;
            const char* a3 = a2 + kstep; const char* b3 = b2 + kstep;
            if constexpr (SP2) {
            PG8_GQ(q1, 1, false); PG8_LDB(B0, 0, 0); PG8_LDB(B1, 0, 1); PG8_SCHED; PG8_LDA(At, 0, 0); PG8_STAGE_Q(PG8_SA(1, 1), a1 + hstepA, q1);
            PG8_WAIT_V(8); PG8_WAIT_L(0); PG8_BAR; PG8_MMA(0, 0, At, B0); PG8_MMA(0, 1, At, B1); PG8_BAR; PG8_SCHED;
            PG8_GQ(q2, 0, last); PG8_LDA(At, 0, 1); PG8_STAGE(PG8_SB(0, 0), b2, voffB); PG8_STAGE(PG8_SB(0, 1), b2 + hstep, voffB); PG8_STAGE_Q(PG8_SA(0, 0), a2, q2);
            PG8_WAIT_V(8); PG8_WAIT_L(0); PG8_BAR; PG8_MMA(1, 0, At, B0); PG8_MMA(1, 1, At, B1); PG8_BAR; PG8_SCHED;
            PG8_GQ(q3, 1, last); PG8_LDB(B0, 1, 0); PG8_LDB(B1, 1, 1); PG8_SCHED; PG8_LDA(At, 1, 0); PG8_STAGE_Q(PG8_SA(0, 1), a2 + hstepA, q3);
            PG8_WAIT_V(8); PG8_WAIT_L(0); PG8_BAR; PG8_MMA(0, 0, At, B0); PG8_MMA(0, 1, At, B1); PG8_BAR; PG8_SCHED;
            PG8_GQ(q4, 0, last); PG8_LDA(At, 1, 1); PG8_STAGE(PG8_SB(1, 0), b3, voffB); PG8_STAGE(PG8_SB(1, 1), b3 + hstep, voffB); PG8_STAGE_Q(PG8_SA(1, 0), a3, q4);
            PG8_WAIT_V(8); PG8_WAIT_L(0); PG8_BAR; PG8_MMA(1, 0, At, B0); PG8_MMA(1, 1, At, B1); PG8_BAR; PG8_SCHED;
            } else {
            PG8_LDB(B0, 0, 0); PG8_SCHED; PG8_LDA(At, 0, 0); PG8_STAGE(PG8_SA(1, 1), a1 + hstep, voffA);
            PG8_WAIT_L(8); PG8_BAR; PG8_WAIT_L(0); PG8_MMA(0, 0, At, B0); PG8_BAR; PG8_SCHED;
            PG8_LDB(B1, 0, 1); PG8_STAGE(PG8_SB(0, 0), b2, voffB);
            PG8_BAR; PG8_WAIT_L(0); PG8_MMA(0, 1, At, B1); PG8_BAR;
            PG8_LDA(At, 0, 1); PG8_STAGE(PG8_SA(0, 0), a2, voffA);
            PG8_BAR; PG8_WAIT_L(0); PG8_MMA(1, 0, At, B0); PG8_BAR; PG8_SCHED;
            PG8_STAGE(PG8_SB(0, 1), b2 + hstep, voffB);
            PG8_WAIT_V(6); PG8_BAR; PG8_MMA(1, 1, At, B1); PG8_BAR;
            PG8_LDB(B0, 1, 0); PG8_SCHED; PG8_LDA(At, 1, 0); PG8_STAGE(PG8_SA(0, 1), a2 + hstep, voffA);
            PG8_WAIT_L(8); PG8_BAR; PG8_WAIT_L(0); PG8_MMA(0, 0, At, B0); PG8_BAR; PG8_SCHED;
            PG8_LDB(B1, 1, 1); PG8_STAGE(PG8_SB(1, 0), b3, voffB);
            PG8_BAR; PG8_WAIT_L(0); PG8_MMA(0, 1, At, B1); PG8_BAR;
            PG8_LDA(At, 1, 1); PG8_STAGE(PG8_SA(1, 0), a3, voffA);
            PG8_BAR; PG8_WAIT_L(0); PG8_MMA(1, 0, At, B0); PG8_BAR; PG8_SCHED;
            PG8_STAGE(PG8_SB(1, 1), b3 + hstep, voffB);
            PG8_WAIT_V(6); PG8_BAR; PG8_MMA(1, 1, At, B1); PG8_BAR;
            }
        }
        if constexpr (ALIGN_EPI) { if (wr == 0) PG8_BAR; }
        E(acc, cur, wr, wc, fr, fq);
        if (!has_next) break;
#pragma unroll
        for (int a = 0; a < 2; ++a)
#pragma unroll
            for (int b = 0; b < 2; ++b)
#pragma unroll
                for (int m = 0; m < 4; ++m)
#pragma unroll
                    for (int n = 0; n < 2; ++n) acc[a][b][m][n] = (f32x4){0.f, 0.f, 0.f, 0.f};
        cur = nxt; cA = nA; cB = nB; ++ui;
        if constexpr (ALIGN_EPI) { if (wr == 1) PG8_BAR; }
    }
    PG8_WAIT_V(0);
    if constexpr (!ALIGN_EPI) { if (wr == 0) PG8_BAR; }
    PG8_BAR;
#undef PG8_SA
#undef PG8_SB
#undef PG8_STAGE
#undef PG8_STAGE_Q
#undef PG8_GQ
#undef PG8_GSLOT
#undef PG8_GCALC
#undef PG8_LDA
#undef PG8_LDB
#undef PG8_MMA
#undef PG8_LD8
#undef PG8_WAIT_V
#undef PG8_WAIT_L
#undef PG8_BAR
#undef PG8_SCHED
}
}

#include <hip/hip_bf16.h>
namespace attn_body {
using bf16=__hip_bfloat16;
using bf16x8=__attribute__((ext_vector_type(8)))short;
using s16x4=__attribute__((ext_vector_type(4)))short;
using f32x16=__attribute__((ext_vector_type(16)))float;
using u32x4=__attribute__((ext_vector_type(4)))unsigned;
constexpr int BATCH=8,NHEAD=16,SEQ=2048,D=64,QP=1024,KVP=256;
constexpr int NW=8,QBLK=32,QB=QBLK*NW,KVBLK=64,NQB=SEQ/QB;
constexpr int ATTN_UNIT_ROWS=QB;
__device__ __forceinline__ int crow(int r,int hi){return (r&3)+8*(r>>2)+4*hi;}
#define SBAR() __builtin_amdgcn_sched_barrier(0)
__device__ __forceinline__ void cmask(f32x16&p0,f32x16&p1,int jb,int qrel,int hi){
  const float NEG=-INFINITY; int kb=64*jb+4*hi;
  #pragma unroll
  for(int r=0;r<16;++r){int kv=kb+(r&3)+8*(r>>2); if(kv>qrel)p0[r]=NEG; if(kv+32>qrel)p1[r]=NEG;}
}

constexpr int NSLOT=3, SLOTB=8192;
constexpr int LDS_K=0, LDS_V=NSLOT*SLOTB, LDS_WS=2*NSLOT*SLOTB, LDS_OST=LDS_WS+NW*64*4, LDS_BYTES=LDS_OST+NW*4096;
constexpr float C2=0.125f*1.4426950408889634f;
__device__ __forceinline__ void glds16(const void*gsrc,unsigned lds_dst){unsigned keep;
  asm volatile("s_mov_b32 %0, m0\n\ts_mov_b32 m0, %2\n\ts_nop 0\n\tglobal_load_lds_dwordx4 %1, off\n\ts_mov_b32 m0, %0":"=&s"(keep):"v"(gsrc),"s"(lds_dst):"memory");}
__device__ __forceinline__ float max3f(float a,float b,float c){float r;asm("v_max3_f32 %0, %1, %2, %3":"=v"(r):"v"(a),"v"(b),"v"(c));return r;}
__device__ __forceinline__ float max2f(float a,float b){float r;asm("v_max_f32_e32 %0, %1, %2":"=v"(r):"v"(a),"v"(b));return r;}
__device__ __forceinline__ float fadd_s(float a,float b){float r;asm("v_add_f32_e32 %0, %1, %2":"=v"(r):"v"(a),"v"(b));return r;}
__device__ __forceinline__ float fsub_s(float a,float b){float r;asm("v_sub_f32_e32 %0, %1, %2":"=v"(r):"v"(a),"v"(b));return r;}
typedef float f32x2_t __attribute__((ext_vector_type(2))); typedef __bf16 bf16x2_t __attribute__((ext_vector_type(2)));
__device__ __forceinline__ unsigned cvtpk_s(float lo,float hi){f32x2_t v={lo,hi};bf16x2_t b=__builtin_convertvector(v,bf16x2_t);return __builtin_bit_cast(unsigned,b);}
#define WAIT_BAR(N) asm volatile("s_waitcnt vmcnt(" #N ") lgkmcnt(0)\n\ts_barrier":::"memory")

__device__ __forceinline__ void qkt(f32x16&p0,f32x16&p1,const char*Kslot,const bf16x8*qr,const f32x16&negm,int r32,int hi){
  const char*kb=Kslot+hi*1024+r32*16;
  #pragma unroll
  for(int d0=0;d0<4;++d0){
    const bf16x8 b0=*reinterpret_cast<const bf16x8*>(kb+d0*2048);
    const bf16x8 b1=*reinterpret_cast<const bf16x8*>(kb+d0*2048+512);
    if(d0==0){p0=__builtin_amdgcn_mfma_f32_32x32x16_bf16(b0,qr[0],negm,0,0,0);p1=__builtin_amdgcn_mfma_f32_32x32x16_bf16(b1,qr[0],negm,0,0,0);}
    else{p0=__builtin_amdgcn_mfma_f32_32x32x16_bf16(b0,qr[d0],p0,0,0,0);p1=__builtin_amdgcn_mfma_f32_32x32x16_bf16(b1,qr[d0],p1,0,0,0);}}
}
typedef __attribute__((address_space(3))) const char* lds_cptr;
typedef short v4i16_t __attribute__((ext_vector_type(4)));
__device__ __forceinline__ void kload8(bf16x8*kf,lds_cptr kp){
  kf[0]=*(const __attribute__((address_space(3))) bf16x8*)(kp);      kf[1]=*(const __attribute__((address_space(3))) bf16x8*)(kp+512);
  kf[2]=*(const __attribute__((address_space(3))) bf16x8*)(kp+2048); kf[3]=*(const __attribute__((address_space(3))) bf16x8*)(kp+2560);
  kf[4]=*(const __attribute__((address_space(3))) bf16x8*)(kp+4096); kf[5]=*(const __attribute__((address_space(3))) bf16x8*)(kp+4608);
  kf[6]=*(const __attribute__((address_space(3))) bf16x8*)(kp+6144); kf[7]=*(const __attribute__((address_space(3))) bf16x8*)(kp+6656);
}
__device__ __forceinline__ void kload2(bf16x8*kf,lds_cptr kp,int j){ kf[2*j]=*(const __attribute__((address_space(3))) bf16x8*)(kp+j*2048); kf[2*j+1]=*(const __attribute__((address_space(3))) bf16x8*)(kp+j*2048+512); }
__device__ __forceinline__ s16x4 vtr(lds_cptr p){ return __builtin_bit_cast(s16x4,__builtin_amdgcn_ds_read_tr16_b64_v4i16((__attribute__((address_space(3))) v4i16_t*)p)); }
__device__ __forceinline__ float rowmax(const f32x16&p0,const f32x16&p1){
  float a=max3f(p0[0],p0[1],p1[0]),b=max3f(p0[2],p0[3],p1[1]);a=max3f(a,p1[2],p1[3]);
  #pragma unroll
  for(int r=4;r<16;r+=4){a=max3f(a,p0[r],p0[r+1]);b=max3f(b,p0[r+2],p0[r+3]);a=max3f(a,p1[r],p1[r+1]);b=max3f(b,p1[r+2],p1[r+3]);}
  const float m=max2f(a,b);
  auto rr=__builtin_amdgcn_permlane32_swap(__float_as_uint(m),__float_as_uint(m),false,false);
  return max2f(__uint_as_float(rr[0]),__uint_as_float(rr[1]));
}
__device__ __forceinline__ void pv(f32x16*o,int vb,bf16x8 pa0,bf16x8 pa1,bf16x8 pa2,bf16x8 pa3){
  #pragma unroll
  for(int d0=0;d0<2;++d0){s16x4 lo[4],hi[4];
    #pragma unroll
    for(int ks=0;ks<4;++ks){
      asm volatile("ds_read_b64_tr_b16 %0,%1 offset:%c2":"=&v"(lo[ks]):"v"(vb),"i"(d0*4096+ks*1024):"memory");
      asm volatile("ds_read_b64_tr_b16 %0,%1 offset:%c2":"=&v"(hi[ks]):"v"(vb),"i"(d0*4096+ks*1024+512):"memory");}
    asm volatile("s_waitcnt lgkmcnt(0)":::"memory");SBAR();
    #define PK(k) (bf16x8){lo[k][0],lo[k][1],lo[k][2],lo[k][3],hi[k][0],hi[k][1],hi[k][2],hi[k][3]}
    o[d0]=__builtin_amdgcn_mfma_f32_32x32x16_bf16(pa0,PK(0),o[d0],0,0,0);
    o[d0]=__builtin_amdgcn_mfma_f32_32x32x16_bf16(pa1,PK(1),o[d0],0,0,0);
    o[d0]=__builtin_amdgcn_mfma_f32_32x32x16_bf16(pa2,PK(2),o[d0],0,0,0);
    o[d0]=__builtin_amdgcn_mfma_f32_32x32x16_bf16(pa3,PK(3),o[d0],0,0,0);
    #undef PK
  }
}

#ifndef ATTN_STORE16
#define ATTN_STORE16(p,v) (*(u32x4*)(p)=(v))
#endif
template<int THRL> __device__ __forceinline__ void attn_unit(int b,int h,int kvh,int qb,const bf16*Q,const bf16*__restrict__ K,const bf16*__restrict__ V,bf16*O,char*shm,const int wid_in){
  int lane; asm volatile("v_mbcnt_lo_u32_b32 %0, -1, 0\n\tv_mbcnt_hi_u32_b32 %0, -1, %0":"=v"(lane)); const int r32=lane&31,hi=lane>>5; const int wid=wid_in;
  const long rowbase=(long)b*SEQ; const int q0=qb*QB;
  const bf16*Qw=Q+(rowbase+q0+wid*QBLK)*QP+h*D;
  const bf16*Kh=K+((long)(b*4+kvh)*(SEQ/KVBLK))*4096,*Vh=V+((long)(b*4+kvh)*(SEQ/KVBLK))*4096;
  const unsigned lds0=(unsigned)(uintptr_t)shm;
  float*wsf=(float*)(shm+LDS_WS)+wid*64;
  const bf16*ksrc=Kh+wid*512+lane*8;
  const bf16*vsrc=Vh+wid*512+lane*8;
  const unsigned kdst=lds0+LDS_K+wid*1024, vdst=lds0+LDS_V+wid*1024;
  #define DMA_K(t,slot) glds16(ksrc+(long)(t)*4096,(unsigned)__builtin_amdgcn_readfirstlane(kdst+(slot)))
  #define DMA_V(t,slot) glds16(vsrc+(long)(t)*4096,(unsigned)__builtin_amdgcn_readfirstlane(vdst+(slot)))
  const int vb0=(int)(lds0+LDS_V)+((lane>>4)&1)*32+(lane&3)*8+(4*hi+((lane&15)>>2))*64;
  const char*Kbase=shm+LDS_K; bf16x8 kf[8];
  const lds_cptr shm3=(lds_cptr)shm; const lds_cptr kp0=shm3+LDS_K+hi*1024+r32*16; const lds_cptr vp0=shm3+LDS_V+((lane>>4)&1)*32+(lane&3)*8+(4*hi+((lane&15)>>2))*64;
  constexpr int NT=SEQ/KVBLK;
  DMA_K(0,0);DMA_V(0,0);DMA_K(1,SLOTB);
  bf16x8 qr[4];
  #pragma unroll
  for(int d0=0;d0<4;++d0)qr[d0]=*reinterpret_cast<const bf16x8*>(&Qw[(long)r32*QP+d0*16+hi*8]);
  float mhat=0.f,l_reg=0.f;f32x16 o[2];o[0]=f32x16{};o[1]=f32x16{};f32x16 negm=f32x16{};asm volatile("":"+v"(negm));
  #define CMASK(P0,P1,t) do{}while(0)
  bool resc=false;
  #define START(P0,P1) do{ const float rm=rowmax(P0,P1); resc=false; \
    { const float dl=rm; mhat=fadd_s(mhat,dl); \
      _Pragma("unroll") for(int r=0;r<16;++r){P0[r]=fsub_s(P0[r],dl);P1[r]=fsub_s(P1[r],dl);} \
      _Pragma("unroll") for(int r=0;r<16;++r)negm[r]=-mhat; asm volatile("":"+v"(negm)); } \
    _Pragma("unroll") for(int r=0;r<16;++r)P0[r]=__builtin_amdgcn_exp2f(P0[r]); }while(0)
  #define RESC() do{ if(resc){ asm volatile("s_waitcnt lgkmcnt(0)":::"memory"); \
      _Pragma("unroll") for(int d_=0;d_<2;++d_) _Pragma("unroll") for(int r=0;r<16;++r)o[d_][r]*=wsf[crow(r,hi)]; } }while(0)
  f32x16 pA0,pA1,pB0,pB1;
  int sl_prev=0,sl_cur=0,sl_next=SLOTB;
  #define ROT() do{sl_prev=sl_cur;sl_cur=sl_next;sl_next=(sl_next==(NSLOT-1)*SLOTB)?0:sl_next+SLOTB;}while(0)
  DMA_K(2,2*SLOTB);
  WAIT_BAR(3);
  qkt(pA0,pA1,Kbase,qr,negm,r32,hi);asm volatile("s_nop 15\n\ts_nop 7":"+v"(pA0),"+v"(pA1));CMASK(pA0,pA1,0);
  START(pA0,pA1);
  _Pragma("unroll") for(int r=0;r<16;++r)pA1[r]=__builtin_amdgcn_exp2f(pA1[r]);
  WAIT_BAR(0);
  DMA_K(3,0);DMA_V(1,SLOTB);
  ROT();
  kload8(kf,kp0+sl_cur);
  WAIT_BAR(2);
  s16x4 vlo[8],vhi[8]; u32x4 pw0,pw1,pw2,pw3;
  #define PKW(P,B) cvtpk_s(P[B],P[B+1])
  #define PAF(k) __builtin_bit_cast(bf16x8,pw##k)
  #define VFR(i) (bf16x8){vlo[i][0],vlo[i][1],vlo[i][2],vlo[i][3],vhi[i][0],vhi[i][1],vhi[i][2],vhi[i][3]}
  #define PIN(x) asm volatile("":"+v"(x))
  #define MX3(a,b,c) __builtin_fmaxf(__builtin_fmaxf((a),(b)),(c))
  #define GAPA(MF,A0,A1,A2,A3,W0,W1,PW) do{ MF; sacc+=A0; sacc+=A1; sacc+=A2; sacc+=A3; PIN(sacc); W0; W1; PIN(PW); SBAR(); }while(0)
  #define EX(v) __builtin_amdgcn_exp2f(v)
  #define GAPB(MF,X,B) do{ MF; X[B]=EX(X[B]); X[B+1]=EX(X[B+1]); X[B+2]=EX(X[B+2]); X[B+3]=EX(X[B+3]); PIN(X); SBAR(); }while(0)
  #define VRD(i) do{ vlo[i]=vtr(vp_+(((i)>>2)*4096+((i)&3)*1024)); vhi[i]=vtr(vp_+(((i)>>2)*4096+((i)&3)*1024+512)); }while(0)
  #define KRD(G,j) do{ if(G){ kload2(kf,kp0+sl_next,j); SBAR(); } }while(0)
  #define STEP(C0,C1,P0,P1,t,GK,GV,GL) do{ SBAR(); \
    const lds_cptr vp_=vp0+sl_prev; \
    VRD(0); SBAR(); float sacc=(P0[0]+P0[1]); \
    GAPA(C0=__builtin_amdgcn_mfma_f32_32x32x16_bf16(kf[0],qr[0],negm,0,0,0), P0[2],P0[3],P0[4],P0[5],     pw0[0]=PKW(P0,0), pw0[1]=PKW(P0,2), pw0); \
    VRD(4); SBAR(); GAPA(C1=__builtin_amdgcn_mfma_f32_32x32x16_bf16(kf[1],qr[0],negm,0,0,0), P0[6],P0[7],P0[8],P0[9],     pw0[2]=PKW(P0,4), pw0[3]=PKW(P0,6), pw0); \
    VRD(1); SBAR(); GAPA(C0=__builtin_amdgcn_mfma_f32_32x32x16_bf16(kf[2],qr[1],C0,0,0,0),   P0[10],P0[11],P0[12],P0[13], pw1[0]=PKW(P0,8), pw1[1]=PKW(P0,10), pw1); \
    VRD(5); SBAR(); GAPA(C1=__builtin_amdgcn_mfma_f32_32x32x16_bf16(kf[3],qr[1],C1,0,0,0),   P0[14],P0[15],P1[0],P1[1],   pw1[2]=PKW(P0,12),pw1[3]=PKW(P0,14), pw1); \
    VRD(2); SBAR(); GAPA(C0=__builtin_amdgcn_mfma_f32_32x32x16_bf16(kf[4],qr[2],C0,0,0,0),   P1[2],P1[3],P1[4],P1[5],     pw2[0]=PKW(P1,0), pw2[1]=PKW(P1,2), pw2); \
    VRD(6); SBAR(); GAPA(C1=__builtin_amdgcn_mfma_f32_32x32x16_bf16(kf[5],qr[2],C1,0,0,0),   P1[6],P1[7],P1[8],P1[9],     pw2[2]=PKW(P1,4), pw2[3]=PKW(P1,6), pw2); \
    VRD(3); SBAR(); GAPA(C0=__builtin_amdgcn_mfma_f32_32x32x16_bf16(kf[6],qr[3],C0,0,0,0),   P1[10],P1[11],P1[12],P1[13], pw3[0]=PKW(P1,8), pw3[1]=PKW(P1,10), pw3); \
    VRD(7); SBAR(); GAPA(C1=__builtin_amdgcn_mfma_f32_32x32x16_bf16(kf[7],qr[3],C1,0,0,0),   P1[14],P1[15],0.f,0.f,       pw3[2]=PKW(P1,12),pw3[3]=PKW(P1,14), pw3); \
    l_reg+=sacc; \
    if(GK){DMA_K((t)+3,sl_cur);} if(GV){DMA_V((t)+1,sl_next);} \
    CMASK(C0,C1,t); \
    { float a=MX3(C0[0],C0[1],C1[0]),b=MX3(C0[2],C0[3],C1[1]); a=MX3(a,C1[2],C1[3]); \
      _Pragma("unroll") for(int r=4;r<16;r+=4){a=MX3(a,C0[r],C0[r+1]);b=MX3(b,C0[r+2],C0[r+3]);a=MX3(a,C1[r],C1[r+1]);b=MX3(b,C1[r+2],C1[r+3]);} \
      float rm=__builtin_fmaxf(a,b); { auto rr=__builtin_amdgcn_permlane32_swap(__float_as_uint(rm),__float_as_uint(rm),false,false); rm=__builtin_fmaxf(__uint_as_float(rr[0]),__uint_as_float(rr[1])); } \
      resc=false; \
      if(__builtin_expect(__any(rm>(float)THRL),0)){ const float dl=__builtin_fmaxf(rm,0.f); mhat+=dl; \
        _Pragma("unroll") for(int r=0;r<16;++r){C0[r]-=dl;C1[r]-=dl;} \
        _Pragma("unroll") for(int r=0;r<16;++r)negm[r]=-mhat; asm volatile("":"+v"(negm)); \
        const float f=__builtin_amdgcn_exp2f(-dl); l_reg*=f; if(hi==0)wsf[r32]=f; resc=true; } } \
    SBAR(); \
    GAPB(o[0]=__builtin_amdgcn_mfma_f32_32x32x16_bf16(PAF(0),VFR(0),o[0],0,0,0), C0,0); \
    GAPB(o[1]=__builtin_amdgcn_mfma_f32_32x32x16_bf16(PAF(0),VFR(4),o[1],0,0,0), C0,4); \
    KRD(GL,0); GAPB(o[0]=__builtin_amdgcn_mfma_f32_32x32x16_bf16(PAF(1),VFR(1),o[0],0,0,0), C0,8); \
    KRD(GL,1); GAPB(o[1]=__builtin_amdgcn_mfma_f32_32x32x16_bf16(PAF(1),VFR(5),o[1],0,0,0), C0,12); \
    KRD(GL,2); GAPB(o[0]=__builtin_amdgcn_mfma_f32_32x32x16_bf16(PAF(2),VFR(2),o[0],0,0,0), C1,0); \
    KRD(GL,3); GAPB(o[1]=__builtin_amdgcn_mfma_f32_32x32x16_bf16(PAF(2),VFR(6),o[1],0,0,0), C1,4); \
    GAPB(o[0]=__builtin_amdgcn_mfma_f32_32x32x16_bf16(PAF(3),VFR(3),o[0],0,0,0), C1,8); \
    GAPB(o[1]=__builtin_amdgcn_mfma_f32_32x32x16_bf16(PAF(3),VFR(7),o[1],0,0,0), C1,12); \
    }while(0)
  int t=1;
  #undef CMASK
  #define CMASK(P0,P1,t) do{}while(0)
  for(;t+5<NT;t+=2){
    STEP(pB0,pB1,pA0,pA1,t,true,true,true);     WAIT_BAR(2); RESC(); ROT();
    STEP(pA0,pA1,pB0,pB1,t+1,true,true,true);   WAIT_BAR(2); RESC(); ROT();
  }
  #undef CMASK
  #define CMASK(P0,P1,t) do{}while(0)
  #define ENDW(tt) do{ if((tt)+3<NT){WAIT_BAR(2);} else if((tt)+2<NT){WAIT_BAR(1);} else {WAIT_BAR(0);} }while(0)
  for(;t+1<NT;t+=2){
    STEP(pB0,pB1,pA0,pA1,t,(t+3<NT),(t+1<NT),(t+1<NT));       ENDW(t);   RESC(); ROT();
    STEP(pA0,pA1,pB0,pB1,t+1,(t+4<NT),(t+2<NT),(t+2<NT));     ENDW(t+1); RESC(); ROT();
  }
  STEP(pB0,pB1,pA0,pA1,NT-1,false,false,false); RESC();
  { float sacc=pB0[0]+pB0[1]; _Pragma("unroll") for(int r=2;r<16;++r)sacc+=pB0[r]; _Pragma("unroll") for(int r=0;r<16;++r)sacc+=pB1[r]; l_reg+=sacc;
    pw0=(u32x4){PKW(pB0,0),PKW(pB0,2),PKW(pB0,4),PKW(pB0,6)};pw1=(u32x4){PKW(pB0,8),PKW(pB0,10),PKW(pB0,12),PKW(pB0,14)};pw2=(u32x4){PKW(pB1,0),PKW(pB1,2),PKW(pB1,4),PKW(pB1,6)};pw3=(u32x4){PKW(pB1,8),PKW(pB1,10),PKW(pB1,12),PKW(pB1,14)};
    SBAR(); pv(o,vb0+sl_cur,PAF(0),PAF(1),PAF(2),PAF(3)); }
  #undef PKW
  #undef PAF
  #undef VFR
  #undef PIN
  #undef MX3
  #undef GAPA
  #undef GAPB
  #undef EX
  #undef VRD
  #undef KRD
  #undef STEP
  #undef ENDW
  {auto rr=__builtin_amdgcn_permlane32_swap(__float_as_uint(l_reg),__float_as_uint(l_reg),false,false);l_reg=__uint_as_float(rr[0])+__uint_as_float(rr[1]);}
  if(hi==0)wsf[32+r32]=l_reg;asm volatile("s_waitcnt lgkmcnt(0)":::"memory");
  float rli[16];
  #pragma unroll
  for(int r=0;r<16;++r)rli[r]=__builtin_amdgcn_rcpf(wsf[32+crow(r,hi)]);
  bf16*Ow=O+(rowbase+q0+wid*QBLK)*QP+h*D;
  { bf16*stg=(bf16*)(shm+LDS_OST)+wid*2048;
    #pragma unroll
    for(int r=0;r<16;++r){const int orow=crow(r,hi);
      #pragma unroll
      for(int d0=0;d0<2;++d0)stg[orow*64+d0*32+r32]=__float2bfloat16(o[d0][r]*rli[r]);}
    asm volatile("s_waitcnt lgkmcnt(0)":::"memory");
    #pragma unroll
    for(int i=0;i<4;++i){const int row=i*8+(lane>>3),ch=lane&7; const u32x4 v=*(const u32x4*)(stg+row*64+ch*8); ATTN_STORE16(Ow+(long)row*QP+ch*8,v);} }
  asm volatile("s_waitcnt lgkmcnt(0)\n\ts_barrier":::"memory");
  #undef DMA_K
  #undef DMA_V
  #undef CMASK
  #undef START
  #undef RESC
  #undef ROT
}
constexpr int ATTN_LDS_BYTES=LDS_BYTES;

#undef SBAR
#undef WAIT_BAR
}
constexpr int T = 16384, D = 1024, SEQ = 2048, NBATCH = 8, NEXP = 32;
constexpr float C2F = 0.125f * 1.4426950408889634f;
constexpr float LN2F = 0.6931471805599453f;
constexpr float NORM_EPS = 1e-6f;
constexpr size_t MiB = 1u << 20;
constexpr size_t WS_CTL = 0, CTL_ZERO_BYTES = 1 * MiB;
constexpr size_t WS_MOD = 1 * MiB;
constexpr size_t WS_ROPEA = 2 * MiB;
constexpr size_t WS_ROPEB = 3 * MiB;
constexpr size_t WS_WRT = 3 * MiB + 65536;
constexpr size_t WS_HIST = 4 * MiB;
constexpr size_t WS_TOT = 4 * MiB + 65536;
constexpr size_t WS_GSORT = 5 * MiB;
constexpr size_t WS_POSOF = 5 * MiB + 524288;
constexpr size_t WS_LSE = 6 * MiB;
constexpr size_t WS_WINA_QK = 16 * MiB, WS_WINA_V = 28 * MiB, WS_WOUTA = 34 * MiB, WS_WINB = 36 * MiB, WS_WOUTB = 39 * MiB;
constexpr size_t WS_WUP = 48 * MiB, WS_WDOWN = 304 * MiB;
constexpr size_t WS_XA = 432 * MiB;
constexpr size_t WS_H0 = 496 * MiB, WS_H1 = 528 * MiB, WS_H2 = 560 * MiB;
constexpr size_t WS_QA = 592 * MiB, WS_KA = 688 * MiB, WS_VTA = 784 * MiB;
constexpr size_t WS_OG = 880 * MiB;
constexpr size_t WS_O = 976 * MiB, WS_Y = 1008 * MiB;
constexpr size_t WS_XS = 592 * MiB, WS_ACT = 736 * MiB, WS_OUTS = 880 * MiB;
constexpr size_t WS_QB = 880 * MiB, WS_KB = 912 * MiB, WS_VB = 920 * MiB;
constexpr size_t WS_END = 1040 * MiB;
static_assert(WS_H2 - WS_H1 == WS_H1 - WS_H0, "H0/H1/H2 equally spaced");
constexpr int MAXROWS = 73728, MAXTILES = 288;
constexpr size_t TSTEP = (size_t)256 * 1024 * 2;
constexpr size_t TSTEP8 = (size_t)256 * 1024;
constexpr float W8_SCALE = 32.0f;
constexpr int CW_TMO = 0, CW_CODE = 1, CW_BAR = 4096, CW_CMP = 200000;
constexpr int RING_BYTES = 131072;
constexpr int TBL_OFF = 135168;
constexpr int RT_PITCH = 2064, RT_LO = 32 * RT_PITCH, T_LG = 139264;
constexpr int T_SEL = TBL_OFF, T_GTE = TBL_OFF + 1024, T_RNK = TBL_OFF + 2048, T_TOT = TBL_OFF + 3072, T_BEF = T_TOT + 128, T_PBASE = T_BEF + 128, T_MYOFF = T_PBASE + 128, T_TEXP = T_MYOFF + 128, T_MT = T_TEXP + 512;
constexpr int LDSCTL_OFF = 143360, MISC_OFF = LDSCTL_OFF + 320;
constexpr int LDS_BYTES = 163840;
constexpr int T_LG2 = 147456;
constexpr int NWAVES = 8;

typedef unsigned u32x2v __attribute__((ext_vector_type(2)));
typedef float f32x2v __attribute__((ext_vector_type(2)));
typedef float f32x16 __attribute__((ext_vector_type(16)));
typedef float f32x2t __attribute__((ext_vector_type(2)));
typedef __bf16 bf16x2t __attribute__((ext_vector_type(2)));
__device__ __forceinline__ unsigned pkbf(float lo, float hi) { f32x2t v = {lo, hi}; bf16x2t b = __builtin_convertvector(v, bf16x2t); return __builtin_bit_cast(unsigned, b); }
constexpr float OUTS_SCALE = 8.0f;
__device__ __forceinline__ unsigned pk4_fp8(float a, float b, float c, float d) { unsigned w = 0; w = __builtin_amdgcn_cvt_pk_fp8_f32(a, b, w, false); w = __builtin_amdgcn_cvt_pk_fp8_f32(c, d, w, true); return w; }
__device__ __forceinline__ float bflo(unsigned u) { return __builtin_bit_cast(float, u << 16); }
__device__ __forceinline__ float bfhi(unsigned u) { return __builtin_bit_cast(float, u & 0xffff0000u); }
__device__ __forceinline__ v4u pack8(f32x4 a, f32x4 b) { v4u w; w.x = pkbf(a[0], a[1]); w.y = pkbf(a[2], a[3]); w.z = pkbf(b[0], b[1]); w.w = pkbf(b[2], b[3]); return w; }
__device__ __forceinline__ float wave_sum(float v) {
#pragma unroll
    for (int o = 1; o < 64; o <<= 1) v += __shfl_xor(v, o);
    return v;
}
__device__ __forceinline__ float hsum4(f32x4 v) { return (v[0] + v[1]) + (v[2] + v[3]); }
__device__ __forceinline__ float dot4(f32x4 a, f32x4 b) { return (a[0] * b[0] + a[1] * b[1]) + (a[2] * b[2] + a[3] * b[3]); }
__device__ __forceinline__ int perm_row(int t, int sh) { const int s = t & 2047; return (t & ~2047) + ((s & ((1 << sh) - 1)) << (11 - sh)) + (s >> sh); }
__device__ __forceinline__ int unperm_row(int p, int sh) { const int pp = p & 2047, Lsh = 11 - sh; return (p & ~2047) + ((pp & ((1 << Lsh) - 1)) << sh) + (pp >> Lsh); }

__host__ __device__ __forceinline__ int swap23(int r) { return (r & 0x13) | ((r & 4) << 1) | ((r & 8) >> 1); }
__host__ __device__ __forceinline__ size_t qk_chunk(int g, int h, int blk) { return ((size_t)(g * 16 + h) * 512 + blk) * 2048; }
struct Args { const float* in[20]; float* out; unsigned char* ws; int ph_lo, ph_hi, li, pad; };
__device__ __forceinline__ int lane_id() { int l; asm volatile("v_mbcnt_lo_u32_b32 %0, -1, 0\n\tv_mbcnt_hi_u32_b32 %0, -1, %0" : "=v"(l)); return l; }
__device__ __forceinline__ unsigned char* opaque_ptr(unsigned char* p) { asm volatile("" : "+s"(p)); return p; }
#ifndef PSEC
#define PSEC 0
#endif
#define SEC_BEGIN(id) unsigned long long tsec_##id = 0; if ((id) == PSEC) tsec_##id = __builtin_amdgcn_s_memrealtime()
#define SEC_END(id) do { if ((id) == PSEC && F.wave == 0 && lane_id() == 0) F.MISC[16] += (unsigned)(__builtin_amdgcn_s_memrealtime() - tsec_##id); } while (0)
struct Frame {
    LAS unsigned char* lds;
    volatile LAS unsigned* MISC;
    gu32* ctl;
    int wave, G, vcu;
    float* out; unsigned char* ws;
};
enum { IN_X = 0, IN_C, IN_WMOD, IN_BMOD, IN_GPREMIX, IN_GPOSTMIX, IN_GPREFFN, IN_GPOSTFFN, IN_WINA, IN_WOUTA, IN_WINB, IN_GQB, IN_GKB, IN_WOUTB, IN_WROUTER, IN_BROUTER, IN_WUP, IN_BUP, IN_WDOWN, IN_BDOWN };

struct RmNat { __device__ __forceinline__ int operator()(int c) const { return c; } };
struct RmInA { unsigned char* qk; unsigned char* v;
    __device__ __forceinline__ unsigned char* row(int c) const { const int g = c / 3072, rem = c - g * 3072, j = rem >> 10, cc = rem & 1023;
        if (j < 2) { const int hq4 = cc >> 8, wc = (cc >> 6) & 3, bj = (cc >> 5) & 1, t = cc & 31; return qk + (size_t)(g * 2048 + (j * 4 + hq4) * 256 + 128 * bj + 32 * wc + t) * 1024; }
        return v + (size_t)(g * 1024 + cc) * 1024; } };
__device__ __forceinline__ int rm_inb(int c) { const int pn = c >> 8, cc = c & 255, wc = cc >> 6, dm = cc & 63, bj = (dm >> 4) & 1, fq = 2 * (dm >> 5) + ((dm >> 3) & 1), n = (dm >> 2) & 1, i = dm & 3; return pn * 256 + 128 * bj + 32 * wc + 8 * fq + 4 * n + i; }
__device__ __forceinline__ int rm_lin(int c) { const int pn = c >> 8, cc = c & 255, wc = cc >> 6, bj = (cc >> 5) & 1, t = cc & 31; return pn * 256 + 128 * bj + 32 * wc + t; }
__device__ __forceinline__ int rm_dn(int c) { const int pn = c >> 8, cc = c & 255, wc = cc >> 6, fq = (cc >> 4) & 3, bj = (cc >> 3) & 1, r = cc & 7; return pn * 256 + 128 * bj + 32 * wc + 8 * fq + r; }
__device__ __forceinline__ int rm_up(int c) { const int bj = c >> 10, pn = (c & 1023) >> 7, jj = c & 127; return pn * 256 + 128 * bj + jj; }
constexpr int I_UP = 64 * 32 * 8, I_DN = 64 * 16 * 8, I_INA = 144 * 8, I_OUT = 16 * 16, I_INB = 24 * 16;
constexpr int NITEMS = I_UP + I_DN + I_INA + 2 * I_OUT + I_INB;
struct CvtItem { const float* src; int ldw; int kind, le, k0, n0; };
__device__ __forceinline__ CvtItem cvt_decode(const Args& args, int it) {
    CvtItem c; int r = it;
    if (r < I_UP) { c.kind = 0; c.le = r >> 8; const int q = r & 255; c.k0 = (q >> 5) * 128; c.n0 = (q & 31) * 64; c.ldw = 2048; c.src = args.in[IN_WUP] + (size_t)c.le * 1024 * 2048; }
    else if ((r -= I_UP) < I_DN) { c.kind = 1; c.le = r >> 7; const int q = r & 127; c.k0 = (q >> 4) * 128; c.n0 = (q & 15) * 64; c.ldw = 1024; c.src = args.in[IN_WDOWN] + (size_t)c.le * 1024 * 1024; }
    else if ((r -= I_DN) < I_INA) { c.kind = 2; c.le = 0; c.k0 = (r / 144) * 128; c.n0 = (r % 144) * 64; c.ldw = 9216; c.src = args.in[IN_WINA]; }
    else if ((r -= I_INA) < I_OUT) { c.kind = 3; c.le = 0; c.k0 = (r >> 4) * 64; c.n0 = (r & 15) * 64; c.ldw = 1024; c.src = args.in[IN_WOUTA]; }
    else if ((r -= I_OUT) < I_OUT) { c.kind = 4; c.le = 0; c.k0 = (r >> 4) * 64; c.n0 = (r & 15) * 64; c.ldw = 1024; c.src = args.in[IN_WOUTB]; }
    else { r -= I_OUT; c.kind = 5; c.le = 0; c.k0 = (r / 24) * 64; c.n0 = (r % 24) * 64; c.ldw = 1536; c.src = args.in[IN_WINB]; }
    return c;
}
__device__ __forceinline__ void cvt_load(const CvtItem& c, int half, f32x4 (&v)[16], int lane) {
    const float* p = c.src + (size_t)(c.k0 + 64 * half + 4 * (lane >> 4)) * c.ldw + c.n0 + 4 * (lane & 15);
#pragma unroll
    for (int i = 0; i < 16; ++i) v[i] = __builtin_nontemporal_load((const GAS f32x4*)(p + (size_t)(16 * (i >> 2) + (i & 3)) * c.ldw));
}
__device__ __forceinline__ unsigned char* cvt_row(const CvtItem& c, unsigned char* ws, int cidx) {
    switch (c.kind) {
    case 0: return ws + WS_WUP + ((size_t)c.le * 2048 + rm_up(cidx)) * 1024;
    case 1: return ws + WS_WDOWN + ((size_t)c.le * 1024 + rm_dn(cidx)) * 1024;
    case 2: { const RmInA rm{ws + WS_WINA_QK, ws + WS_WINA_V}; return rm.row(cidx); }
    case 3: return ws + WS_WOUTA + (size_t)rm_lin(cidx) * 2048;
    case 4: return ws + WS_WOUTB + (size_t)rm_lin(cidx) * 2048;
    default: return ws + WS_WINB + (size_t)rm_inb(cidx) * 2048;
    }
}
__device__ __forceinline__ void cvt_pack8(const f32x4 (&v)[16], int half, LAS unsigned* scr, int lane) {
    const int lr = lane >> 4, lc = 4 * (lane & 15);
#pragma unroll
    for (int j = 0; j < 4; ++j)
#pragma unroll
        for (int q = 0; q < 4; ++q) scr[(lc + q) * 33 + 16 * half + 4 * j + lr] = pk4_fp8(v[4 * j][q] * W8_SCALE, v[4 * j + 1][q] * W8_SCALE, v[4 * j + 2][q] * W8_SCALE, v[4 * j + 3][q] * W8_SCALE);
}
__device__ __forceinline__ void cvt_store8(const CvtItem& c, unsigned char* ws, LAS unsigned* scr, int lane) {
    LDS_WAIT(); asm volatile("" ::: "memory");
    const int cq = lane & 7;
#pragma unroll
    for (int s = 0; s < 8; ++s) { const int nl = 8 * s + (lane >> 3); const LAS unsigned* q = scr + nl * 33 + 4 * cq;
        v4u o; o.x = q[0]; o.y = q[1]; o.z = q[2]; o.w = q[3];
        *(GAS v4u*)(cvt_row(c, ws, c.n0 + nl) + c.k0 + 16 * cq) = o; }
    LDS_WAIT(); asm volatile("" ::: "memory");
}
__device__ __forceinline__ void cvt_finish16(const CvtItem& c, const f32x4 (&v)[16], unsigned char* ws, LAS float* scr, int lane) {
    const int lr = lane >> 4, lc = 4 * (lane & 15);
#pragma unroll
    for (int i = 0; i < 16; ++i) { LAS float* p = scr + (16 * (i >> 2) + 4 * lr + (i & 3)) * 65 + lc; p[0] = v[i][0]; p[1] = v[i][1]; p[2] = v[i][2]; p[3] = v[i][3]; }
    LDS_WAIT(); asm volatile("" ::: "memory");
    const int cq = lane & 7;
#pragma unroll
    for (int s = 0; s < 8; ++s) { const int nl = 8 * s + (lane >> 3); const LAS float* q = scr + (8 * cq) * 65 + nl;
        v4u o; o.x = pkbf(q[0], q[65]); o.y = pkbf(q[2 * 65], q[3 * 65]); o.z = pkbf(q[4 * 65], q[5 * 65]); o.w = pkbf(q[6 * 65], q[7 * 65]);
        *(GAS v4u*)(cvt_row(c, ws, c.n0 + nl) + (size_t)(c.k0 + 8 * cq) * 2) = o; }
    LDS_WAIT(); asm volatile("" ::: "memory");
}
__device__ __forceinline__ void p0_prologue(Frame& F, const Args& args) {
    unsigned char* const wsl = opaque_ptr(F.ws);
    unsigned char* ws = wsl;
    const int gtid = blockIdx.x * 512 + (F.wave * 64 + lane_id());
    if (gtid < 65536) { const int l = gtid >> 15, e = (gtid >> 10) & 31, k = gtid & 1023; const float wv = args.in[IN_WROUTER][((size_t)l * 1024 + k) * 32 + e];
        const unsigned hb = pkbf(wv, 0.f) & 0xffffu; const float hf_ = __builtin_bit_cast(float, hb << 16); const unsigned lb = pkbf(wv - hf_, 0.f) & 0xffffu;
        ((bf16*)(ws + WS_WRT))[gtid] = (bf16)hb; ((bf16*)(ws + WS_WRT + 131072))[gtid] = (bf16)lb; }
    if (blockIdx.x < 192) {
        const int is = blockIdx.x / 48, n0 = (blockIdx.x % 48) * 64;
        LAS float* sil = (LAS float*)F.lds;
        LAS float* red = (LAS float*)(F.lds + 32768);
        const int w = F.wave, lane = lane_id();
#pragma unroll
        for (int b = 0; b < 8; ++b)
#pragma unroll
            for (int q = 0; q < 2; ++q) { const int kk = lane * 2 + q; const float cv = args.in[IN_C][b * 1024 + 128 * w + kk]; sil[(w * 8 + b) * 128 + kk] = cv / (1.f + expf(-cv)); }
        LDS_WAIT(); asm volatile("" ::: "memory");
        const float* wm = args.in[IN_WMOD] + (size_t)is * 1024 * 3072 + (size_t)(128 * w) * 3072 + n0 + lane;
        float acc[8] = {0.f, 0.f, 0.f, 0.f, 0.f, 0.f, 0.f, 0.f};
#pragma unroll 8
        for (int kk = 0; kk < 128; ++kk) { const float wv = wm[(size_t)kk * 3072];
#pragma unroll
            for (int b = 0; b < 8; ++b) acc[b] += sil[(w * 8 + b) * 128 + kk] * wv; }
#pragma unroll
        for (int b = 0; b < 8; ++b) red[(w * 8 + b) * 64 + lane] = acc[b];
        __syncthreads();
        { const int b = (F.wave * 64 + lane_id()) >> 6, col = (F.wave * 64 + lane_id()) & 63; float s = 0.f;
#pragma unroll
          for (int ww = 0; ww < 8; ++ww) s += red[(ww * 8 + b) * 64 + col];
          ((float*)(ws + WS_MOD))[(size_t)(is * 8 + b) * 3072 + n0 + col] = s + args.in[IN_BMOD][is * 3072 + n0 + col]; }
        __syncthreads();
    }
    LAS float* scr = (LAS float*)(F.lds + F.wave * 16640);
    const int gw = blockIdx.x * NWAVES + F.wave, NGW = F.G * NWAVES, lane = lane_id();
    {
        f32x4 va[16], vb[16];
        int it = gw; if (it >= NITEMS) return;
        CvtItem ca = cvt_decode(args, it); int ha = 0;
        cvt_load(ca, ha, va, lane);
        for (;;) {
            CvtItem cb = ca; int hb = ha + 1; bool haveb = true;
            if (!(ca.kind < 3 && ha == 0)) { it += NGW; hb = 0; haveb = it < NITEMS; if (haveb) cb = cvt_decode(args, it); }
            if (haveb) cvt_load(cb, hb, vb, lane);
            if (ca.kind < 3) { cvt_pack8(va, ha, (LAS unsigned*)scr, lane); if (ha == 1) cvt_store8(ca, ws, (LAS unsigned*)scr, lane); } else cvt_finish16(ca, va, ws, scr, lane);
            if (!haveb) break;
            CvtItem cc = cb; int hc = hb + 1; bool havec = true;
            if (!(cb.kind < 3 && hb == 0)) { it += NGW; hc = 0; havec = it < NITEMS; if (havec) cc = cvt_decode(args, it); }
            if (havec) cvt_load(cc, hc, va, lane);
            if (cb.kind < 3) { cvt_pack8(vb, hb, (LAS unsigned*)scr, lane); if (hb == 1) cvt_store8(cb, ws, (LAS unsigned*)scr, lane); } else cvt_finish16(cb, vb, ws, scr, lane);
            if (!havec) break;
            ca = cc; ha = hc;
        }
    }
}

__device__ __forceinline__ void p1_prenorm0(Frame& F, const Args& args) {
    unsigned char* const wsl = opaque_ptr(F.ws);
    const int lane = lane_id(); const int gw = blockIdx.x * NWAVES + F.wave, NGW = F.G * NWAVES;
    unsigned char* H0 = wsl + WS_H0; unsigned char* H1 = wsl + WS_H1; unsigned char* H2 = wsl + WS_H2;
    for (int t0 = gw * 8; t0 < T; t0 += NGW * 8) {
        const int b = t0 >> 11;
        const float* m0 = (const float*)(wsl + WS_MOD) + (size_t)(0 * 8 + b) * 3072;
        f32x4 gs[4], sh[4];
#pragma unroll
        for (int j = 0; j < 4; ++j) { const int c = 16 * lane + 4 * j; const f32x4 g = *(const f32x4*)(args.in[IN_GPREMIX] + c), sc = *(const f32x4*)(m0 + 1024 + c); gs[j] = g * (sc + 1.0f); sh[j] = *(const f32x4*)(m0 + c); }
        for (int i0 = 0; i0 < 8; i0 += 4) {
            f32x4 v[4][4];
#pragma unroll
            for (int u = 0; u < 4; ++u)
#pragma unroll
                for (int j = 0; j < 4; ++j) v[u][j] = *(const GAS f32x4*)(args.in[IN_X] + (size_t)(t0 + i0 + u) * D + 16 * lane + 4 * j);
#pragma unroll
            for (int u = 0; u < 4; ++u) { const int t = t0 + i0 + u; float ss = 0.f;
#pragma unroll
                for (int j = 0; j < 4; ++j) ss += dot4(v[u][j], v[u][j]);
                const float rstd = rsqrtf(wave_sum(ss) * (1.f / D) + NORM_EPS);
                v4u w;
#pragma unroll
                for (int j = 0; j < 4; ++j) { const f32x4 h = v[u][j] * rstd * gs[j] + sh[j]; w[j] = pk4_fp8(h[0], h[1], h[2], h[3]); }
                *(GAS v4u*)(H0 + (size_t)t * 1024 + 16 * lane) = w; *(GAS v4u*)(H1 + (size_t)perm_row(t, 2) * 1024 + 16 * lane) = w; *(GAS v4u*)(H2 + (size_t)perm_row(t, 4) * 1024 + 16 * lane) = w; }
        }
    }
}

__device__ __forceinline__ int rfl(int v) { return __builtin_amdgcn_readfirstlane(v); }
__device__ __forceinline__ const char* uptr(const char* p) { const unsigned long long v = (unsigned long long)p; const unsigned lo = __builtin_amdgcn_readfirstlane((unsigned)v), hi = __builtin_amdgcn_readfirstlane((unsigned)(v >> 32)); return (const char*)(((unsigned long long)hi << 32) | lo); }
__device__ __forceinline__ void store_rows128(unsigned char* seg0  , size_t pitch, int fr, int off0  , int off1  , v4u p0, v4u p1) {
    const bool odd = fr & 1; const v4u snd = odd ? p0 : p1; v4u rcv;
#pragma unroll
    for (int e = 0; e < 4; ++e) rcv[e] = (unsigned)__builtin_amdgcn_update_dpp(0, (int)snd[e], 0xB1  , 0xF, 0xF, false);
    const v4u a = odd ? rcv : p0, b = odd ? p1 : rcv;
    const int off = odd ? off1 : off0;
    *(GAS v4u*)(seg0 + (size_t)(odd ? fr - 1 : fr) * pitch + off) = a; *(GAS v4u*)(seg0 + (size_t)(odd ? fr : fr + 1) * pitch + off) = b;
}
typedef pg8::f32x4 (&AccRef)[2][2][4][2];
struct SchedPlain {
    pg8::GridOrder go; const char* A; const char* B;
    __device__ __forceinline__ bool next(int i, pg8::Unit& u) const { int pm, pn; if (!go.tile(i, pm, pn)) return false; pm = rfl(pm); pn = rfl(pn); u.a = uptr(A + (size_t)pm * TSTEP); u.b = uptr(B + (size_t)pn * TSTEP); u.pm = pm; u.pn = pn; u.aux = 0; return true; }
};
struct EpiPlain {
    static constexpr bool PERM = true;
    bf16* O; size_t ldc;
    __device__ __forceinline__ void operator()(const pg8::f32x4 (&acc)[2][2][4][2], const pg8::Unit& u, int wr, int wc, int fr_in, int fq_in) const {
        const int ln_ = lane_id(), fr = ln_ & 15, fq = ln_ >> 4; (void)fr_in; (void)fq_in;
#pragma unroll
        for (int ai = 0; ai < 2; ++ai)
#pragma unroll
            for (int m = 0; m < 4; ++m) store_rows128((unsigned char*)(O + (size_t)(u.pm * 256 + ai * 128 + wr * 64 + m * 16) * ldc + u.pn * 256 + wc * 64), ldc * 2, fr, 16 * fq, 64 + 16 * fq,
                                                      pack8(acc[ai][0][m][0], acc[ai][0][m][1]), pack8(acc[ai][1][m][0], acc[ai][1][m][1]));
    }
};
struct SchedInaQK {
    pg8::GridOrder go; const char* h0; const char* w;
    __device__ __forceinline__ bool next(int i, pg8::Unit& u) const { int pm, pv; if (!go.tile(i, pm, pv)) return false; pm = rfl(pm); pv = rfl(pv); const int g = pv >> 3, pn = pv & 7;
        const char* hg = h0 + (size_t)g * (WS_H1 - WS_H0); u.a = uptr(hg + (size_t)pm * TSTEP8); u.b = uptr(w + (size_t)(g * 2048 + pn * 256) * 1024); u.pm = pm; u.pn = pn; u.aux = g; return true; }
};
struct EpiRopeA {
    static constexpr bool PERM = true;
    bf16* QA; bf16* KA;
    __device__ __forceinline__ void operator()(const pg8::f32x4 (&acc)[2][2][4][2], const pg8::Unit& u, int wr, int wc, int fr_in, int fq_in) const {
        const int ln_ = lane_id(), fr = ln_ & 15, fq = ln_ >> 4; (void)fr_in; (void)fq_in;
        const int g = u.aux, j = u.pn >> 2, head = (u.pn & 3) * 4 + wc, sh = g == 0 ? 0 : (g == 1 ? 2 : 4);
        bf16* dst = (j == 0 ? QA : KA);
        const float sc = j == 0 ? C2F : 1.0f;
        float invr[2][4];
#pragma unroll
        for (int n = 0; n < 2; ++n)
#pragma unroll
            for (int i = 0; i < 4; ++i) invr[n][i] = __builtin_amdgcn_exp2f((float)(8 * fq + 4 * n + i) * (-13.287712379549449f / 32.0f)) * 0.15915494309189535f;
#pragma unroll
        for (int ai = 0; ai < 2; ++ai)
#pragma unroll
            for (int m = 0; m < 4; ++m) { const int p = u.pm * 256 + ai * 128 + wr * 64 + m * 16 + fr; const float pos = (float)(unperm_row(p, sh) & 2047);
                pg8::f32x4 o1[2], o2[2];
#pragma unroll
                for (int n = 0; n < 2; ++n) { pg8::f32x4 c, sn;
#pragma unroll
                    for (int i = 0; i < 4; ++i) { const float rv = __builtin_amdgcn_fractf(pos * invr[n][i]); c[i] = __builtin_amdgcn_cosf(rv); sn[i] = __builtin_amdgcn_sinf(rv); }
                    const pg8::f32x4 x1 = acc[ai][0][m][n], x2 = acc[ai][1][m][n];
                    o1[n] = (x1 * c - x2 * sn) * sc; o2[n] = (x2 * c + x1 * sn) * sc; }
                const int r = p & 31, slot = j == 0 ? r : swap23(r);
                bf16* cp2 = dst + qk_chunk(g, head, p >> 5) + (size_t)(((fq >> 1) * 2 + (fq & 1)) * 32 + slot) * 8;
                *(GAS v4u*)cp2 = pack8(o1[0], o1[1]); *(GAS v4u*)(cp2 + 2 * 2 * 32 * 8) = pack8(o2[0], o2[1]); }
    }
};
struct SchedInaV {
    pg8::GridOrder go; const char* h0; const char* w;
    __device__ __forceinline__ bool next(int i, pg8::Unit& u) const { int pv, pn; if (!go.tile(i, pv, pn)) return false; pv = rfl(pv); pn = rfl(pn); const int g = pv >> 2, pmf = pv & 3;
        const char* hg = h0 + (size_t)g * (WS_H1 - WS_H0); u.a = uptr(w + (size_t)(g * 1024 + pmf * 256) * 1024); u.b = uptr(hg + (size_t)pn * TSTEP8); u.pm = pmf; u.pn = pn; u.aux = g; return true; }
};
struct EpiVt {
    static constexpr bool PERM = true;
    bf16* VT;
    __device__ __forceinline__ void operator()(const pg8::f32x4 (&acc)[2][2][4][2], const pg8::Unit& u, int wr, int wc, int fr_in, int fq_in) const {
        const int ln_ = lane_id(), fr = ln_ & 15, fq = ln_ >> 4; (void)fr_in; (void)fq_in;
#pragma unroll
        for (int ai = 0; ai < 2; ++ai)
#pragma unroll
            for (int m = 0; m < 4; ++m) { const int f = u.pm * 256 + ai * 128 + wr * 64 + m * 16 + fr, h = f >> 6, db = (f >> 5) & 1, dd = f & 31;
                bf16* cp2 = VT + (size_t)((((fq >> 1) * 2 + db) * 2 + (fq & 1)) * 32 + dd) * 8;
#pragma unroll
                for (int bj = 0; bj < 2; ++bj) *(GAS v4u*)(cp2 + qk_chunk(u.aux, h, u.pn * 8 + bj * 4 + wc)) = pack8(acc[ai][bj][m][0], acc[ai][bj][m][1]); }
    }
};
struct EpiInB {
    static constexpr bool PERM = true;
    bf16* QB; bf16* KB; bf16* VB; const float* gq; const float* gk;
    __device__ __forceinline__ void operator()(const pg8::f32x4 (&acc)[2][2][4][2], const pg8::Unit& u, int wr, int wc, int fr_in, int fq_in) const {
        const int ln_ = lane_id(), fr = ln_ & 15, fq = ln_ >> 4; (void)fr_in; (void)fq_in;
        const int pn = u.pn, A = fq >> 1, f8 = 8 * (fq & 1), off0 = 64 * A + 2 * f8;
        const bool isq = pn < 4, isv = pn == 5; const float* gv = isq ? gq : gk; const float sc = isq ? C2F : 1.0f;
        bf16* dst = QB + (pn * 4 + wc) * 64; const size_t pitch = 1024;
        pg8::f32x4 gg[2][2];
#pragma unroll
        for (int bj = 0; bj < 2; ++bj)
#pragma unroll
            for (int n = 0; n < 2; ++n) gg[bj][n] = isv ? (pg8::f32x4){1.f, 1.f, 1.f, 1.f} : *(const pg8::f32x4*)(gv + 32 * A + 16 * bj + f8 + 4 * n);
        float invr[2][4];
#pragma unroll
        for (int n = 0; n < 2; ++n)
#pragma unroll
            for (int i = 0; i < 4; ++i) invr[n][i] = __builtin_amdgcn_exp2f((float)(f8 + 4 * n + i) * (-13.287712379549449f / 16.0f)) * 0.15915494309189535f;
#pragma unroll
        for (int ai = 0; ai < 2; ++ai)
#pragma unroll
            for (int m = 0; m < 4; ++m) { const int t0 = u.pm * 256 + ai * 128 + wr * 64 + m * 16, s = (t0 + fr) & 2047;
                float ss = 0.f;
#pragma unroll
                for (int bj = 0; bj < 2; ++bj)
#pragma unroll
                    for (int n = 0; n < 2; ++n) { const pg8::f32x4 x = acc[ai][bj][m][n]; ss += (x[0] * x[0] + x[1] * x[1]) + (x[2] * x[2] + x[3] * x[3]); }
                ss += __shfl_xor(ss, 16); ss += __shfl_xor(ss, 32);
                const float rstd = isv ? 1.0f : rsqrtf(ss * (1.f / 64.f) + NORM_EPS) * sc;
                const float pos = (float)(A == 0 ? (s >> 6) : (s & 63));
                pg8::f32x4 o1[2], o2[2];
#pragma unroll
                for (int n = 0; n < 2; ++n) { const pg8::f32x4 x1 = acc[ai][0][m][n] * rstd * gg[0][n], x2 = acc[ai][1][m][n] * rstd * gg[1][n];
                    if (isv) { o1[n] = x1; o2[n] = x2; }
                    else { pg8::f32x4 c, sn;
#pragma unroll
                        for (int i = 0; i < 4; ++i) { const float rv = __builtin_amdgcn_fractf(pos * invr[n][i]); c[i] = __builtin_amdgcn_cosf(rv); sn[i] = __builtin_amdgcn_sinf(rv); }
                        o1[n] = x1 * c - x2 * sn; o2[n] = x2 * c + x1 * sn; } }
                if (isq) store_rows128((unsigned char*)(dst + (size_t)t0 * pitch), pitch * 2, fr, off0, off0 + 32, pack8(o1[0], o1[1]), pack8(o2[0], o2[1]));
                else {
                    const int t = t0 + fr, bq = t >> 11, r64 = t & 63; bf16* blk = KB + (isv ? (size_t)((WS_VB - WS_KB) / 2) : (size_t)0) + ((size_t)(bq * 4 + wc) * 32 + ((t & 2047) >> 6)) * 4096;
                    if (!isv) { bf16* kp = blk + (4 * A + (fq & 1)) * 512 + r64 * 8;
                        *(GAS v4u*)kp = pack8(o1[0], o1[1]); *(GAS v4u*)(kp + 2 * 512) = pack8(o2[0], o2[1]); }
                    else { bf16* vp = blk + (A * 4 + (r64 >> 4)) * 512 + (r64 & 15) * 32 + (fq & 1) * 8;
                        *(GAS v4u*)vp = pack8(o1[0], o1[1]); *(GAS v4u*)(vp + 16) = pack8(o2[0], o2[1]); }
                } }
    }
};
struct SchedMoe {
    pg8::GridOrder go; const char* A; const char* W; size_t wstride; const LAS unsigned char* texp;
    __device__ __forceinline__ bool next(int i, pg8::Unit& u) const { int pm, pn; if (!go.tile(i, pm, pn)) return false; pm = rfl(pm); pn = rfl(pn); const int e = rfl((int)texp[pm]);
        u.a = uptr(A + (size_t)pm * TSTEP8); u.b = uptr(W + (size_t)e * wstride + (size_t)pn * TSTEP8); u.pm = pm; u.pn = pn; u.aux = e; return true; }
};
static_assert(pg8::GATHER_LDS == T_LG2 && LDS_BYTES - pg8::GATHER_LDS >= 16384, "gather offset slots");
struct SchedMoeG {
    pg8::GridOrder go; const char* A; const char* W; size_t wstride; const LAS unsigned char* texp; const int* tokof;
    __device__ __forceinline__ bool next(int i, pg8::Unit& u) const { int pm, pn; if (!go.tile(i, pm, pn)) return false; pm = rfl(pm); pn = rfl(pn); const int e = rfl((int)texp[pm]);
        u.a = uptr(A); u.b = uptr(W + (size_t)e * wstride + (size_t)pn * TSTEP8); u.pm = pm; u.pn = pn; u.aux = e; return true; }
};
struct EpiSwiglu {
    static constexpr bool PERM = true;
    unsigned char* ACT; const float* bup;
    __device__ __forceinline__ void operator()(const pg8::f32x4 (&acc)[2][2][4][2], const pg8::Unit& u, int wr, int wc, int fr_in, int fq_in) const {
        const int ln_ = lane_id(), fr = ln_ & 15, fq = ln_ >> 4; (void)fr_in; (void)fq_in;
        const int cj = u.pn * 128 + wc * 32 + 8 * fq; const float* bb = bup + (size_t)u.aux * 2048 + cj;
        pg8::f32x4 bg[2], bl[2];
#pragma unroll
        for (int n = 0; n < 2; ++n) { bg[n] = *(const pg8::f32x4*)(bb + 4 * n); bl[n] = *(const pg8::f32x4*)(bb + 1024 + 4 * n); }
#pragma unroll
        for (int ai = 0; ai < 2; ++ai)
#pragma unroll
            for (int m = 0; m < 4; ++m) { pg8::f32x4 a[2];
#pragma unroll
                for (int n = 0; n < 2; ++n) { const pg8::f32x4 gl = acc[ai][0][m][n] + bg[n], li = acc[ai][1][m][n] + bl[n];
#pragma unroll
                    for (int i = 0; i < 4; ++i) { const float gx = fminf(gl[i], 7.0f), lx = fminf(fmaxf(li[i], -7.0f), 7.0f);
                        a[n][i] = gx * __builtin_amdgcn_rcpf(1.0f + __builtin_amdgcn_exp2f(gx * (-1.702f * 1.4426950408889634f))) * (lx + 1.0f); } }
                u32x2v o8; o8.x = pk4_fp8(a[0][0], a[0][1], a[0][2], a[0][3]); o8.y = pk4_fp8(a[1][0], a[1][1], a[1][2], a[1][3]);
                *(GAS u32x2v*)(ACT + (size_t)(u.pm * 256 + ai * 128 + wr * 64 + m * 16 + fr) * 1024 + cj) = o8; }
    }
};
struct EpiDown {
    static constexpr bool PERM = true;
    unsigned char* OUTS; const float* bdn; const float* gsort;
    __device__ __forceinline__ void operator()(const pg8::f32x4 (&acc)[2][2][4][2], const pg8::Unit& u, int wr, int wc, int fr_in, int fq_in) const {
        const int ln_ = lane_id(), fr = ln_ & 15, fq = ln_ >> 4; (void)fr_in; (void)fq_in;
        const int c0 = u.pn * 256 + wc * 64 + 16 * fq; const float* bb = bdn + (size_t)u.aux * 1024 + c0;
        pg8::f32x4 bv[2][2];
#pragma unroll
        for (int bj = 0; bj < 2; ++bj)
#pragma unroll
            for (int n = 0; n < 2; ++n) bv[bj][n] = *(const pg8::f32x4*)(bb + 8 * bj + 4 * n);
#pragma unroll
        for (int ai = 0; ai < 2; ++ai)
#pragma unroll
            for (int m = 0; m < 4; ++m) { const int row0 = u.pm * 256 + ai * 128 + wr * 64 + m * 16; const float gt = gsort[row0 + fr] * OUTS_SCALE; v4u o;
#pragma unroll
                for (int bj = 0; bj < 2; ++bj)
#pragma unroll
                    for (int n = 0; n < 2; ++n) { const pg8::f32x4 v = (acc[ai][bj][m][n] + bv[bj][n]) * gt;
                        o[bj * 2 + n] = pk4_fp8(__builtin_amdgcn_fmed3f(v[0], -448.f, 448.f), __builtin_amdgcn_fmed3f(v[1], -448.f, 448.f), __builtin_amdgcn_fmed3f(v[2], -448.f, 448.f), __builtin_amdgcn_fmed3f(v[3], -448.f, 448.f)); }
                *(GAS v4u*)(OUTS + (size_t)(row0 + fr) * 1024 + c0) = o; }
    }
};

__device__ __forceinline__ unsigned p3_swz(int row, int byte) { return (unsigned)(row * 128 + ((((byte >> 4) ^ (row ^ (row >> 4))) & 7) << 4) + (byte & 15)); }
struct P3Out { f32x16 O0, O1; float lse; };
__device__ __forceinline__ P3Out p3_wave_unit(const bf16* QA, const bf16* KA, const bf16* VTA, int g, int h, int p0, int lane) {
    const int r32 = lane & 31, hi = lane >> 5;
    const int sh = g == 0 ? 0 : (g == 1 ? 2 : 4), Lsh = 11 - sh;
    const int seqbase = p0 & ~((1 << Lsh) - 1), jq = (p0 & ((1 << Lsh) - 1)) >> 5, nch = 1 << (Lsh - 5);
    const int lo8 = (hi * 32 + r32) * 8;
    const bf16* Qg = QA + qk_chunk(g, h, p0 >> 5) + lo8;
    const bf16* Kg = KA + qk_chunk(g, h, seqbase >> 5) + lo8;
    const bf16* Vg = VTA + qk_chunk(g, h, seqbase >> 5) + lo8;
    bf16x8 qf[4], kf[5][4]; int cc[5]; bool ok[5];
#pragma unroll
    for (int d0 = 0; d0 < 4; ++d0) qf[d0] = *(const GAS bf16x8*)(Qg + d0 * 512);
#pragma unroll
    for (int ci = 0; ci < 5; ++ci) { const int c = jq - 2 + ci; ok[ci] = (c >= 0) && (c < nch); cc[ci] = c < 0 ? 0 : (c >= nch ? nch - 1 : c);
        const bf16* kp = Kg + (size_t)cc[ci] * 2048;
#pragma unroll
        for (int d0 = 0; d0 < 4; ++d0) kf[ci][d0] = *(const GAS bf16x8*)(kp + d0 * 512); }
    f32x16 S[5];
#pragma unroll
    for (int ci = 0; ci < 5; ++ci) { f32x16 a = {};
#pragma unroll
        for (int d0 = 0; d0 < 4; ++d0) a = __builtin_amdgcn_mfma_f32_32x32x16_bf16(kf[ci][d0], qf[d0], a, 0, 0, 0);
        S[ci] = a; }
    bf16x8 vf[5][2][2];
#pragma unroll
    for (int ci = 0; ci < 5; ++ci)
#pragma unroll
        for (int s2 = 0; s2 < 2; ++s2) { const bf16* vp = Vg + (size_t)cc[ci] * 2048 + s2 * 1024; vf[ci][s2][0] = *(const GAS bf16x8*)vp; vf[ci][s2][1] = *(const GAS bf16x8*)(vp + 512); }
#pragma unroll
    for (int ci = 0; ci < 5; ++ci)
#pragma unroll
        for (int i = 0; i < 16; ++i) { const int kk = 16 * (i >> 3) + 8 * hi + (i & 7);
            bool keep = ok[ci]; if (ci == 0) keep = keep && (kk >= r32); if (ci == 4) keep = keep && (kk <= r32);
            S[ci][i] = keep ? S[ci][i] : -INFINITY; }
    float mx = -INFINITY;
#pragma unroll
    for (int ci = 0; ci < 5; ++ci)
#pragma unroll
        for (int i = 0; i < 16; ++i) mx = fmaxf(mx, S[ci][i]);
    mx = fmaxf(mx, __shfl_xor(mx, 32));
    float sum = 0.f;
#pragma unroll
    for (int ci = 0; ci < 5; ++ci)
#pragma unroll
        for (int i = 0; i < 16; ++i) { const float p = __builtin_amdgcn_exp2f(S[ci][i] - mx); S[ci][i] = p; sum += p; }
    sum += __shfl_xor(sum, 32);
    P3Out R; R.O0 = f32x16{}; R.O1 = f32x16{};
#pragma unroll
    for (int ci = 0; ci < 5; ++ci)
#pragma unroll
        for (int s2 = 0; s2 < 2; ++s2) { v4u pw; pw.x = pkbf(S[ci][8 * s2 + 0], S[ci][8 * s2 + 1]); pw.y = pkbf(S[ci][8 * s2 + 2], S[ci][8 * s2 + 3]); pw.z = pkbf(S[ci][8 * s2 + 4], S[ci][8 * s2 + 5]); pw.w = pkbf(S[ci][8 * s2 + 6], S[ci][8 * s2 + 7]);
            const bf16x8 pf = __builtin_bit_cast(bf16x8, pw);
            R.O0 = __builtin_amdgcn_mfma_f32_32x32x16_bf16(vf[ci][s2][0], pf, R.O0, 0, 0, 0); R.O1 = __builtin_amdgcn_mfma_f32_32x32x16_bf16(vf[ci][s2][1], pf, R.O1, 0, 0, 0); }
    const float inv = 1.0f / sum;
#pragma unroll
    for (int i = 0; i < 16; ++i) { R.O0[i] *= inv; R.O1[i] *= inv; }
    R.lse = (mx + __builtin_amdgcn_logf(sum)) * LN2F;
    return R;
}
__device__ __forceinline__ void p3_attn_a(Frame& F) {
    unsigned char* const wsl = opaque_ptr(F.ws);
    const int lane = lane_id(); const int r32 = lane & 31, hi = lane >> 5, w = F.wave;
    const bf16* QA = (const bf16*)(wsl + WS_QA); const bf16* KA = (const bf16*)(wsl + WS_KA); const bf16* VTA = (const bf16*)(wsl + WS_VTA);
    bf16* O = (bf16*)(wsl + WS_O);
    LAS unsigned char* OL = F.lds;
    LAS float* LL = (LAS float*)(F.lds + 131072);
    for (int bu = blockIdx.x; bu < 512; bu += F.G) {
        const int b = bu >> 6, h = (bu >> 2) & 15, ch = bu & 3, tok0 = b * 2048 + 512 * ch;
#pragma unroll 1
        for (int k = 0; k < 4; ++k) { const int g = 2 - (k >> 1), wu = w + 8 * (k & 1), sh = g == 1 ? 2 : 4;
            const int p0 = b * 2048 + (wu & ((1 << sh) - 1)) * (2048 >> sh) + ((512 * ch) >> sh) + 32 * (wu >> sh);
            const P3Out R = p3_wave_unit(QA, KA, VTA, g, h, p0, lane);
            const int x = unperm_row(p0 + r32, sh) - tok0;
            LAS unsigned char* og = OL + (g - 1) * 65536;
#pragma unroll
            for (int i4 = 0; i4 < 4; ++i4) { u32x2v w0, w1; w0.x = pkbf(R.O0[4 * i4], R.O0[4 * i4 + 1]); w0.y = pkbf(R.O0[4 * i4 + 2], R.O0[4 * i4 + 3]); w1.x = pkbf(R.O1[4 * i4], R.O1[4 * i4 + 1]); w1.y = pkbf(R.O1[4 * i4 + 2], R.O1[4 * i4 + 3]);
                *(LAS u32x2v*)(og + p3_swz(x, 16 * i4 + 8 * hi)) = w0; *(LAS u32x2v*)(og + p3_swz(x, 64 + 16 * i4 + 8 * hi)) = w1; }
            if (hi == 0) LL[(g - 1) * 512 + x] = R.lse;
        }
        __syncthreads();
#pragma unroll 1
        for (int k = 0; k < 2; ++k) { const int wu = w + 8 * k, p0 = tok0 + 32 * wu, x = 32 * wu + r32;
            const P3Out R = p3_wave_unit(QA, KA, VTA, 0, h, p0, lane);
            const float l0 = R.lse, l1 = LL[x], l2 = LL[512 + x], m = fmaxf(l0, fmaxf(l1, l2));
            float w0f = __expf(l0 - m), w1f = __expf(l1 - m), w2f = __expf(l2 - m); const float iw = 1.0f / (w0f + w1f + w2f); w0f *= iw; w1f *= iw; w2f *= iw;
#pragma unroll
            for (int i4 = 0; i4 < 4; ++i4)
#pragma unroll
                for (int db = 0; db < 2; ++db) { const unsigned off = p3_swz(x, 64 * db + 16 * i4 + 8 * hi);
                    const u32x2v a1 = *(const LAS u32x2v*)(OL + off), a2 = *(const LAS u32x2v*)(OL + 65536 + off);
                    const f32x16& Og = db == 0 ? R.O0 : R.O1; u32x2v o;
                    o.x = pkbf(Og[4 * i4] * w0f + bflo(a1.x) * w1f + bflo(a2.x) * w2f, Og[4 * i4 + 1] * w0f + bfhi(a1.x) * w1f + bfhi(a2.x) * w2f);
                    o.y = pkbf(Og[4 * i4 + 2] * w0f + bflo(a1.y) * w1f + bflo(a2.y) * w2f, Og[4 * i4 + 3] * w0f + bfhi(a1.y) * w1f + bfhi(a2.y) * w2f);
                    *(LAS u32x2v*)(OL + off) = o; }
            LDS_WAIT(); asm volatile("" ::: "memory");
#pragma unroll
            for (int s4 = 0; s4 < 4; ++s4) { const int q = 8 * s4 + (lane >> 3), xr = 32 * wu + q; const v4u o = *(const LAS v4u*)(OL + p3_swz(xr, 16 * (lane & 7)));
                *(GAS v4u*)(O + (size_t)(tok0 + xr) * 1024 + h * 64 + 8 * (lane & 7)) = o; }
        }
        __syncthreads();
    }
}
__device__ __forceinline__ void p6a(Frame& F, const Args& args, int layer, const float* xin) {
    unsigned char* const wsl = opaque_ptr(F.ws);
    const int lane = lane_id(); const int w = F.wave;
    const int tokb = blockIdx.x * 64, b = tokb >> 11;
    const float* MOD = (const float*)(wsl + WS_MOD);
    const float* m0 = MOD + (size_t)((layer * 2 + 0) * 8 + b) * 3072; const float* m1 = MOD + (size_t)((layer * 2 + 1) * 8 + b) * 3072;
    const bf16* Y = (const bf16*)(wsl + WS_Y); bf16* XA = (bf16*)(wsl + WS_XA); unsigned char* H2N8 = wsl + WS_H1;
    const bf16* WH = (const bf16*)(wsl + WS_WRT) + (size_t)layer * 32 * 1024; const bf16* WL = WH + 65536;
    const float* br = args.in[IN_BROUTER] + layer * 32;
    LAS int* SEL = (LAS int*)(F.lds + T_SEL); LAS float* GTE = (LAS float*)(F.lds + T_GTE); LAS int* RNK = (LAS int*)(F.lds + T_RNK); LAS float* LG = (LAS float*)(F.lds + T_LG);
    for (int rnd = 0; rnd < 2; ++rnd) {
        SEC_BEGIN(1);
#pragma unroll
        for (int tt = 0; tt < 4; ++tt) { const int row = w * 4 + tt, rl = rnd * 32 + row, t = tokb + rl;
            f32x4 y[4], x[4]; float ss = 0.f;
#pragma unroll
            for (int j = 0; j < 4; ++j) { const u32x2v yy = *(const GAS u32x2v*)(Y + (size_t)t * D + 4 * lane + 256 * j); y[j] = (f32x4){bflo(yy.x), bfhi(yy.x), bflo(yy.y), bfhi(yy.y)};
                if (layer == 0) x[j] = *(const GAS f32x4*)(xin + (size_t)t * D + 4 * lane + 256 * j);
                else { const u32x2v xx = *(const GAS u32x2v*)((const bf16*)xin + (size_t)t * D + 4 * lane + 256 * j); x[j] = (f32x4){bflo(xx.x), bfhi(xx.x), bflo(xx.y), bfhi(xx.y)}; }
                ss += dot4(y[j], y[j]); }
            const float rstd1 = rsqrtf(wave_sum(ss) * (1.f / D) + NORM_EPS);
            float ss2 = 0.f;
#pragma unroll
            for (int j = 0; j < 4; ++j) { const int c = 4 * lane + 256 * j; const f32x4 A1 = *(const f32x4*)(m0 + 2048 + c) * *(const f32x4*)(args.in[IN_GPOSTMIX] + layer * 1024 + c);
                x[j] = x[j] + A1 * (y[j] * rstd1); { u32x2v px; px.x = pkbf(x[j][0], x[j][1]); px.y = pkbf(x[j][2], x[j][3]); *(GAS u32x2v*)(XA + (size_t)t * D + c) = px; } ss2 += dot4(x[j], x[j]); }
            const float rstd2 = rsqrtf(wave_sum(ss2) * (1.f / D) + NORM_EPS);
#pragma unroll
            for (int j = 0; j < 4; ++j) { const int c = 4 * lane + 256 * j; const f32x4 A2 = *(const f32x4*)(args.in[IN_GPREFFN] + layer * 1024 + c) * (*(const f32x4*)(m1 + 1024 + c) + 1.0f), S2 = *(const f32x4*)(m1 + c);
                const f32x4 hh = x[j] * rstd2 * A2 + S2; u32x2v ph, pl; ph.x = pkbf(hh[0], hh[1]); ph.y = pkbf(hh[2], hh[3]);
                pl.x = pkbf(hh[0] - bflo(ph.x), hh[1] - bfhi(ph.x)); pl.y = pkbf(hh[2] - bflo(ph.y), hh[3] - bfhi(ph.y));
                *(GAS unsigned*)(H2N8 + (size_t)t * D + c) = pk4_fp8(hh[0], hh[1], hh[2], hh[3]);
                *(LAS u32x2v*)(F.lds + row * RT_PITCH + c * 2) = ph; *(LAS u32x2v*)(F.lds + RT_LO + row * RT_PITCH + c * 2) = pl; }
        }
        __syncthreads();
        SEC_END(1); SEC_BEGIN(2);
        {
            const int th = w & 1, eh = (w >> 1) & 1, kh = w >> 2, l16 = lane & 15, kg = lane >> 4;
            const LAS unsigned char* ah = F.lds + (16 * th + l16) * RT_PITCH + kg * 16 + kh * 1024; const LAS unsigned char* al = ah + RT_LO;
            const bf16* bh = WH + (size_t)(16 * eh + l16) * 1024 + kg * 8 + kh * 512; const bf16* bl = WL + (size_t)(16 * eh + l16) * 1024 + kg * 8 + kh * 512;
            bf16x8 b_h[16], b_l[16];
#pragma unroll
            for (int ks = 0; ks < 16; ++ks) { b_h[ks] = *(const GAS bf16x8*)(bh + ks * 32); b_l[ks] = *(const GAS bf16x8*)(bl + ks * 32); }
            f32x4 acc = {0.f, 0.f, 0.f, 0.f};
#pragma unroll
            for (int ks = 0; ks < 16; ++ks) { const bf16x8 a_h = *(const LAS bf16x8*)(ah + ks * 64), a_l = *(const LAS bf16x8*)(al + ks * 64);
                acc = __builtin_amdgcn_mfma_f32_16x16x32_bf16(a_l, b_h[ks], acc, 0, 0, 0); acc = __builtin_amdgcn_mfma_f32_16x16x32_bf16(a_h, b_l[ks], acc, 0, 0, 0); acc = __builtin_amdgcn_mfma_f32_16x16x32_bf16(a_h, b_h[ks], acc, 0, 0, 0); }
            LAS float* lgp = kh == 0 ? LG : (LAS float*)(F.lds + T_LG2);
#pragma unroll
            for (int i = 0; i < 4; ++i) lgp[(16 * th + 4 * kg + i) * 32 + 16 * eh + l16] = acc[i];
        }
        __syncthreads();
        SEC_END(2); SEC_BEGIN(3);
        { const int l16 = lane & 15, row = w * 4 + (lane >> 4);
            const LAS float* LG2 = (const LAS float*)(F.lds + T_LG2);
            float v0 = (LG[row * 32 + l16] + LG2[row * 32 + l16]) + br[l16], v1 = (LG[row * 32 + 16 + l16] + LG2[row * 32 + 16 + l16]) + br[16 + l16]; const int i0 = l16, i1 = l16 + 16;
            float selv[4]; int seli[4];
#pragma unroll
            for (int kk = 0; kk < 4; ++kk) { float bv = v0; int bi = i0; if (v1 > bv) { bv = v1; bi = i1; }
#pragma unroll
                for (int off = 8; off > 0; off >>= 1) { const float ov = __shfl_xor(bv, off); const int oi = __shfl_xor(bi, off); if (ov > bv || (ov == bv && oi < bi)) { bv = ov; bi = oi; } }
                selv[kk] = bv; seli[kk] = bi; if (bi == i0) v0 = -INFINITY; if (bi == i1) v1 = -INFINITY; }
            const float p1 = __expf(selv[1] - selv[0]), p2 = __expf(selv[2] - selv[0]), p3 = __expf(selv[3] - selv[0]), ip = 1.0f / (1.0f + p1 + p2 + p3);
            if (l16 == 0) { const int rl = rnd * 32 + row;
                SEL[rl * 4 + 0] = seli[0]; SEL[rl * 4 + 1] = seli[1]; SEL[rl * 4 + 2] = seli[2]; SEL[rl * 4 + 3] = seli[3];
                GTE[rl * 4 + 0] = ip; GTE[rl * 4 + 1] = p1 * ip; GTE[rl * 4 + 2] = p2 * ip; GTE[rl * 4 + 3] = p3 * ip; }
        }
        SEC_END(3);
    }
    SEC_BEGIN(4);
    __syncthreads();
    if (w == 0) {
        const int s0 = SEL[lane * 4 + 0], s1 = SEL[lane * 4 + 1], s2 = SEL[lane * 4 + 2], s3 = SEL[lane * 4 + 3];
        int r0 = 0, r1 = 0, r2 = 0, r3 = 0, cnt = 0;
        const unsigned long long below = (1ull << lane) - 1ull;
        for (int e = 0; e < 32; ++e) { const bool has = (s0 == e) | (s1 == e) | (s2 == e) | (s3 == e); const unsigned long long mk = __ballot(has); const int rk = __popcll(mk & below);
            if (s0 == e) r0 = rk; if (s1 == e) r1 = rk; if (s2 == e) r2 = rk; if (s3 == e) r3 = rk; if (lane == e) cnt = __popcll(mk); }
        RNK[lane * 4 + 0] = r0; RNK[lane * 4 + 1] = r1; RNK[lane * 4 + 2] = r2; RNK[lane * 4 + 3] = r3;
        if (lane < 32) ((int*)(wsl + WS_HIST))[blockIdx.x * 32 + lane] = cnt;
    }
    SEC_END(4);
}
__device__ __forceinline__ void moe_tile_table(Frame& F, const int* tot  ) {
    if (F.wave == 0) { const int lane = lane_id(); LAS unsigned char* TEXP = (LAS unsigned char*)(F.lds + T_TEXP);
        const int nt = lane < 32 ? ((tot[lane & 31] + 255) >> 8) : 0; int inc = nt;
#pragma unroll
        for (int o = 1; o < 32; o <<= 1) { const int v = __shfl_up(inc, o); if ((lane & 31) >= o) inc += v; }
        const int first = inc - nt;
        for (int q = 0; q < nt; ++q) TEXP[first + q] = (unsigned char)lane;
        if (lane == 31) *(LAS int*)(F.lds + T_MT) = inc; }
}
__device__ __forceinline__ void p6b(Frame& F) {
    unsigned char* const wsl = opaque_ptr(F.ws);
    const int lane = lane_id(); const int w = F.wave, tokb = blockIdx.x * 64;
    LAS int* SEL = (LAS int*)(F.lds + T_SEL); LAS float* GTE = (LAS float*)(F.lds + T_GTE); LAS int* RNK = (LAS int*)(F.lds + T_RNK);
    LAS int* TOT = (LAS int*)(F.lds + T_TOT); LAS int* BEF = (LAS int*)(F.lds + T_BEF); LAS int* MYOFF = (LAS int*)(F.lds + T_MYOFF);
    const int* HIST = (const int*)(wsl + WS_HIST);
    const int tid = F.wave * 64 + lane;
    SEC_BEGIN(5);
    {
        LAS int* PT = (LAS int*)(F.lds + 65536); LAS int* PB = PT + 512;
        const int e = tid & 31, part = tid >> 5; int c[16];
#pragma unroll
        for (int k = 0; k < 16; ++k) c[k] = HIST[(part * 16 + k) * 32 + e];
        int tot = 0, bef = 0;
#pragma unroll
        for (int k = 0; k < 16; ++k) { tot += c[k]; bef += (part * 16 + k < (int)blockIdx.x) ? c[k] : 0; }
        PT[part * 32 + e] = tot; PB[part * 32 + e] = bef;
        __syncthreads();
        if (tid < 32) { int t2 = 0, b2 = 0;
#pragma unroll
            for (int k = 0; k < 16; ++k) { t2 += PT[k * 32 + tid]; b2 += PB[k * 32 + tid]; }
            TOT[tid] = t2; BEF[tid] = b2; if (blockIdx.x == 0) ((int*)(wsl + WS_TOT))[tid] = t2; }
    }
    __syncthreads();
    if (w == 0) { const int nt = lane < 32 ? ((TOT[lane & 31] + 255) >> 8) : 0; int inc = nt;
#pragma unroll
        for (int o = 1; o < 32; o <<= 1) { const int v = __shfl_up(inc, o); if ((lane & 31) >= o) inc += v; }
        if (lane < 32) MYOFF[lane] = (inc - nt) * 256 + BEF[lane];
        LAS unsigned char* TEXP = (LAS unsigned char*)(F.lds + T_TEXP); const int first = inc - nt;
        for (int q = 0; q < nt; ++q) TEXP[first + q] = (unsigned char)lane;
        if (lane == 31) *(LAS int*)(F.lds + T_MT) = inc; }
    __syncthreads();
    int* TOKOF = (int*)(wsl + WS_XS); float* GS = (float*)(wsl + WS_GSORT); int* POSOF = (int*)(wsl + WS_POSOF);
    SEC_END(5); SEC_BEGIN(6);
    if (tid < 256) { const int e = SEL[tid]; const int pos = MYOFF[e] + RNK[tid];
        TOKOF[pos] = tokb + (tid >> 2); GS[pos] = GTE[tid]; POSOF[tokb * 4 + tid] = pos; }
    if (blockIdx.x < 32) { const int e = blockIdx.x, cnt = TOT[e], base = MYOFF[e] - BEF[e], end = (cnt + 255) & ~255;
        for (int i = cnt + tid; i < end; i += NWAVES * 64) TOKOF[base + i] = 0; }
    asm volatile("s_waitcnt vmcnt(0)" ::: "memory");
    SEC_END(6);
}
__device__ __forceinline__ void p9_post(Frame& F, const Args& args, int layer) {
    unsigned char* const wsl = opaque_ptr(F.ws);
    const int lane = lane_id(); const int gw = blockIdx.x * NWAVES + F.wave, NGW = F.G * NWAVES;
    const bool last = layer == 1;
    const float* MOD = (const float*)(wsl + WS_MOD);
    const unsigned char* OUTS = wsl + WS_OUTS; const int* POSOF = (const int*)(wsl + WS_POSOF); bf16* XA = (bf16*)(wsl + WS_XA); bf16* H0 = (bf16*)(wsl + WS_H0);
    for (int t0 = gw * 8; t0 < T; t0 += NGW * 8) {
        const int b = t0 >> 11;
        const float* m1 = MOD + (size_t)((layer * 2 + 1) * 8 + b) * 3072; const float* mn = MOD + (size_t)((1 * 2 + 0) * 8 + b) * 3072;
        f32x4 A3[4], A4[4], S4[4];
#pragma unroll
        for (int j = 0; j < 4; ++j) { const int c = 4 * lane + 256 * j;
            A3[j] = *(const f32x4*)(m1 + 2048 + c) * *(const f32x4*)(args.in[IN_GPOSTFFN] + layer * 1024 + c);
            A4[j] = *(const f32x4*)(args.in[IN_GPREMIX] + 1024 + c) * (*(const f32x4*)(mn + 1024 + c) + 1.0f); S4[j] = *(const f32x4*)(mn + c); }
        const int posv = POSOF[t0 * 4 + (lane & 31)];
        for (int i0 = 0; i0 < 8; i0 += 2) {
            unsigned q[2][4][4]; u32x2v xr[2][4];
#pragma unroll
            for (int u = 0; u < 2; ++u) { const int t = t0 + i0 + u;
#pragma unroll
                for (int k = 0; k < 4; ++k) { const int p = __builtin_amdgcn_readlane(posv, (i0 + u) * 4 + k);
#pragma unroll
                    for (int j = 0; j < 4; ++j) q[u][k][j] = *(const GAS unsigned*)(OUTS + (size_t)p * 1024 + 4 * lane + 256 * j); }
#pragma unroll
                for (int j = 0; j < 4; ++j) xr[u][j] = *(const GAS u32x2v*)(XA + (size_t)t * D + 4 * lane + 256 * j); }
#pragma unroll
            for (int u = 0; u < 2; ++u) { const int t = t0 + i0 + u;
                f32x4 y[4]; float ss = 0.f;
#pragma unroll
                for (int j = 0; j < 4; ++j) { const unsigned a = q[u][0][j], bq = q[u][1][j], cq = q[u][2][j], dq = q[u][3][j];
                    const f32x2v al = __builtin_amdgcn_cvt_pk_f32_fp8(a, false), ah = __builtin_amdgcn_cvt_pk_f32_fp8(a, true), bl = __builtin_amdgcn_cvt_pk_f32_fp8(bq, false), bh = __builtin_amdgcn_cvt_pk_f32_fp8(bq, true);
                    const f32x2v cl = __builtin_amdgcn_cvt_pk_f32_fp8(cq, false), ch = __builtin_amdgcn_cvt_pk_f32_fp8(cq, true), dl = __builtin_amdgcn_cvt_pk_f32_fp8(dq, false), dh = __builtin_amdgcn_cvt_pk_f32_fp8(dq, true);
                    y[j] = (f32x4){((al[0] + bl[0]) + cl[0]) + dl[0], ((al[1] + bl[1]) + cl[1]) + dl[1], ((ah[0] + bh[0]) + ch[0]) + dh[0], ((ah[1] + bh[1]) + ch[1]) + dh[1]} * (1.0f / OUTS_SCALE);
                    ss += dot4(y[j], y[j]); }
                const float rstd = rsqrtf(wave_sum(ss) * (1.f / D) + NORM_EPS);
                f32x4 x[4]; float ss2 = 0.f;
#pragma unroll
                for (int j = 0; j < 4; ++j) { const u32x2v xx = xr[u][j]; x[j] = (f32x4){bflo(xx.x), bfhi(xx.x), bflo(xx.y), bfhi(xx.y)} + A3[j] * (y[j] * rstd); ss2 += dot4(x[j], x[j]); }
                if (last) {
#pragma unroll
                    for (int j = 0; j < 4; ++j) *(GAS f32x4*)(F.out + (size_t)t * D + 4 * lane + 256 * j) = x[j];
                } else {
                    const float rstd2 = rsqrtf(wave_sum(ss2) * (1.f / D) + NORM_EPS);
#pragma unroll
                    for (int j = 0; j < 4; ++j) { const int c = 4 * lane + 256 * j; { u32x2v px; px.x = pkbf(x[j][0], x[j][1]); px.y = pkbf(x[j][2], x[j][3]); *(GAS u32x2v*)(XA + (size_t)t * D + c) = px; }
                        const f32x4 hh = x[j] * rstd2 * A4[j] + S4[j]; u32x2v pw; pw.x = pkbf(hh[0], hh[1]); pw.y = pkbf(hh[2], hh[3]); *(GAS u32x2v*)(H0 + (size_t)t * D + c) = pw; }
                }
            }
        }
    }
}
constexpr int N_PHASES = 19;
#define COMMON_PHASES(layer, pb) \
    const int P_OUT = pb + 3, P_T1 = pb + 4, P_T2 = pb + 5, P_UP = pb + 6, P_DN = pb + 7, P_POST = pb + 8; \
    if (IN(P_OUT)) for (int rep_ = 0; rep_ < 1 + DUPF(P_OUT); ++rep_) { if (rep_) __syncthreads(); \
        SchedPlain S; S.go.init(64, 4, F.G, (int)blockIdx.x); S.A = (const char*)(ws + WS_O); S.B = (const char*)(ws + (layer == 0 ? WS_WOUTA : WS_WOUTB)); \
        EpiPlain E{(bf16*)(ws + WS_Y), 1024}; \
        pg8::gemm_phase<EpiPlain, SchedPlain, true, true>(F.lds, (const char*)ws, 1024, S, E, F.wave); \
    } SEAM(P_OUT); \
    if (IN(P_T1)) for (int rep_ = 0; rep_ < 1 + DUPF(P_T1); ++rep_) { if (rep_) __syncthreads(); p6a(F, args, layer, layer == 0 ? args.in[IN_X] : (const float*)(ws + WS_XA)); } SEAM(P_T1); \
    if (IN(P_T2)) for (int rep_ = 0; rep_ < 1 + DUPF(P_T2); ++rep_) { if (rep_) __syncthreads(); p6b(F); } SEAM(P_T2); \
    if (IN(P_UP)) for (int rep_ = 0; rep_ < 1 + DUPF(P_UP); ++rep_) { if (rep_) __syncthreads(); \
        SchedMoeG S; S.go.init(*(LAS int*)(F.lds + T_MT), 8, F.G, (int)blockIdx.x); S.A = (const char*)(ws + WS_H1); S.W = (const char*)(ws + WS_WUP) + (size_t)layer * 32 * 2048 * 1024; S.wstride = (size_t)2048 * 1024; \
        S.texp = (const LAS unsigned char*)(F.lds + T_TEXP); S.tokof = (const int*)(ws + WS_XS); \
        EpiSwiglu E{ws + WS_ACT, args.in[IN_BUP] + (size_t)layer * 32 * 2048}; \
        pg8::gemm_phase<EpiSwiglu, SchedMoeG, true, true, true, true>(F.lds, (const char*)ws, 512, S, E, F.wave); \
    } SEAM(P_UP); \
    if (IN(P_DN)) for (int rep_ = 0; rep_ < 1 + DUPF(P_DN); ++rep_) { if (rep_) __syncthreads(); \
        SchedMoe S; S.go.init(*(LAS int*)(F.lds + T_MT), 4, F.G, (int)blockIdx.x); S.A = (const char*)(ws + WS_ACT); S.W = (const char*)(ws + WS_WDOWN) + (size_t)layer * 32 * 1024 * 1024; S.wstride = (size_t)1024 * 1024; \
        S.texp = (const LAS unsigned char*)(F.lds + T_TEXP); \
        EpiDown E{ws + WS_OUTS, args.in[IN_BDOWN] + (size_t)layer * 32 * 1024, (const float*)(ws + WS_GSORT)}; \
        pg8::gemm_phase<EpiDown, SchedMoe, true, true, true>(F.lds, (const char*)ws, 512, S, E, F.wave); \
    } SEAM(P_DN); \
    if (IN(P_POST)) for (int rep_ = 0; rep_ < 1 + (DUPF(10) && layer == 1); ++rep_) { if (rep_) __syncthreads(); p9_post(F, args, layer); }
__global__ void __launch_bounds__(NWAVES * 64, 2) mega_fwd(Args args) {
    extern __shared__ __attribute__((aligned(16))) unsigned char lds[];
    Frame F;
    F.lds = (LAS unsigned char*)lds;
    F.MISC = (volatile LAS unsigned*)(F.lds + MISC_OFF);
    F.wave = __builtin_amdgcn_readfirstlane((int)threadIdx.x >> 6);
    F.G = gridDim.x; { const int bx = blockIdx.x; F.vcu = (bx % 8) * (F.G / 8) + bx / 8; }
    F.out = args.out; F.ws = args.ws; F.ctl = (gu32*)(args.ws + WS_CTL);
    for (int u = threadIdx.x; u < (LDS_BYTES - LDSCTL_OFF) / 4; u += NWAVES * 64) ((LAS unsigned*)(F.lds + LDSCTL_OFF))[u] = 0u;
    __syncthreads();
    XcdBarrier bar = xcd_barrier_post((unsigned*)(F.ctl + CW_BAR) + args.li * XCD_BAR_WORDS, F.MISC + 8);
    const int lo = args.ph_lo, hi = args.ph_hi;
#ifndef DUP_MASK
#define DUP_MASK 0u
#endif
#define DUPF(k) ((int)((DUP_MASK >> (k)) & 1u))
#ifndef PHMASK
#define PHMASK 0xFFFFFFFFu
#endif
#define IN(k) (((PHMASK >> ((k) > 10 ? (k) - 8 : (k))) & 1u) && lo <= (k) && (k) < hi)
#define SEAM(k) do { if (IN(k) && IN((k) + 1)) { xcd_barrier(bar); if (DUPF(20)) xcd_barrier(bar); } } while (0)

    if (IN(0)) for (int rep_ = 0; rep_ < 1 + DUPF(0); ++rep_) { if (rep_) __syncthreads(); p0_prologue(F, args); } SEAM(0);
    if (IN(1)) for (int rep_ = 0; rep_ < 1 + DUPF(1); ++rep_) { if (rep_) __syncthreads(); p1_prenorm0(F, args); } SEAM(1);

    { unsigned char* ws = opaque_ptr(args.ws);
        if (IN(2)) for (int rep_ = 0; rep_ < 1 + DUPF(2); ++rep_) { if (rep_) __syncthreads();
            { SchedInaQK S; S.go.init(64, 24, F.G, (int)blockIdx.x); S.h0 = (const char*)(ws + WS_H0); S.w = (const char*)(ws + WS_WINA_QK);
              EpiRopeA E{(bf16*)(ws + WS_QA), (bf16*)(ws + WS_KA)};
              pg8::gemm_phase<EpiRopeA, SchedInaQK, true, true, true>(F.lds, (const char*)ws, 512, S, E, F.wave); }
            { SchedInaV S; S.go.init(12, 64, F.G, (int)blockIdx.x); S.h0 = (const char*)(ws + WS_H0); S.w = (const char*)(ws + WS_WINA_V);
              EpiVt E{(bf16*)(ws + WS_VTA)};
              pg8::gemm_phase<EpiVt, SchedInaV, true, true, true>(F.lds, (const char*)ws, 512, S, E, F.wave); }
        } SEAM(2);
        if (IN(3)) for (int rep_ = 0; rep_ < 1 + DUPF(3); ++rep_) { if (rep_) __syncthreads(); p3_attn_a(F); } do { if (IN(3) && IN(5)) xcd_barrier(bar); } while (0);
    }
    { unsigned char* ws = opaque_ptr(args.ws); COMMON_PHASES(0, 2) }
    SEAM(10);
    { unsigned char* ws = opaque_ptr(args.ws);
        if (IN(11)) for (int rep_ = 0; rep_ < 1 + DUPF(11); ++rep_) { if (rep_) __syncthreads();
            SchedPlain S; S.go.init(64, 6, F.G, (int)blockIdx.x); S.A = (const char*)(ws + WS_H0); S.B = (const char*)(ws + WS_WINB);
            EpiInB E{(bf16*)(ws + WS_QB), (bf16*)(ws + WS_KB), (bf16*)(ws + WS_VB), args.in[IN_GQB], args.in[IN_GKB]};
            pg8::gemm_phase<EpiInB, SchedPlain, true, true>(F.lds, (const char*)ws, 1024, S, E, F.wave);
        } SEAM(11);
        if (IN(12)) for (int rep_ = 0; rep_ < 1 + DUPF(12); ++rep_) { if (rep_) __syncthreads();
            const int xcd = F.vcu >> 5, j = F.vcu & 31;
            for (int i = 0; i < 4; ++i) { const int pair = xcd * 4 + i, b = pair >> 2, kvh = pair & 3, hq = kvh * 4 + (j >> 3), qb = j & 7;
                attn_body::attn_unit<8>(b, hq, kvh, qb, (const attn_body::bf16*)(ws + WS_QB), (const attn_body::bf16*)(ws + WS_KB), (const attn_body::bf16*)(ws + WS_VB), (attn_body::bf16*)(ws + WS_O), (char*)lds, F.wave); }
        } SEAM(12);
    }
    { unsigned char* ws = opaque_ptr(args.ws); COMMON_PHASES(1, 10) }
    if (PSEC > 0) { __syncthreads(); const unsigned long long te_ = __builtin_amdgcn_s_memrealtime(); const unsigned dd_ = F.MISC[16]; while (__builtin_amdgcn_s_memrealtime() - te_ < dd_) __builtin_amdgcn_s_sleep(8); }
#undef IN
#undef SEAM
#undef COMMON_PHASES
}
static int g_grid = 0;
static bool mega_setup() {
    if (g_grid == 0) {
        int dev = 0, cus = 0;
        if (hipGetDevice(&dev) != hipSuccess || hipDeviceGetAttribute(&cus, hipDeviceAttributeMultiprocessorCount, dev) != hipSuccess) { g_grid = -1; return false; }
        if (hipFuncSetAttribute((const void*)mega_fwd, hipFuncAttributeMaxDynamicSharedMemorySize, LDS_BYTES) != hipSuccess) { fprintf(stderr, "hipFuncSetAttribute failed\n"); g_grid = -1; return false; }
        int per_cu = 0;
        if (hipOccupancyMaxActiveBlocksPerMultiprocessor(&per_cu, (const void*)mega_fwd, NWAVES * 64, LDS_BYTES) != hipSuccess || per_cu < 1) { fprintf(stderr, "occupancy query: %d\n", per_cu); }
        (void)hipGetLastError();
        if (cus != 256) { fprintf(stderr, "built for 256 CUs, found %d\n", cus); g_grid = -1; return false; }
        g_grid = 256;
    }
    return g_grid > 0;
}
static void mega_launch(void* const* d_in, float* out, unsigned char* ws, int lo, int hi, int li, hipStream_t stream) {
    Args a{};
    for (int i = 0; i < 20; ++i) a.in[i] = (const float*)d_in[i];
    a.out = out; a.ws = ws; a.ph_lo = lo; a.ph_hi = hi; a.li = li; a.pad = 0;
    hipLaunchKernelGGL(mega_fwd, dim3(g_grid), dim3(NWAVES * 64), LDS_BYTES, stream, a);
}
extern "C" void kernel_launch(void* const* d_in, const int* in_sizes, int n_in, void* d_out, int out_size, void* d_ws, size_t ws_size, hipStream_t stream) {
    if (n_in != 20 || ws_size < WS_END || out_size != T * D) { fprintf(stderr, "kernel_launch: unexpected n_in %d / ws %zu / out %d\n", n_in, ws_size, out_size); return; }
    if (!mega_setup()) return;
    unsigned char* ws = (unsigned char*)d_ws;
    (void)hipMemsetAsync(ws + WS_CTL, 0, CTL_ZERO_BYTES, stream);
    mega_launch(d_in, (float*)d_out, ws, 0, N_PHASES, 0, stream);
}
```

```cpp
#include <hip/hip_runtime.h>
#include <cstdio>
#include <cstdint>
#include <cmath>
#define GAS __attribute__((address_space(1)))
#define LAS __attribute__((address_space(3)))
typedef unsigned short bf16;
typedef unsigned v4u __attribute__((ext_vector_type(4)));
typedef float f32x4 __attribute__((ext_vector_type(4)));
typedef short bf16x8 __attribute__((ext_vector_type(8)));
typedef GAS unsigned gu32;
typedef GAS unsigned long long gu64;
#define RLX_AGENT __ATOMIC_RELAXED, __HIP_MEMORY_SCOPE_AGENT
#define LDS_WAIT() asm volatile("s_waitcnt lgkmcnt(0)" ::: "memory")
#define VM_WAIT() asm volatile("s_waitcnt vmcnt(0)" ::: "memory")
__device__ __forceinline__ unsigned long long rt() { return __builtin_amdgcn_s_memrealtime(); }
__device__ __forceinline__ unsigned f2bf(float f) { unsigned u = __builtin_bit_cast(unsigned, f); return (u + 0x7fffu + ((u >> 16) & 1u)) >> 16; }
__device__ __forceinline__ unsigned pk2(float lo, float hi) { return f2bf(lo) | (f2bf(hi) << 16); }

#define XB_TMO      128
#define XB_XCNT(j)  (256  + 64 * (j))
#define XB_XSUB(j)  (1280 + 64 * (j))
#define XB_XGEN(j)  (2304 + 64 * (j))
#define XB_TOP      3328
#define XB_TOPGEN   3392
#define XCD_BAR_WORDS 3456
#define XB_SPIN_CAP (1u << 18)

__device__ __forceinline__ unsigned xb_ld(unsigned* p)              { return __hip_atomic_load(p, __ATOMIC_RELAXED, __HIP_MEMORY_SCOPE_AGENT); }
__device__ __forceinline__ unsigned xb_add(unsigned* p, unsigned v) { return __hip_atomic_fetch_add(p, v, __ATOMIC_RELAXED, __HIP_MEMORY_SCOPE_AGENT); }
__device__ __forceinline__ unsigned xb_xcc_id() { return (unsigned)__builtin_amdgcn_s_getreg((3 << 11) | 20) & 0xFu; }
#define XB_SPIN(cond, bar) do { unsigned _sp = 0; while (cond) { __builtin_amdgcn_s_sleep(1); \
    if ((++_sp & 255u) == 0u) { if (xb_ld(&(bar)[XB_TMO])) break; if (_sp > XB_SPIN_CAP) { atomicAdd(&(bar)[XB_TMO], 1u); break; } } } } while (0)

struct XcdBarrier {
    unsigned* bar; unsigned x;
    volatile LAS unsigned* st;
};

__device__ __forceinline__ XcdBarrier xcd_barrier_post(unsigned* bar, volatile LAS unsigned* st) {
    XcdBarrier b; b.bar = bar; b.x = xb_xcc_id(); b.st = st;
    if (threadIdx.x == 0) (void)xb_add(&bar[XB_XCNT(b.x)], 1u);
    return b;
}
__device__ __forceinline__ void xcd_barrier_complete(unsigned* bar, unsigned x, unsigned& nloc, unsigned& nx) {
    const unsigned G = gridDim.x * gridDim.y * gridDim.z;
    unsigned sum, cnt, mine, sp = 0u;
    for (;;) {
        sum = 0u; cnt = 0u; mine = 0u;
#pragma unroll
        for (unsigned j = 0; j < 16; ++j) { const unsigned c = xb_ld(&bar[XB_XCNT(j)]); sum += c; cnt += (c > 0u) ? 1u : 0u; mine = (j == x) ? c : mine; }
        if (sum == G) break;
        __builtin_amdgcn_s_sleep(1);
        if ((++sp & 255u) == 0u) { if (xb_ld(&bar[XB_TMO])) break; if (sp > XB_SPIN_CAP) { atomicAdd(&bar[XB_TMO], 1u); break; } }
    }
    nloc = mine > 0u ? mine : 1u; nx = cnt > 0u ? cnt : 1u;
}

__device__ __forceinline__ void xcd_barrier(const XcdBarrier& b) {
    asm volatile("s_waitcnt vmcnt(0)" ::: "memory");
    __syncthreads();
    if (threadIdx.x == 0) {
        unsigned* bar = b.bar;
        __builtin_amdgcn_s_waitcnt(0);
        unsigned nloc = b.st[0], nx = b.st[1];
        if (nloc == 0u) { xcd_barrier_complete(bar, b.x, nloc, nx); b.st[0] = nloc; b.st[1] = nx; }
        const unsigned old = xb_add(&bar[XB_XSUB(b.x)], 1u);
        const unsigned gen = old / nloc;
        if (old + 1u == (gen + 1u) * nloc) {
            __builtin_amdgcn_fence(__ATOMIC_RELEASE, "agent");
            asm volatile("s_waitcnt vmcnt(0)" ::: "memory");
            const unsigned og = xb_add(&bar[XB_TOP], 1u);
            const unsigned tg = og / nx;
            if (og + 1u == (tg + 1u) * nx) xb_add(&bar[XB_TOPGEN], 1u);
            else XB_SPIN(xb_ld(&bar[XB_TOPGEN]) == tg, bar);
            __builtin_amdgcn_fence(__ATOMIC_ACQUIRE, "agent");
            xb_add(&bar[XB_XGEN(b.x)], 1u);
            asm volatile("s_waitcnt vmcnt(0)" ::: "memory");
        } else {
            XB_SPIN(xb_ld(&bar[XB_XGEN(b.x)]) == gen, bar);
            __builtin_amdgcn_fence(__ATOMIC_ACQUIRE, "agent");
            asm volatile("s_waitcnt vmcnt(0)" ::: "memory");
        }
    }
    __syncthreads();
}
namespace pg8 {
#define PG8_LAS __attribute__((address_space(3)))
typedef unsigned short bf16_t;
typedef short bf16x8 __attribute__((ext_vector_type(8)));
typedef float f32x4 __attribute__((ext_vector_type(4)));
typedef unsigned u32x4 __attribute__((ext_vector_type(4)));
typedef int v4i_t __attribute__((ext_vector_type(4)));
typedef int v8i_t __attribute__((ext_vector_type(8)));
constexpr int BM = 256, BK = 64, HALF = 128, HTB = HALF * BK * 2  , STAGE_BYTES = 8 * HTB, NXCD = 8, WGM = 8;

__host__ __device__ __forceinline__ int lds_byte(int r, int c) { const int st = (r >> 4) * 2 + (c >> 5), rr = r & 15, cc = c & 31, ob = rr * 64 + cc * 2; return st * 1024 + (ob ^ (((ob >> 9) & 1) << 5)); }
__host__ __device__ __forceinline__ void stage_rc(int b, int& R, int& C) { const int st = b / 1024, sb = b % 1024, swz = sb ^ (((sb >> 9) & 1) << 5); R = (st >> 1) * 16 + swz / 64; C = (st & 1) * 32 + (swz % 64) / 2; }
__host__ __device__ __forceinline__ int perm32(int rho) { const int n = rho >> 4, i = rho & 15; return 8 * (i >> 2) + 4 * n + (i & 3); }

constexpr int GATHER_LDS = 147456;
typedef unsigned v4u_t __attribute__((ext_vector_type(4)));
struct Unit { const char* a; const char* b; int pm, pn, aux; };
typedef unsigned u32x2 __attribute__((ext_vector_type(2)));
__device__ __forceinline__ unsigned cvt_pk_bf16(float lo, float hi) { unsigned r; asm volatile("v_cvt_pk_bf16_f32 %0, %1, %2" : "=v"(r) : "v"(lo), "v"(hi)); return r; }
struct GridOrder {
    int nM, nN, nwg, G, c;
    __device__ __forceinline__ void init(int nM_, int nN_, int G_, int c_) { nM = nM_; nN = nN_; nwg = nM * nN; G = G_; c = c_; }
    __device__ __forceinline__ bool tile(int i, int& pm, int& pn) const {
        const int L = i * G + c; if (L >= nwg) return false;
        int wgid = L; { const int q = nwg / NXCD, r = nwg % NXCD, xcd = wgid % NXCD, off = wgid / NXCD; wgid = (xcd < r ? xcd * (q + 1) : r * (q + 1) + (xcd - r) * q) + off; }
        const int nig = WGM * nN, gid = wgid / nig, fm = gid * WGM, gsz = (nM - fm) < WGM ? (nM - fm) : WGM;
        pm = fm + ((wgid % nig) % gsz); pn = (wgid % nig) / gsz; return true;
    }
};

template <class Epi, class Sched, bool ALIGN_EPI = false, bool SP2 = false, bool F8 = false, bool GATHER = false>
__device__ __forceinline__ void gemm_phase(PG8_LAS unsigned char* lds, const char* rbase  , const int K, const Sched& S, const Epi& E, const int wid_in  ) {
    static_assert(!GATHER || SP2, "the gathered A tile is wired into the SP2 schedule only");
    int lane; asm volatile("v_mbcnt_lo_u32_b32 %0, -1, 0\n\tv_mbcnt_hi_u32_b32 %0, -1, %0" : "=v"(lane));
    const int wid = wid_in, tid = wid * 64 + lane, wr = wid >> 2, wc = wid & 3, fr = lane & 15, fq = lane >> 4;
    const int nt = K / BK;
    int sc_ab = 122 | (127 << 8); asm volatile("" : "+v"(sc_ab));
    const __amdgpu_buffer_rsrc_t rsrc = __builtin_amdgcn_make_buffer_rsrc((void*)rbase, 0, 0xffffffff, 0x00020000);
    unsigned voffA[2], voffB[2];
#pragma unroll
    for (int i = 0; i < 2; ++i) { int R, C; stage_rc(tid * 16 + i * 8192, R, C); const int Rb = Epi::PERM ? ((R & ~31) + perm32(R & 31)) : R;
        voffA[i] = (unsigned)(R * K + C) * 2u; voffB[i] = (unsigned)(Rb * K + C) * 2u; }
    const size_t kstep = (size_t)(BK * 2);
    const size_t hstep = (size_t)HALF * K * 2;
    const size_t hstepA = GATHER ? (size_t)0 : hstep;
    const unsigned ldsw = (unsigned)wid * 1024u;
    const int aoff = lds_byte(wr * 64 + fr, fq * 8), boff = lds_byte(wc * 32 + fr, fq * 8);
#define PG8_SA(b, h) (((b) * 2 + (h)) * HTB)
#define PG8_SB(b, h) ((4 + (b) * 2 + (h)) * HTB)
#define PG8_STAGE(bufoff, gbase, voff) do { const unsigned _so = (unsigned)((const char*)(gbase) - rbase); _Pragma("unroll") for (int _i = 0; _i < 2; ++_i) \
        __builtin_amdgcn_raw_ptr_buffer_load_lds(rsrc, (PG8_LAS unsigned*)(lds + (bufoff) + ldsw + _i * 8192), 16, (voff)[_i], _so, 0, 0); } while (0)
#define PG8_GSLOT(set_, h_) (lds + GATHER_LDS + (set_) * 8192 + tid * 16 + (h_) * 8)
#define PG8_GQ(q_, h_, nx_) u32x2 q_; if constexpr (GATHER) q_ = *(const PG8_LAS u32x2*)PG8_GSLOT((ui & 1) ^ ((nx_) ? 1 : 0), h_); else q_ = (u32x2){voffA[0], voffA[1]}
#define PG8_STAGE_Q(bufoff, gbase, q_) do { const unsigned _so = (unsigned)((const char*)(gbase) - rbase); \
        __builtin_amdgcn_raw_ptr_buffer_load_lds(rsrc, (PG8_LAS unsigned*)(lds + (bufoff) + ldsw), 16, (q_).x, _so, 0, 0); \
        __builtin_amdgcn_raw_ptr_buffer_load_lds(rsrc, (PG8_LAS unsigned*)(lds + (bufoff) + ldsw + 8192), 16, (q_).y, _so, 0, 0); } while (0)
#define PG8_GCALC(dst, pm_) do { int l2_; asm volatile("v_mbcnt_lo_u32_b32 %0, -1, 0\n\tv_mbcnt_hi_u32_b32 %0, -1, %0" : "=v"(l2_)); const int t2_ = wid * 64 + l2_;     \
        const __attribute__((address_space(1))) int* tk_ = (const __attribute__((address_space(1))) int*)S.tokof + (pm_) * 256; \
        _Pragma("unroll") for (int _h = 0; _h < 2; ++_h) _Pragma("unroll") for (int _i = 0; _i < 2; ++_i) { int R_, C_; stage_rc(t2_ * 16 + _i * 8192, R_, C_); \
        dst[_h * 2 + _i] = (unsigned)tk_[_h * 128 + R_] * (unsigned)(K * 2) + (unsigned)C_ * 2u; } } while (0)
#define PG8_LD8(p) __builtin_shufflevector(*(const PG8_LAS v4i_t*)(p), *(const PG8_LAS v4i_t*)((p) + 1024), 0, 1, 2, 3, 4, 5, 6, 7)
#define PG8_LDA(dst, b, h) do { if constexpr (F8) { _Pragma("unroll") for (int m = 0; m < 4; ++m) dst##8[m] = PG8_LD8(lds + PG8_SA(b, h) + aoff + m * 2048); } else { \
        _Pragma("unroll") for (int m = 0; m < 4; ++m) _Pragma("unroll") for (int k = 0; k < 2; ++k) dst[m][k] = *(const PG8_LAS bf16x8*)(lds + PG8_SA(b, h) + aoff + m * 2048 + k * 1024); } } while (0)
#define PG8_LDB(dst, b, h) do { if constexpr (F8) { _Pragma("unroll") for (int n = 0; n < 2; ++n) dst##8[n] = PG8_LD8(lds + PG8_SB(b, h) + boff + n * 2048); } else { \
        _Pragma("unroll") for (int n = 0; n < 2; ++n) _Pragma("unroll") for (int k = 0; k < 2; ++k) dst[n][k] = *(const PG8_LAS bf16x8*)(lds + PG8_SB(b, h) + boff + n * 2048 + k * 1024); } } while (0)
#define PG8_MMA(ai, bj, At, Bt) do { __builtin_amdgcn_s_setprio(1); if constexpr (F8) { _Pragma("unroll") for (int m = 0; m < 4; ++m) _Pragma("unroll") for (int n = 0; n < 2; ++n) \
        acc[ai][bj][m][n] = __builtin_amdgcn_mfma_scale_f32_16x16x128_f8f6f4(Bt##8[n], At##8[m], acc[ai][bj][m][n], 0, 0, 0, sc_ab, 1, sc_ab); } else { \
        _Pragma("unroll") for (int m = 0; m < 4; ++m) _Pragma("unroll") for (int n = 0; n < 2; ++n) _Pragma("unroll") for (int k = 0; k < 2; ++k) \
        acc[ai][bj][m][n] = __builtin_amdgcn_mfma_f32_16x16x32_bf16(Bt[n][k], At[m][k], acc[ai][bj][m][n], 0, 0, 0); } __builtin_amdgcn_s_setprio(0); } while (0)
#define PG8_WAIT_V(n) asm volatile("s_waitcnt vmcnt(" #n ")" ::: "memory")
#define PG8_WAIT_L(n) asm volatile("s_waitcnt lgkmcnt(" #n ")" ::: "memory")
#define PG8_BAR __builtin_amdgcn_s_barrier()
#define PG8_SCHED __builtin_amdgcn_sched_barrier(0)
    Unit cur, nxt; int ui = 0;
    if (!S.next(0, cur)) return;
    f32x4 acc[2][2][4][2];
#pragma unroll
    for (int a = 0; a < 2; ++a)
#pragma unroll
        for (int b = 0; b < 2; ++b)
#pragma unroll
            for (int m = 0; m < 4; ++m)
#pragma unroll
                for (int n = 0; n < 2; ++n) acc[a][b][m][n] = (f32x4){0.f, 0.f, 0.f, 0.f};
    bf16x8 At[4][2], B0[2][2], B1[2][2]; v8i_t At8[4], B08[2], B18[2];
    const char* cA = cur.a; const char* cB = cur.b;
    if constexpr (SP2) {
        u32x2 p0 = (u32x2){voffA[0], voffA[1]}, p1 = p0;
        if constexpr (GATHER) { v4u_t g4; PG8_GCALC(g4, cur.pm); *(PG8_LAS v4u_t*)PG8_GSLOT(0, 0) = g4; p0 = (u32x2){g4[0], g4[1]}; p1 = (u32x2){g4[2], g4[3]}; }
        PG8_STAGE(PG8_SB(0, 0), cB, voffB); PG8_STAGE(PG8_SB(0, 1), cB + hstep, voffB); PG8_STAGE_Q(PG8_SA(0, 0), cA, p0); PG8_STAGE_Q(PG8_SA(0, 1), cA + hstepA, p1);
        if (wr == 1) PG8_BAR;
        PG8_WAIT_V(2); PG8_BAR;
        PG8_STAGE(PG8_SB(1, 0), cB + kstep, voffB); PG8_STAGE_Q(PG8_SA(1, 0), cA + kstep, p0); PG8_STAGE(PG8_SB(1, 1), cB + hstep + kstep, voffB);
        PG8_WAIT_V(6); PG8_BAR;
    } else {
        PG8_STAGE(PG8_SB(0, 0), cB, voffB); PG8_STAGE(PG8_SA(0, 0), cA, voffA); PG8_STAGE(PG8_SB(0, 1), cB + hstep, voffB); PG8_STAGE(PG8_SA(0, 1), cA + hstep, voffA);
        if (wr == 1) PG8_BAR;
        PG8_WAIT_V(4); PG8_BAR;
        PG8_STAGE(PG8_SB(1, 0), cB + kstep, voffB); PG8_STAGE(PG8_SA(1, 0), cA + kstep, voffA); PG8_STAGE(PG8_SB(1, 1), cB + hstep + kstep, voffB);
        PG8_WAIT_V(6); PG8_BAR;
    }
    for (;;) {
        const bool has_next = S.next(ui + 1, nxt);
        if constexpr (GATHER) { v4u_t g4 = *(const PG8_LAS v4u_t*)PG8_GSLOT(ui & 1, 0); if (has_next) PG8_GCALC(g4, nxt.pm); *(PG8_LAS v4u_t*)PG8_GSLOT((ui & 1) ^ 1, 0) = g4; }
        const char* nA = has_next ? nxt.a : cA; const char* nB = has_next ? nxt.b : cB;
#pragma nounroll
        for (int t = 0; t < nt; t += 2) {
            const bool last = (t == nt - 2);
            const char* a1 = cA + (size_t)(t + 1) * kstep;
            const char* a2 = last ? nA : cA + (size_t)(t + 2) * kstep; const char* b2 = last ? nB : cB + (size_t)(t + 2) * kstep;
            const char* a3 = a2 + kstep; const char* b3 = b2 + kstep;
            if constexpr (SP2) {
            PG8_GQ(q1, 1, false); PG8_LDB(B0, 0, 0); PG8_LDB(B1, 0, 1); PG8_SCHED; PG8_LDA(At, 0, 0); PG8_STAGE_Q(PG8_SA(1, 1), a1 + hstepA, q1);
            PG8_WAIT_V(8); PG8_WAIT_L(0); PG8_BAR; PG8_MMA(0, 0, At, B0); PG8_MMA(0, 1, At, B1); PG8_BAR; PG8_SCHED;
            PG8_GQ(q2, 0, last); PG8_LDA(At, 0, 1); PG8_STAGE(PG8_SB(0, 0), b2, voffB); PG8_STAGE(PG8_SB(0, 1), b2 + hstep, voffB); PG8_STAGE_Q(PG8_SA(0, 0), a2, q2);
            PG8_WAIT_V(8); PG8_WAIT_L(0); PG8_BAR; PG8_MMA(1, 0, At, B0); PG8_MMA(1, 1, At, B1); PG8_BAR; PG8_SCHED;
            PG8_GQ(q3, 1, last); PG8_LDB(B0, 1, 0); PG8_LDB(B1, 1, 1); PG8_SCHED; PG8_LDA(At, 1, 0); PG8_STAGE_Q(PG8_SA(0, 1), a2 + hstepA, q3);
            PG8_WAIT_V(8); PG8_WAIT_L(0); PG8_BAR; PG8_MMA(0, 0, At, B0); PG8_MMA(0, 1, At, B1); PG8_BAR; PG8_SCHED;
            PG8_GQ(q4, 0, last); PG8_LDA(At, 1, 1); PG8_STAGE(PG8_SB(1, 0), b3, voffB); PG8_STAGE(PG8_SB(1, 1), b3 + hstep, voffB); PG8_STAGE_Q(PG8_SA(1, 0), a3, q4);
            PG8_WAIT_V(8); PG8_WAIT_L(0); PG8_BAR; PG8_MMA(1, 0, At, B0); PG8_MMA(1, 1, At, B1); PG8_BAR; PG8_SCHED;
            } else {
            PG8_LDB(B0, 0, 0); PG8_SCHED; PG8_LDA(At, 0, 0); PG8_STAGE(PG8_SA(1, 1), a1 + hstep, voffA);
            PG8_WAIT_L(8); PG8_BAR; PG8_WAIT_L(0); PG8_MMA(0, 0, At, B0); PG8_BAR; PG8_SCHED;
            PG8_LDB(B1, 0, 1); PG8_STAGE(PG8_SB(0, 0), b2, voffB);
            PG8_BAR; PG8_WAIT_L(0); PG8_MMA(0, 1, At, B1); PG8_BAR;
            PG8_LDA(At, 0, 1); PG8_STAGE(PG8_SA(0, 0), a2, voffA);
            PG8_BAR; PG8_WAIT_L(0); PG8_MMA(1, 0, At, B0); PG8_BAR; PG8_SCHED;
            PG8_STAGE(PG8_SB(0, 1), b2 + hstep, voffB);
            PG8_WAIT_V(6); PG8_BAR; PG8_MMA(1, 1, At, B1); PG8_BAR;
            PG8_LDB(B0, 1, 0); PG8_SCHED; PG8_LDA(At, 1, 0); PG8_STAGE(PG8_SA(0, 1), a2 + hstep, voffA);
            PG8_WAIT_L(8); PG8_BAR; PG8_WAIT_L(0); PG8_MMA(0, 0, At, B0); PG8_BAR; PG8_SCHED;
            PG8_LDB(B1, 1, 1); PG8_STAGE(PG8_SB(1, 0), b3, voffB);
            PG8_BAR; PG8_WAIT_L(0); PG8_MMA(0, 1, At, B1); PG8_BAR;
            PG8_LDA(At, 1, 1); PG8_STAGE(PG8_SA(1, 0), a3, voffA);
            PG8_BAR; PG8_WAIT_L(0); PG8_MMA(1, 0, At, B0); PG8_BAR; PG8_SCHED;
            PG8_STAGE(PG8_SB(1, 1), b3 + hstep, voffB);
            PG8_WAIT_V(6); PG8_BAR; PG8_MMA(1, 1, At, B1); PG8_BAR;
            }
        }
        if constexpr (ALIGN_EPI) { if (wr == 0) PG8_BAR; }
        E(acc, cur, wr, wc, fr, fq);
        if (!has_next) break;
#pragma unroll
        for (int a = 0; a < 2; ++a)
#pragma unroll
            for (int b = 0; b < 2; ++b)
#pragma unroll
                for (int m = 0; m < 4; ++m)
#pragma unroll
                    for (int n = 0; n < 2; ++n) acc[a][b][m][n] = (f32x4){0.f, 0.f, 0.f, 0.f};
        cur = nxt; cA = nA; cB = nB; ++ui;
        if constexpr (ALIGN_EPI) { if (wr == 1) PG8_BAR; }
    }
    PG8_WAIT_V(0);
    if constexpr (!ALIGN_EPI) { if (wr == 0) PG8_BAR; }
    PG8_BAR;
#undef PG8_SA
#undef PG8_SB
#undef PG8_STAGE
#undef PG8_STAGE_Q
#undef PG8_GQ
#undef PG8_GSLOT
#undef PG8_GCALC
#undef PG8_LDA
#undef PG8_LDB
#undef PG8_MMA
#undef PG8_LD8
#undef PG8_WAIT_V
#undef PG8_WAIT_L
#undef PG8_BAR
#undef PG8_SCHED
}
}

#include <hip/hip_bf16.h>
namespace attn_body {
using bf16=__hip_bfloat16;
using bf16x8=__attribute__((ext_vector_type(8)))short;
using s16x4=__attribute__((ext_vector_type(4)))short;
using f32x16=__attribute__((ext_vector_type(16)))float;
using u32x4=__attribute__((ext_vector_type(4)))unsigned;
constexpr int BATCH=8,NHEAD=16,SEQ=2048,D=64,QP=1024,KVP=256;
constexpr int NW=8,QBLK=32,QB=QBLK*NW,KVBLK=64,NQB=SEQ/QB;
constexpr int ATTN_UNIT_ROWS=QB;
__device__ __forceinline__ int crow(int r,int hi){return (r&3)+8*(r>>2)+4*hi;}
#define SBAR() __builtin_amdgcn_sched_barrier(0)
__device__ __forceinline__ void cmask(f32x16&p0,f32x16&p1,int jb,int qrel,int hi){
  const float NEG=-INFINITY; int kb=64*jb+4*hi;
  #pragma unroll
  for(int r=0;r<16;++r){int kv=kb+(r&3)+8*(r>>2); if(kv>qrel)p0[r]=NEG; if(kv+32>qrel)p1[r]=NEG;}
}

constexpr int NSLOT=3, SLOTB=8192;
constexpr int LDS_K=0, LDS_V=NSLOT*SLOTB, LDS_WS=2*NSLOT*SLOTB, LDS_OST=LDS_WS+NW*64*4, LDS_BYTES=LDS_OST+NW*4096;
constexpr float C2=0.125f*1.4426950408889634f;
__device__ __forceinline__ void glds16(const void*gsrc,unsigned lds_dst){unsigned keep;
  asm volatile("s_mov_b32 %0, m0\n\ts_mov_b32 m0, %2\n\ts_nop 0\n\tglobal_load_lds_dwordx4 %1, off\n\ts_mov_b32 m0, %0":"=&s"(keep):"v"(gsrc),"s"(lds_dst):"memory");}
__device__ __forceinline__ float max3f(float a,float b,float c){float r;asm("v_max3_f32 %0, %1, %2, %3":"=v"(r):"v"(a),"v"(b),"v"(c));return r;}
__device__ __forceinline__ float max2f(float a,float b){float r;asm("v_max_f32_e32 %0, %1, %2":"=v"(r):"v"(a),"v"(b));return r;}
__device__ __forceinline__ float fadd_s(float a,float b){float r;asm("v_add_f32_e32 %0, %1, %2":"=v"(r):"v"(a),"v"(b));return r;}
__device__ __forceinline__ float fsub_s(float a,float b){float r;asm("v_sub_f32_e32 %0, %1, %2":"=v"(r):"v"(a),"v"(b));return r;}
typedef float f32x2_t __attribute__((ext_vector_type(2))); typedef __bf16 bf16x2_t __attribute__((ext_vector_type(2)));
__device__ __forceinline__ unsigned cvtpk_s(float lo,float hi){f32x2_t v={lo,hi};bf16x2_t b=__builtin_convertvector(v,bf16x2_t);return __builtin_bit_cast(unsigned,b);}
#define WAIT_BAR(N) asm volatile("s_waitcnt vmcnt(" #N ") lgkmcnt(0)\n\ts_barrier":::"memory")

__device__ __forceinline__ void qkt(f32x16&p0,f32x16&p1,const char*Kslot,const bf16x8*qr,const f32x16&negm,int r32,int hi){
  const char*kb=Kslot+hi*1024+r32*16;
  #pragma unroll
  for(int d0=0;d0<4;++d0){
    const bf16x8 b0=*reinterpret_cast<const bf16x8*>(kb+d0*2048);
    const bf16x8 b1=*reinterpret_cast<const bf16x8*>(kb+d0*2048+512);
    if(d0==0){p0=__builtin_amdgcn_mfma_f32_32x32x16_bf16(b0,qr[0],negm,0,0,0);p1=__builtin_amdgcn_mfma_f32_32x32x16_bf16(b1,qr[0],negm,0,0,0);}
    else{p0=__builtin_amdgcn_mfma_f32_32x32x16_bf16(b0,qr[d0],p0,0,0,0);p1=__builtin_amdgcn_mfma_f32_32x32x16_bf16(b1,qr[d0],p1,0,0,0);}}
}
typedef __attribute__((address_space(3))) const char* lds_cptr;
typedef short v4i16_t __attribute__((ext_vector_type(4)));
__device__ __forceinline__ void kload8(bf16x8*kf,lds_cptr kp){
  kf[0]=*(const __attribute__((address_space(3))) bf16x8*)(kp);      kf[1]=*(const __attribute__((address_space(3))) bf16x8*)(kp+512);
  kf[2]=*(const __attribute__((address_space(3))) bf16x8*)(kp+2048); kf[3]=*(const __attribute__((address_space(3))) bf16x8*)(kp+2560);
  kf[4]=*(const __attribute__((address_space(3))) bf16x8*)(kp+4096); kf[5]=*(const __attribute__((address_space(3))) bf16x8*)(kp+4608);
  kf[6]=*(const __attribute__((address_space(3))) bf16x8*)(kp+6144); kf[7]=*(const __attribute__((address_space(3))) bf16x8*)(kp+6656);
}
__device__ __forceinline__ void kload2(bf16x8*kf,lds_cptr kp,int j){ kf[2*j]=*(const __attribute__((address_space(3))) bf16x8*)(kp+j*2048); kf[2*j+1]=*(const __attribute__((address_space(3))) bf16x8*)(kp+j*2048+512); }
__device__ __forceinline__ s16x4 vtr(lds_cptr p){ return __builtin_bit_cast(s16x4,__builtin_amdgcn_ds_read_tr16_b64_v4i16((__attribute__((address_space(3))) v4i16_t*)p)); }
__device__ __forceinline__ float rowmax(const f32x16&p0,const f32x16&p1){
  float a=max3f(p0[0],p0[1],p1[0]),b=max3f(p0[2],p0[3],p1[1]);a=max3f(a,p1[2],p1[3]);
  #pragma unroll
  for(int r=4;r<16;r+=4){a=max3f(a,p0[r],p0[r+1]);b=max3f(b,p0[r+2],p0[r+3]);a=max3f(a,p1[r],p1[r+1]);b=max3f(b,p1[r+2],p1[r+3]);}
  const float m=max2f(a,b);
  auto rr=__builtin_amdgcn_permlane32_swap(__float_as_uint(m),__float_as_uint(m),false,false);
  return max2f(__uint_as_float(rr[0]),__uint_as_float(rr[1]));
}
__device__ __forceinline__ void pv(f32x16*o,int vb,bf16x8 pa0,bf16x8 pa1,bf16x8 pa2,bf16x8 pa3){
  #pragma unroll
  for(int d0=0;d0<2;++d0){s16x4 lo[4],hi[4];
    #pragma unroll
    for(int ks=0;ks<4;++ks){
      asm volatile("ds_read_b64_tr_b16 %0,%1 offset:%c2":"=&v"(lo[ks]):"v"(vb),"i"(d0*4096+ks*1024):"memory");
      asm volatile("ds_read_b64_tr_b16 %0,%1 offset:%c2":"=&v"(hi[ks]):"v"(vb),"i"(d0*4096+ks*1024+512):"memory");}
    asm volatile("s_waitcnt lgkmcnt(0)":::"memory");SBAR();
    #define PK(k) (bf16x8){lo[k][0],lo[k][1],lo[k][2],lo[k][3],hi[k][0],hi[k][1],hi[k][2],hi[k][3]}
    o[d0]=__builtin_amdgcn_mfma_f32_32x32x16_bf16(pa0,PK(0),o[d0],0,0,0);
    o[d0]=__builtin_amdgcn_mfma_f32_32x32x16_bf16(pa1,PK(1),o[d0],0,0,0);
    o[d0]=__builtin_amdgcn_mfma_f32_32x32x16_bf16(pa2,PK(2),o[d0],0,0,0);
    o[d0]=__builtin_amdgcn_mfma_f32_32x32x16_bf16(pa3,PK(3),o[d0],0,0,0);
    #undef PK
  }
}

#ifndef ATTN_STORE16
#define ATTN_STORE16(p,v) (*(u32x4*)(p)=(v))
#endif
template<int THRL> __device__ __forceinline__ void attn_unit(int b,int h,int kvh,int qb,const bf16*Q,const bf16*__restrict__ K,const bf16*__restrict__ V,bf16*O,char*shm,const int wid_in){
  int lane; asm volatile("v_mbcnt_lo_u32_b32 %0, -1, 0\n\tv_mbcnt_hi_u32_b32 %0, -1, %0":"=v"(lane)); const int r32=lane&31,hi=lane>>5; const int wid=wid_in;
  const long rowbase=(long)b*SEQ; const int q0=qb*QB;
  const bf16*Qw=Q+(rowbase+q0+wid*QBLK)*QP+h*D;
  const bf16*Kh=K+((long)(b*4+kvh)*(SEQ/KVBLK))*4096,*Vh=V+((long)(b*4+kvh)*(SEQ/KVBLK))*4096;
  const unsigned lds0=(unsigned)(uintptr_t)shm;
  float*wsf=(float*)(shm+LDS_WS)+wid*64;
  const bf16*ksrc=Kh+wid*512+lane*8;
  const bf16*vsrc=Vh+wid*512+lane*8;
  const unsigned kdst=lds0+LDS_K+wid*1024, vdst=lds0+LDS_V+wid*1024;
  #define DMA_K(t,slot) glds16(ksrc+(long)(t)*4096,(unsigned)__builtin_amdgcn_readfirstlane(kdst+(slot)))
  #define DMA_V(t,slot) glds16(vsrc+(long)(t)*4096,(unsigned)__builtin_amdgcn_readfirstlane(vdst+(slot)))
  const int vb0=(int)(lds0+LDS_V)+((lane>>4)&1)*32+(lane&3)*8+(4*hi+((lane&15)>>2))*64;
  const char*Kbase=shm+LDS_K; bf16x8 kf[8];
  const lds_cptr shm3=(lds_cptr)shm; const lds_cptr kp0=shm3+LDS_K+hi*1024+r32*16; const lds_cptr vp0=shm3+LDS_V+((lane>>4)&1)*32+(lane&3)*8+(4*hi+((lane&15)>>2))*64;
  constexpr int NT=SEQ/KVBLK;
  DMA_K(0,0);DMA_V(0,0);DMA_K(1,SLOTB);
  bf16x8 qr[4];
  #pragma unroll
  for(int d0=0;d0<4;++d0)qr[d0]=*reinterpret_cast<const bf16x8*>(&Qw[(long)r32*QP+d0*16+hi*8]);
  float mhat=0.f,l_reg=0.f;f32x16 o[2];o[0]=f32x16{};o[1]=f32x16{};f32x16 negm=f32x16{};asm volatile("":"+v"(negm));
  #define CMASK(P0,P1,t) do{}while(0)
  bool resc=false;
  #define START(P0,P1) do{ const float rm=rowmax(P0,P1); resc=false; \
    { const float dl=rm; mhat=fadd_s(mhat,dl); \
      _Pragma("unroll") for(int r=0;r<16;++r){P0[r]=fsub_s(P0[r],dl);P1[r]=fsub_s(P1[r],dl);} \
      _Pragma("unroll") for(int r=0;r<16;++r)negm[r]=-mhat; asm volatile("":"+v"(negm)); } \
    _Pragma("unroll") for(int r=0;r<16;++r)P0[r]=__builtin_amdgcn_exp2f(P0[r]); }while(0)
  #define RESC() do{ if(resc){ asm volatile("s_waitcnt lgkmcnt(0)":::"memory"); \
      _Pragma("unroll") for(int d_=0;d_<2;++d_) _Pragma("unroll") for(int r=0;r<16;++r)o[d_][r]*=wsf[crow(r,hi)]; } }while(0)
  f32x16 pA0,pA1,pB0,pB1;
  int sl_prev=0,sl_cur=0,sl_next=SLOTB;
  #define ROT() do{sl_prev=sl_cur;sl_cur=sl_next;sl_next=(sl_next==(NSLOT-1)*SLOTB)?0:sl_next+SLOTB;}while(0)
  DMA_K(2,2*SLOTB);
  WAIT_BAR(3);
  qkt(pA0,pA1,Kbase,qr,negm,r32,hi);asm volatile("s_nop 15\n\ts_nop 7":"+v"(pA0),"+v"(pA1));CMASK(pA0,pA1,0);
  START(pA0,pA1);
  _Pragma("unroll") for(int r=0;r<16;++r)pA1[r]=__builtin_amdgcn_exp2f(pA1[r]);
  WAIT_BAR(0);
  DMA_K(3,0);DMA_V(1,SLOTB);
  ROT();
  kload8(kf,kp0+sl_cur);
  WAIT_BAR(2);
  s16x4 vlo[8],vhi[8]; u32x4 pw0,pw1,pw2,pw3;
  #define PKW(P,B) cvtpk_s(P[B],P[B+1])
  #define PAF(k) __builtin_bit_cast(bf16x8,pw##k)
  #define VFR(i) (bf16x8){vlo[i][0],vlo[i][1],vlo[i][2],vlo[i][3],vhi[i][0],vhi[i][1],vhi[i][2],vhi[i][3]}
  #define PIN(x) asm volatile("":"+v"(x))
  #define MX3(a,b,c) __builtin_fmaxf(__builtin_fmaxf((a),(b)),(c))
  #define GAPA(MF,A0,A1,A2,A3,W0,W1,PW) do{ MF; sacc+=A0; sacc+=A1; sacc+=A2; sacc+=A3; PIN(sacc); W0; W1; PIN(PW); SBAR(); }while(0)
  #define EX(v) __builtin_amdgcn_exp2f(v)
  #define GAPB(MF,X,B) do{ MF; X[B]=EX(X[B]); X[B+1]=EX(X[B+1]); X[B+2]=EX(X[B+2]); X[B+3]=EX(X[B+3]); PIN(X); SBAR(); }while(0)
  #define VRD(i) do{ vlo[i]=vtr(vp_+(((i)>>2)*4096+((i)&3)*1024)); vhi[i]=vtr(vp_+(((i)>>2)*4096+((i)&3)*1024+512)); }while(0)
  #define KRD(G,j) do{ if(G){ kload2(kf,kp0+sl_next,j); SBAR(); } }while(0)
  #define STEP(C0,C1,P0,P1,t,GK,GV,GL) do{ SBAR(); \
    const lds_cptr vp_=vp0+sl_prev; \
    VRD(0); SBAR(); float sacc=(P0[0]+P0[1]); \
    GAPA(C0=__builtin_amdgcn_mfma_f32_32x32x16_bf16(kf[0],qr[0],negm,0,0,0), P0[2],P0[3],P0[4],P0[5],     pw0[0]=PKW(P0,0), pw0[1]=PKW(P0,2), pw0); \
    VRD(4); SBAR(); GAPA(C1=__builtin_amdgcn_mfma_f32_32x32x16_bf16(kf[1],qr[0],negm,0,0,0), P0[6],P0[7],P0[8],P0[9],     pw0[2]=PKW(P0,4), pw0[3]=PKW(P0,6), pw0); \
    VRD(1); SBAR(); GAPA(C0=__builtin_amdgcn_mfma_f32_32x32x16_bf16(kf[2],qr[1],C0,0,0,0),   P0[10],P0[11],P0[12],P0[13], pw1[0]=PKW(P0,8), pw1[1]=PKW(P0,10), pw1); \
    VRD(5); SBAR(); GAPA(C1=__builtin_amdgcn_mfma_f32_32x32x16_bf16(kf[3],qr[1],C1,0,0,0),   P0[14],P0[15],P1[0],P1[1],   pw1[2]=PKW(P0,12),pw1[3]=PKW(P0,14), pw1); \
    VRD(2); SBAR(); GAPA(C0=__builtin_amdgcn_mfma_f32_32x32x16_bf16(kf[4],qr[2],C0,0,0,0),   P1[2],P1[3],P1[4],P1[5],     pw2[0]=PKW(P1,0), pw2[1]=PKW(P1,2), pw2); \
    VRD(6); SBAR(); GAPA(C1=__builtin_amdgcn_mfma_f32_32x32x16_bf16(kf[5],qr[2],C1,0,0,0),   P1[6],P1[7],P1[8],P1[9],     pw2[2]=PKW(P1,4), pw2[3]=PKW(P1,6), pw2); \
    VRD(3); SBAR(); GAPA(C0=__builtin_amdgcn_mfma_f32_32x32x16_bf16(kf[6],qr[3],C0,0,0,0),   P1[10],P1[11],P1[12],P1[13], pw3[0]=PKW(P1,8), pw3[1]=PKW(P1,10), pw3); \
    VRD(7); SBAR(); GAPA(C1=__builtin_amdgcn_mfma_f32_32x32x16_bf16(kf[7],qr[3],C1,0,0,0),   P1[14],P1[15],0.f,0.f,       pw3[2]=PKW(P1,12),pw3[3]=PKW(P1,14), pw3); \
    l_reg+=sacc; \
    if(GK){DMA_K((t)+3,sl_cur);} if(GV){DMA_V((t)+1,sl_next);} \
    CMASK(C0,C1,t); \
    { float a=MX3(C0[0],C0[1],C1[0]),b=MX3(C0[2],C0[3],C1[1]); a=MX3(a,C1[2],C1[3]); \
      _Pragma("unroll") for(int r=4;r<16;r+=4){a=MX3(a,C0[r],C0[r+1]);b=MX3(b,C0[r+2],C0[r+3]);a=MX3(a,C1[r],C1[r+1]);b=MX3(b,C1[r+2],C1[r+3]);} \
      float rm=__builtin_fmaxf(a,b); { auto rr=__builtin_amdgcn_permlane32_swap(__float_as_uint(rm),__float_as_uint(rm),false,false); rm=__builtin_fmaxf(__uint_as_float(rr[0]),__uint_as_float(rr[1])); } \
      resc=false; \
      if(__builtin_expect(__any(rm>(float)THRL),0)){ const float dl=__builtin_fmaxf(rm,0.f); mhat+=dl; \
        _Pragma("unroll") for(int r=0;r<16;++r){C0[r]-=dl;C1[r]-=dl;} \
        _Pragma("unroll") for(int r=0;r<16;++r)negm[r]=-mhat; asm volatile("":"+v"(negm)); \
        const float f=__builtin_amdgcn_exp2f(-dl); l_reg*=f; if(hi==0)wsf[r32]=f; resc=true; } } \
    SBAR(); \
    GAPB(o[0]=__builtin_amdgcn_mfma_f32_32x32x16_bf16(PAF(0),VFR(0),o[0],0,0,0), C0,0); \
    GAPB(o[1]=__builtin_amdgcn_mfma_f32_32x32x16_bf16(PAF(0),VFR(4),o[1],0,0,0), C0,4); \
    KRD(GL,0); GAPB(o[0]=__builtin_amdgcn_mfma_f32_32x32x16_bf16(PAF(1),VFR(1),o[0],0,0,0), C0,8); \
    KRD(GL,1); GAPB(o[1]=__builtin_amdgcn_mfma_f32_32x32x16_bf16(PAF(1),VFR(5),o[1],0,0,0), C0,12); \
    KRD(GL,2); GAPB(o[0]=__builtin_amdgcn_mfma_f32_32x32x16_bf16(PAF(2),VFR(2),o[0],0,0,0), C1,0); \
    KRD(GL,3); GAPB(o[1]=__builtin_amdgcn_mfma_f32_32x32x16_bf16(PAF(2),VFR(6),o[1],0,0,0), C1,4); \
    GAPB(o[0]=__builtin_amdgcn_mfma_f32_32x32x16_bf16(PAF(3),VFR(3),o[0],0,0,0), C1,8); \
    GAPB(o[1]=__builtin_amdgcn_mfma_f32_32x32x16_bf16(PAF(3),VFR(7),o[1],0,0,0), C1,12); \
    }while(0)
  int t=1;
  #undef CMASK
  #define CMASK(P0,P1,t) do{}while(0)
  for(;t+5<NT;t+=2){
    STEP(pB0,pB1,pA0,pA1,t,true,true,true);     WAIT_BAR(2); RESC(); ROT();
    STEP(pA0,pA1,pB0,pB1,t+1,true,true,true);   WAIT_BAR(2); RESC(); ROT();
  }
  #undef CMASK
  #define CMASK(P0,P1,t) do{}while(0)
  #define ENDW(tt) do{ if((tt)+3<NT){WAIT_BAR(2);} else if((tt)+2<NT){WAIT_BAR(1);} else {WAIT_BAR(0);} }while(0)
  for(;t+1<NT;t+=2){
    STEP(pB0,pB1,pA0,pA1,t,(t+3<NT),(t+1<NT),(t+1<NT));       ENDW(t);   RESC(); ROT();
    STEP(pA0,pA1,pB0,pB1,t+1,(t+4<NT),(t+2<NT),(t+2<NT));     ENDW(t+1); RESC(); ROT();
  }
  STEP(pB0,pB1,pA0,pA1,NT-1,false,false,false); RESC();
  { float sacc=pB0[0]+pB0[1]; _Pragma("unroll") for(int r=2;r<16;++r)sacc+=pB0[r]; _Pragma("unroll") for(int r=0;r<16;++r)sacc+=pB1[r]; l_reg+=sacc;
    pw0=(u32x4){PKW(pB0,0),PKW(pB0,2),PKW(pB0,4),PKW(pB0,6)};pw1=(u32x4){PKW(pB0,8),PKW(pB0,10),PKW(pB0,12),PKW(pB0,14)};pw2=(u32x4){PKW(pB1,0),PKW(pB1,2),PKW(pB1,4),PKW(pB1,6)};pw3=(u32x4){PKW(pB1,8),PKW(pB1,10),PKW(pB1,12),PKW(pB1,14)};
    SBAR(); pv(o,vb0+sl_cur,PAF(0),PAF(1),PAF(2),PAF(3)); }
  #undef PKW
  #undef PAF
  #undef VFR
  #undef PIN
  #undef MX3
  #undef GAPA
  #undef GAPB
  #undef EX
  #undef VRD
  #undef KRD
  #undef STEP
  #undef ENDW
  {auto rr=__builtin_amdgcn_permlane32_swap(__float_as_uint(l_reg),__float_as_uint(l_reg),false,false);l_reg=__uint_as_float(rr[0])+__uint_as_float(rr[1]);}
  if(hi==0)wsf[32+r32]=l_reg;asm volatile("s_waitcnt lgkmcnt(0)":::"memory");
  float rli[16];
  #pragma unroll
  for(int r=0;r<16;++r)rli[r]=__builtin_amdgcn_rcpf(wsf[32+crow(r,hi)]);
  bf16*Ow=O+(rowbase+q0+wid*QBLK)*QP+h*D;
  { bf16*stg=(bf16*)(shm+LDS_OST)+wid*2048;
    #pragma unroll
    for(int r=0;r<16;++r){const int orow=crow(r,hi);
      #pragma unroll
      for(int d0=0;d0<2;++d0)stg[orow*64+d0*32+r32]=__float2bfloat16(o[d0][r]*rli[r]);}
    asm volatile("s_waitcnt lgkmcnt(0)":::"memory");
    #pragma unroll
    for(int i=0;i<4;++i){const int row=i*8+(lane>>3),ch=lane&7; const u32x4 v=*(const u32x4*)(stg+row*64+ch*8); ATTN_STORE16(Ow+(long)row*QP+ch*8,v);} }
  asm volatile("s_waitcnt lgkmcnt(0)\n\ts_barrier":::"memory");
  #undef DMA_K
  #undef DMA_V
  #undef CMASK
  #undef START
  #undef RESC
  #undef ROT
}
constexpr int ATTN_LDS_BYTES=LDS_BYTES;

#undef SBAR
#undef WAIT_BAR
}
constexpr int T = 16384, D = 1024, SEQ = 2048, NBATCH = 8, NEXP = 32;
constexpr float C2F = 0.125f * 1.4426950408889634f;
constexpr float LN2F = 0.6931471805599453f;
constexpr float NORM_EPS = 1e-6f;
constexpr size_t MiB = 1u << 20;
constexpr size_t WS_CTL = 0, CTL_ZERO_BYTES = 1 * MiB;
constexpr size_t WS_MOD = 1 * MiB;
constexpr size_t WS_ROPEA = 2 * MiB;
constexpr size_t WS_ROPEB = 3 * MiB;
constexpr size_t WS_WRT = 3 * MiB + 65536;
constexpr size_t WS_HIST = 4 * MiB;
constexpr size_t WS_TOT = 4 * MiB + 65536;
constexpr size_t WS_GSORT = 5 * MiB;
constexpr size_t WS_POSOF = 5 * MiB + 524288;
constexpr size_t WS_LSE = 6 * MiB;
constexpr size_t WS_WINA_QK = 16 * MiB, WS_WINA_V = 28 * MiB, WS_WOUTA = 34 * MiB, WS_WINB = 36 * MiB, WS_WOUTB = 39 * MiB;
constexpr size_t WS_WUP = 48 * MiB, WS_WDOWN = 304 * MiB;
constexpr size_t WS_XA = 432 * MiB;
constexpr size_t WS_H0 = 496 * MiB, WS_H1 = 528 * MiB, WS_H2 = 560 * MiB;
constexpr size_t WS_QA = 592 * MiB, WS_KA = 688 * MiB, WS_VTA = 784 * MiB;
constexpr size_t WS_OG = 880 * MiB;
constexpr size_t WS_O = 976 * MiB, WS_Y = 1008 * MiB;
constexpr size_t WS_XS = 592 * MiB, WS_ACT = 736 * MiB, WS_OUTS = 880 * MiB;
constexpr size_t WS_QB = 880 * MiB, WS_KB = 912 * MiB, WS_VB = 920 * MiB;
constexpr size_t WS_END = 1040 * MiB;
static_assert(WS_H2 - WS_H1 == WS_H1 - WS_H0, "H0/H1/H2 equally spaced");
constexpr int MAXROWS = 73728, MAXTILES = 288;
constexpr size_t TSTEP = (size_t)256 * 1024 * 2;
constexpr size_t TSTEP8 = (size_t)256 * 1024;
constexpr float W8_SCALE = 32.0f;
constexpr int CW_TMO = 0, CW_CODE = 1, CW_BAR = 4096, CW_CMP = 200000;
constexpr int RING_BYTES = 131072;
constexpr int TBL_OFF = 135168;
constexpr int RT_PITCH = 2064, RT_LO = 32 * RT_PITCH, T_LG = 139264;
constexpr int T_SEL = TBL_OFF, T_GTE = TBL_OFF + 1024, T_RNK = TBL_OFF + 2048, T_TOT = TBL_OFF + 3072, T_BEF = T_TOT + 128, T_PBASE = T_BEF + 128, T_MYOFF = T_PBASE + 128, T_TEXP = T_MYOFF + 128, T_MT = T_TEXP + 512;
constexpr int LDSCTL_OFF = 143360, MISC_OFF = LDSCTL_OFF + 320;
constexpr int LDS_BYTES = 163840;
constexpr int T_LG2 = 147456;
constexpr int NWAVES = 8;

typedef unsigned u32x2v __attribute__((ext_vector_type(2)));
typedef float f32x2v __attribute__((ext_vector_type(2)));
typedef float f32x16 __attribute__((ext_vector_type(16)));
typedef float f32x2t __attribute__((ext_vector_type(2)));
typedef __bf16 bf16x2t __attribute__((ext_vector_type(2)));
__device__ __forceinline__ unsigned pkbf(float lo, float hi) { f32x2t v = {lo, hi}; bf16x2t b = __builtin_convertvector(v, bf16x2t); return __builtin_bit_cast(unsigned, b); }
constexpr float OUTS_SCALE = 8.0f;
__device__ __forceinline__ unsigned pk4_fp8(float a, float b, float c, float d) { unsigned w = 0; w = __builtin_amdgcn_cvt_pk_fp8_f32(a, b, w, false); w = __builtin_amdgcn_cvt_pk_fp8_f32(c, d, w, true); return w; }
__device__ __forceinline__ float bflo(unsigned u) { return __builtin_bit_cast(float, u << 16); }
__device__ __forceinline__ float bfhi(unsigned u) { return __builtin_bit_cast(float, u & 0xffff0000u); }
__device__ __forceinline__ v4u pack8(f32x4 a, f32x4 b) { v4u w; w.x = pkbf(a[0], a[1]); w.y = pkbf(a[2], a[3]); w.z = pkbf(b[0], b[1]); w.w = pkbf(b[2], b[3]); return w; }
__device__ __forceinline__ float wave_sum(float v) {
#pragma unroll
    for (int o = 1; o < 64; o <<= 1) v += __shfl_xor(v, o);
    return v;
}
__device__ __forceinline__ float hsum4(f32x4 v) { return (v[0] + v[1]) + (v[2] + v[3]); }
__device__ __forceinline__ float dot4(f32x4 a, f32x4 b) { return (a[0] * b[0] + a[1] * b[1]) + (a[2] * b[2] + a[3] * b[3]); }
__device__ __forceinline__ int perm_row(int t, int sh) { const int s = t & 2047; return (t & ~2047) + ((s & ((1 << sh) - 1)) << (11 - sh)) + (s >> sh); }
__device__ __forceinline__ int unperm_row(int p, int sh) { const int pp = p & 2047, Lsh = 11 - sh; return (p & ~2047) + ((pp & ((1 << Lsh) - 1)) << sh) + (pp >> Lsh); }

__host__ __device__ __forceinline__ int swap23(int r) { return (r & 0x13) | ((r & 4) << 1) | ((r & 8) >> 1); }
__host__ __device__ __forceinline__ size_t qk_chunk(int g, int h, int blk) { return ((size_t)(g * 16 + h) * 512 + blk) * 2048; }
struct Args { const float* in[20]; float* out; unsigned char* ws; int ph_lo, ph_hi, li, pad; };
__device__ __forceinline__ int lane_id() { int l; asm volatile("v_mbcnt_lo_u32_b32 %0, -1, 0\n\tv_mbcnt_hi_u32_b32 %0, -1, %0" : "=v"(l)); return l; }
__device__ __forceinline__ unsigned char* opaque_ptr(unsigned char* p) { asm volatile("" : "+s"(p)); return p; }
#ifndef PSEC
#define PSEC 0
#endif
#define SEC_BEGIN(id) unsigned long long tsec_##id = 0; if ((id) == PSEC) tsec_##id = __builtin_amdgcn_s_memrealtime()
#define SEC_END(id) do { if ((id) == PSEC && F.wave == 0 && lane_id() == 0) F.MISC[16] += (unsigned)(__builtin_amdgcn_s_memrealtime() - tsec_##id); } while (0)
struct Frame {
    LAS unsigned char* lds;
    volatile LAS unsigned* MISC;
    gu32* ctl;
    int wave, G, vcu;
    float* out; unsigned char* ws;
};
enum { IN_X = 0, IN_C, IN_WMOD, IN_BMOD, IN_GPREMIX, IN_GPOSTMIX, IN_GPREFFN, IN_GPOSTFFN, IN_WINA, IN_WOUTA, IN_WINB, IN_GQB, IN_GKB, IN_WOUTB, IN_WROUTER, IN_BROUTER, IN_WUP, IN_BUP, IN_WDOWN, IN_BDOWN };

struct RmNat { __device__ __forceinline__ int operator()(int c) const { return c; } };
struct RmInA { unsigned char* qk; unsigned char* v;
    __device__ __forceinline__ unsigned char* row(int c) const { const int g = c / 3072, rem = c - g * 3072, j = rem >> 10, cc = rem & 1023;
        if (j < 2) { const int hq4 = cc >> 8, wc = (cc >> 6) & 3, bj = (cc >> 5) & 1, t = cc & 31; return qk + (size_t)(g * 2048 + (j * 4 + hq4) * 256 + 128 * bj + 32 * wc + t) * 1024; }
        return v + (size_t)(g * 1024 + cc) * 1024; } };
__device__ __forceinline__ int rm_inb(int c) { const int pn = c >> 8, cc = c & 255, wc = cc >> 6, dm = cc & 63, bj = (dm >> 4) & 1, fq = 2 * (dm >> 5) + ((dm >> 3) & 1), n = (dm >> 2) & 1, i = dm & 3; return pn * 256 + 128 * bj + 32 * wc + 8 * fq + 4 * n + i; }
__device__ __forceinline__ int rm_lin(int c) { const int pn = c >> 8, cc = c & 255, wc = cc >> 6, bj = (cc >> 5) & 1, t = cc & 31; return pn * 256 + 128 * bj + 32 * wc + t; }
__device__ __forceinline__ int rm_dn(int c) { const int pn = c >> 8, cc = c & 255, wc = cc >> 6, fq = (cc >> 4) & 3, bj = (cc >> 3) & 1, r = cc & 7; return pn * 256 + 128 * bj + 32 * wc + 8 * fq + r; }
__device__ __forceinline__ int rm_up(int c) { const int bj = c >> 10, pn = (c & 1023) >> 7, jj = c & 127; return pn * 256 + 128 * bj + jj; }
constexpr int I_UP = 64 * 32 * 8, I_DN = 64 * 16 * 8, I_INA = 144 * 8, I_OUT = 16 * 16, I_INB = 24 * 16;
constexpr int NITEMS = I_UP + I_DN + I_INA + 2 * I_OUT + I_INB;
struct CvtItem { const float* src; int ldw; int kind, le, k0, n0; };
__device__ __forceinline__ CvtItem cvt_decode(const Args& args, int it) {
    CvtItem c; int r = it;
    if (r < I_UP) { c.kind = 0; c.le = r >> 8; const int q = r & 255; c.k0 = (q >> 5) * 128; c.n0 = (q & 31) * 64; c.ldw = 2048; c.src = args.in[IN_WUP] + (size_t)c.le * 1024 * 2048; }
    else if ((r -= I_UP) < I_DN) { c.kind = 1; c.le = r >> 7; const int q = r & 127; c.k0 = (q >> 4) * 128; c.n0 = (q & 15) * 64; c.ldw = 1024; c.src = args.in[IN_WDOWN] + (size_t)c.le * 1024 * 1024; }
    else if ((r -= I_DN) < I_INA) { c.kind = 2; c.le = 0; c.k0 = (r / 144) * 128; c.n0 = (r % 144) * 64; c.ldw = 9216; c.src = args.in[IN_WINA]; }
    else if ((r -= I_INA) < I_OUT) { c.kind = 3; c.le = 0; c.k0 = (r >> 4) * 64; c.n0 = (r & 15) * 64; c.ldw = 1024; c.src = args.in[IN_WOUTA]; }
    else if ((r -= I_OUT) < I_OUT) { c.kind = 4; c.le = 0; c.k0 = (r >> 4) * 64; c.n0 = (r & 15) * 64; c.ldw = 1024; c.src = args.in[IN_WOUTB]; }
    else { r -= I_OUT; c.kind = 5; c.le = 0; c.k0 = (r / 24) * 64; c.n0 = (r % 24) * 64; c.ldw = 1536; c.src = args.in[IN_WINB]; }
    return c;
}
__device__ __forceinline__ void cvt_load(const CvtItem& c, int half, f32x4 (&v)[16], int lane) {
    const float* p = c.src + (size_t)(c.k0 + 64 * half + 4 * (lane >> 4)) * c.ldw + c.n0 + 4 * (lane & 15);
#pragma unroll
    for (int i = 0; i < 16; ++i) v[i] = __builtin_nontemporal_load((const GAS f32x4*)(p + (size_t)(16 * (i >> 2) + (i & 3)) * c.ldw));
}
__device__ __forceinline__ unsigned char* cvt_row(const CvtItem& c, unsigned char* ws, int cidx) {
    switch (c.kind) {
    case 0: return ws + WS_WUP + ((size_t)c.le * 2048 + rm_up(cidx)) * 1024;
    case 1: return ws + WS_WDOWN + ((size_t)c.le * 1024 + rm_dn(cidx)) * 1024;
    case 2: { const RmInA rm{ws + WS_WINA_QK, ws + WS_WINA_V}; return rm.row(cidx); }
    case 3: return ws + WS_WOUTA + (size_t)rm_lin(cidx) * 2048;
    case 4: return ws + WS_WOUTB + (size_t)rm_lin(cidx) * 2048;
    default: return ws + WS_WINB + (size_t)rm_inb(cidx) * 2048;
    }
}
__device__ __forceinline__ void cvt_pack8(const f32x4 (&v)[16], int half, LAS unsigned* scr, int lane) {
    const int lr = lane >> 4, lc = 4 * (lane & 15);
#pragma unroll
    for (int j = 0; j < 4; ++j)
#pragma unroll
        for (int q = 0; q < 4; ++q) scr[(lc + q) * 33 + 16 * half + 4 * j + lr] = pk4_fp8(v[4 * j][q] * W8_SCALE, v[4 * j + 1][q] * W8_SCALE, v[4 * j + 2][q] * W8_SCALE, v[4 * j + 3][q] * W8_SCALE);
}
__device__ __forceinline__ void cvt_store8(const CvtItem& c, unsigned char* ws, LAS unsigned* scr, int lane) {
    LDS_WAIT(); asm volatile("" ::: "memory");
    const int cq = lane & 7;
#pragma unroll
    for (int s = 0; s < 8; ++s) { const int nl = 8 * s + (lane >> 3); const LAS unsigned* q = scr + nl * 33 + 4 * cq;
        v4u o; o.x = q[0]; o.y = q[1]; o.z = q[2]; o.w = q[3];
        *(GAS v4u*)(cvt_row(c, ws, c.n0 + nl) + c.k0 + 16 * cq) = o; }
    LDS_WAIT(); asm volatile("" ::: "memory");
}
__device__ __forceinline__ void cvt_finish16(const CvtItem& c, const f32x4 (&v)[16], unsigned char* ws, LAS float* scr, int lane) {
    const int lr = lane >> 4, lc = 4 * (lane & 15);
#pragma unroll
    for (int i = 0; i < 16; ++i) { LAS float* p = scr + (16 * (i >> 2) + 4 * lr + (i & 3)) * 65 + lc; p[0] = v[i][0]; p[1] = v[i][1]; p[2] = v[i][2]; p[3] = v[i][3]; }
    LDS_WAIT(); asm volatile("" ::: "memory");
    const int cq = lane & 7;
#pragma unroll
    for (int s = 0; s < 8; ++s) { const int nl = 8 * s + (lane >> 3); const LAS float* q = scr + (8 * cq) * 65 + nl;
        v4u o; o.x = pkbf(q[0], q[65]); o.y = pkbf(q[2 * 65], q[3 * 65]); o.z = pkbf(q[4 * 65], q[5 * 65]); o.w = pkbf(q[6 * 65], q[7 * 65]);
        *(GAS v4u*)(cvt_row(c, ws, c.n0 + nl) + (size_t)(c.k0 + 8 * cq) * 2) = o; }
    LDS_WAIT(); asm volatile("" ::: "memory");
}
__device__ __forceinline__ void p0_prologue(Frame& F, const Args& args) {
    unsigned char* const wsl = opaque_ptr(F.ws);
    unsigned char* ws = wsl;
    const int gtid = blockIdx.x * 512 + (F.wave * 64 + lane_id());
    if (gtid < 65536) { const int l = gtid >> 15, e = (gtid >> 10) & 31, k = gtid & 1023; const float wv = args.in[IN_WROUTER][((size_t)l * 1024 + k) * 32 + e];
        const unsigned hb = pkbf(wv, 0.f) & 0xffffu; const float hf_ = __builtin_bit_cast(float, hb << 16); const unsigned lb = pkbf(wv - hf_, 0.f) & 0xffffu;
        ((bf16*)(ws + WS_WRT))[gtid] = (bf16)hb; ((bf16*)(ws + WS_WRT + 131072))[gtid] = (bf16)lb; }
    if (blockIdx.x < 192) {
        const int is = blockIdx.x / 48, n0 = (blockIdx.x % 48) * 64;
        LAS float* sil = (LAS float*)F.lds;
        LAS float* red = (LAS float*)(F.lds + 32768);
        const int w = F.wave, lane = lane_id();
#pragma unroll
        for (int b = 0; b < 8; ++b)
#pragma unroll
            for (int q = 0; q < 2; ++q) { const int kk = lane * 2 + q; const float cv = args.in[IN_C][b * 1024 + 128 * w + kk]; sil[(w * 8 + b) * 128 + kk] = cv / (1.f + expf(-cv)); }
        LDS_WAIT(); asm volatile("" ::: "memory");
        const float* wm = args.in[IN_WMOD] + (size_t)is * 1024 * 3072 + (size_t)(128 * w) * 3072 + n0 + lane;
        float acc[8] = {0.f, 0.f, 0.f, 0.f, 0.f, 0.f, 0.f, 0.f};
#pragma unroll 8
        for (int kk = 0; kk < 128; ++kk) { const float wv = wm[(size_t)kk * 3072];
#pragma unroll
            for (int b = 0; b < 8; ++b) acc[b] += sil[(w * 8 + b) * 128 + kk] * wv; }
#pragma unroll
        for (int b = 0; b < 8; ++b) red[(w * 8 + b) * 64 + lane] = acc[b];
        __syncthreads();
        { const int b = (F.wave * 64 + lane_id()) >> 6, col = (F.wave * 64 + lane_id()) & 63; float s = 0.f;
#pragma unroll
          for (int ww = 0; ww < 8; ++ww) s += red[(ww * 8 + b) * 64 + col];
          ((float*)(ws + WS_MOD))[(size_t)(is * 8 + b) * 3072 + n0 + col] = s + args.in[IN_BMOD][is * 3072 + n0 + col]; }
        __syncthreads();
    }
    LAS float* scr = (LAS float*)(F.lds + F.wave * 16640);
    const int gw = blockIdx.x * NWAVES + F.wave, NGW = F.G * NWAVES, lane = lane_id();
    {
        f32x4 va[16], vb[16];
        int it = gw; if (it >= NITEMS) return;
        CvtItem ca = cvt_decode(args, it); int ha = 0;
        cvt_load(ca, ha, va, lane);
        for (;;) {
            CvtItem cb = ca; int hb = ha + 1; bool haveb = true;
            if (!(ca.kind < 3 && ha == 0)) { it += NGW; hb = 0; haveb = it < NITEMS; if (haveb) cb = cvt_decode(args, it); }
            if (haveb) cvt_load(cb, hb, vb, lane);
            if (ca.kind < 3) { cvt_pack8(va, ha, (LAS unsigned*)scr, lane); if (ha == 1) cvt_store8(ca, ws, (LAS unsigned*)scr, lane); } else cvt_finish16(ca, va, ws, scr, lane);
            if (!haveb) break;
            CvtItem cc = cb; int hc = hb + 1; bool havec = true;
            if (!(cb.kind < 3 && hb == 0)) { it += NGW; hc = 0; havec = it < NITEMS; if (havec) cc = cvt_decode(args, it); }
            if (havec) cvt_load(cc, hc, va, lane);
            if (cb.kind < 3) { cvt_pack8(vb, hb, (LAS unsigned*)scr, lane); if (hb == 1) cvt_store8(cb, ws, (LAS unsigned*)scr, lane); } else cvt_finish16(cb, vb, ws, scr, lane);
            if (!havec) break;
            ca = cc; ha = hc;
        }
    }
}

__device__ __forceinline__ void p1_prenorm0(Frame& F, const Args& args) {
    unsigned char* const wsl = opaque_ptr(F.ws);
    const int lane = lane_id(); const int gw = blockIdx.x * NWAVES + F.wave, NGW = F.G * NWAVES;
    unsigned char* H0 = wsl + WS_H0; unsigned char* H1 = wsl + WS_H1; unsigned char* H2 = wsl + WS_H2;
    for (int t0 = gw * 8; t0 < T; t0 += NGW * 8) {
        const int b = t0 >> 11;
        const float* m0 = (const float*)(wsl + WS_MOD) + (size_t)(0 * 8 + b) * 3072;
        f32x4 gs[4], sh[4];
#pragma unroll
        for (int j = 0; j < 4; ++j) { const int c = 16 * lane + 4 * j; const f32x4 g = *(const f32x4*)(args.in[IN_GPREMIX] + c), sc = *(const f32x4*)(m0 + 1024 + c); gs[j] = g * (sc + 1.0f); sh[j] = *(const f32x4*)(m0 + c); }
        for (int i0 = 0; i0 < 8; i0 += 4) {
            f32x4 v[4][4];
#pragma unroll
            for (int u = 0; u < 4; ++u)
#pragma unroll
                for (int j = 0; j < 4; ++j) v[u][j] = *(const GAS f32x4*)(args.in[IN_X] + (size_t)(t0 + i0 + u) * D + 16 * lane + 4 * j);
#pragma unroll
            for (int u = 0; u < 4; ++u) { const int t = t0 + i0 + u; float ss = 0.f;
#pragma unroll
                for (int j = 0; j < 4; ++j) ss += dot4(v[u][j], v[u][j]);
                const float rstd = rsqrtf(wave_sum(ss) * (1.f / D) + NORM_EPS);
                v4u w;
#pragma unroll
                for (int j = 0; j < 4; ++j) { const f32x4 h = v[u][j] * rstd * gs[j] + sh[j]; w[j] = pk4_fp8(h[0], h[1], h[2], h[3]); }
                *(GAS v4u*)(H0 + (size_t)t * 1024 + 16 * lane) = w; *(GAS v4u*)(H1 + (size_t)perm_row(t, 2) * 1024 + 16 * lane) = w; *(GAS v4u*)(H2 + (size_t)perm_row(t, 4) * 1024 + 16 * lane) = w; }
        }
    }
}

__device__ __forceinline__ int rfl(int v) { return __builtin_amdgcn_readfirstlane(v); }
__device__ __forceinline__ const char* uptr(const char* p) { const unsigned long long v = (unsigned long long)p; const unsigned lo = __builtin_amdgcn_readfirstlane((unsigned)v), hi = __builtin_amdgcn_readfirstlane((unsigned)(v >> 32)); return (const char*)(((unsigned long long)hi << 32) | lo); }
__device__ __forceinline__ void store_rows128(unsigned char* seg0  , size_t pitch, int fr, int off0  , int off1  , v4u p0, v4u p1) {
    const bool odd = fr & 1; const v4u snd = odd ? p0 : p1; v4u rcv;
#pragma unroll
    for (int e = 0; e < 4; ++e) rcv[e] = (unsigned)__builtin_amdgcn_update_dpp(0, (int)snd[e], 0xB1  , 0xF, 0xF, false);
    const v4u a = odd ? rcv : p0, b = odd ? p1 : rcv;
    const int off = odd ? off1 : off0;
    *(GAS v4u*)(seg0 + (size_t)(odd ? fr - 1 : fr) * pitch + off) = a; *(GAS v4u*)(seg0 + (size_t)(odd ? fr : fr + 1) * pitch + off) = b;
}
typedef pg8::f32x4 (&AccRef)[2][2][4][2];
struct SchedPlain {
    pg8::GridOrder go; const char* A; const char* B;
    __device__ __forceinline__ bool next(int i, pg8::Unit& u) const { int pm, pn; if (!go.tile(i, pm, pn)) return false; pm = rfl(pm); pn = rfl(pn); u.a = uptr(A + (size_t)pm * TSTEP); u.b = uptr(B + (size_t)pn * TSTEP); u.pm = pm; u.pn = pn; u.aux = 0; return true; }
};
struct EpiPlain {
    static constexpr bool PERM = true;
    bf16* O; size_t ldc;
    __device__ __forceinline__ void operator()(const pg8::f32x4 (&acc)[2][2][4][2], const pg8::Unit& u, int wr, int wc, int fr_in, int fq_in) const {
        const int ln_ = lane_id(), fr = ln_ & 15, fq = ln_ >> 4; (void)fr_in; (void)fq_in;
#pragma unroll
        for (int ai = 0; ai < 2; ++ai)
#pragma unroll
            for (int m = 0; m < 4; ++m) store_rows128((unsigned char*)(O + (size_t)(u.pm * 256 + ai * 128 + wr * 64 + m * 16) * ldc + u.pn * 256 + wc * 64), ldc * 2, fr, 16 * fq, 64 + 16 * fq,
                                                      pack8(acc[ai][0][m][0], acc[ai][0][m][1]), pack8(acc[ai][1][m][0], acc[ai][1][m][1]));
    }
};
struct SchedInaQK {
    pg8::GridOrder go; const char* h0; const char* w;
    __device__ __forceinline__ bool next(int i, pg8::Unit& u) const { int pm, pv; if (!go.tile(i, pm, pv)) return false; pm = rfl(pm); pv = rfl(pv); const int g = pv >> 3, pn = pv & 7;
        const char* hg = h0 + (size_t)g * (WS_H1 - WS_H0); u.a = uptr(hg + (size_t)pm * TSTEP8); u.b = uptr(w + (size_t)(g * 2048 + pn * 256) * 1024); u.pm = pm; u.pn = pn; u.aux = g; return true; }
};
struct EpiRopeA {
    static constexpr bool PERM = true;
    bf16* QA; bf16* KA;
    __device__ __forceinline__ void operator()(const pg8::f32x4 (&acc)[2][2][4][2], const pg8::Unit& u, int wr, int wc, int fr_in, int fq_in) const {
        const int ln_ = lane_id(), fr = ln_ & 15, fq = ln_ >> 4; (void)fr_in; (void)fq_in;
        const int g = u.aux, j = u.pn >> 2, head = (u.pn & 3) * 4 + wc, sh = g == 0 ? 0 : (g == 1 ? 2 : 4);
        bf16* dst = (j == 0 ? QA : KA);
        const float sc = j == 0 ? C2F : 1.0f;
        float invr[2][4];
#pragma unroll
        for (int n = 0; n < 2; ++n)
#pragma unroll
            for (int i = 0; i < 4; ++i) invr[n][i] = __builtin_amdgcn_exp2f((float)(8 * fq + 4 * n + i) * (-13.287712379549449f / 32.0f)) * 0.15915494309189535f;
#pragma unroll
        for (int ai = 0; ai < 2; ++ai)
#pragma unroll
            for (int m = 0; m < 4; ++m) { const int p = u.pm * 256 + ai * 128 + wr * 64 + m * 16 + fr; const float pos = (float)(unperm_row(p, sh) & 2047);
                pg8::f32x4 o1[2], o2[2];
#pragma unroll
                for (int n = 0; n < 2; ++n) { pg8::f32x4 c, sn;
#pragma unroll
                    for (int i = 0; i < 4; ++i) { const float rv = __builtin_amdgcn_fractf(pos * invr[n][i]); c[i] = __builtin_amdgcn_cosf(rv); sn[i] = __builtin_amdgcn_sinf(rv); }
                    const pg8::f32x4 x1 = acc[ai][0][m][n], x2 = acc[ai][1][m][n];
                    o1[n] = (x1 * c - x2 * sn) * sc; o2[n] = (x2 * c + x1 * sn) * sc; }
                const int r = p & 31, slot = j == 0 ? r : swap23(r);
                bf16* cp2 = dst + qk_chunk(g, head, p >> 5) + (size_t)(((fq >> 1) * 2 + (fq & 1)) * 32 + slot) * 8;
                *(GAS v4u*)cp2 = pack8(o1[0], o1[1]); *(GAS v4u*)(cp2 + 2 * 2 * 32 * 8) = pack8(o2[0], o2[1]); }
    }
};
struct SchedInaV {
    pg8::GridOrder go; const char* h0; const char* w;
    __device__ __forceinline__ bool next(int i, pg8::Unit& u) const { int pv, pn; if (!go.tile(i, pv, pn)) return false; pv = rfl(pv); pn = rfl(pn); const int g = pv >> 2, pmf = pv & 3;
        const char* hg = h0 + (size_t)g * (WS_H1 - WS_H0); u.a = uptr(w + (size_t)(g * 1024 + pmf * 256) * 1024); u.b = uptr(hg + (size_t)pn * TSTEP8); u.pm = pmf; u.pn = pn; u.aux = g; return true; }
};
struct EpiVt {
    static constexpr bool PERM = true;
    bf16* VT;
    __device__ __forceinline__ void operator()(const pg8::f32x4 (&acc)[2][2][4][2], const pg8::Unit& u, int wr, int wc, int fr_in, int fq_in) const {
        const int ln_ = lane_id(), fr = ln_ & 15, fq = ln_ >> 4; (void)fr_in; (void)fq_in;
#pragma unroll
        for (int ai = 0; ai < 2; ++ai)
#pragma unroll
            for (int m = 0; m < 4; ++m) { const int f = u.pm * 256 + ai * 128 + wr * 64 + m * 16 + fr, h = f >> 6, db = (f >> 5) & 1, dd = f & 31;
                bf16* cp2 = VT + (size_t)((((fq >> 1) * 2 + db) * 2 + (fq & 1)) * 32 + dd) * 8;
#pragma unroll
                for (int bj = 0; bj < 2; ++bj) *(GAS v4u*)(cp2 + qk_chunk(u.aux, h, u.pn * 8 + bj * 4 + wc)) = pack8(acc[ai][bj][m][0], acc[ai][bj][m][1]); }
    }
};
struct EpiInB {
    static constexpr bool PERM = true;
    bf16* QB; bf16* KB; bf16* VB; const float* gq; const float* gk;
    __device__ __forceinline__ void operator()(const pg8::f32x4 (&acc)[2][2][4][2], const pg8::Unit& u, int wr, int wc, int fr_in, int fq_in) const {
        const int ln_ = lane_id(), fr = ln_ & 15, fq = ln_ >> 4; (void)fr_in; (void)fq_in;
        const int pn = u.pn, A = fq >> 1, f8 = 8 * (fq & 1), off0 = 64 * A + 2 * f8;
        const bool isq = pn < 4, isv = pn == 5; const float* gv = isq ? gq : gk; const float sc = isq ? C2F : 1.0f;
        bf16* dst = QB + (pn * 4 + wc) * 64; const size_t pitch = 1024;
        pg8::f32x4 gg[2][2];
#pragma unroll
        for (int bj = 0; bj < 2; ++bj)
#pragma unroll
            for (int n = 0; n < 2; ++n) gg[bj][n] = isv ? (pg8::f32x4){1.f, 1.f, 1.f, 1.f} : *(const pg8::f32x4*)(gv + 32 * A + 16 * bj + f8 + 4 * n);
        float invr[2][4];
#pragma unroll
        for (int n = 0; n < 2; ++n)
#pragma unroll
            for (int i = 0; i < 4; ++i) invr[n][i] = __builtin_amdgcn_exp2f((float)(f8 + 4 * n + i) * (-13.287712379549449f / 16.0f)) * 0.15915494309189535f;
#pragma unroll
        for (int ai = 0; ai < 2; ++ai)
#pragma unroll
            for (int m = 0; m < 4; ++m) { const int t0 = u.pm * 256 + ai * 128 + wr * 64 + m * 16, s = (t0 + fr) & 2047;
                float ss = 0.f;
#pragma unroll
                for (int bj = 0; bj < 2; ++bj)
#pragma unroll
                    for (int n = 0; n < 2; ++n) { const pg8::f32x4 x = acc[ai][bj][m][n]; ss += (x[0] * x[0] + x[1] * x[1]) + (x[2] * x[2] + x[3] * x[3]); }
                ss += __shfl_xor(ss, 16); ss += __shfl_xor(ss, 32);
                const float rstd = isv ? 1.0f : rsqrtf(ss * (1.f / 64.f) + NORM_EPS) * sc;
                const float pos = (float)(A == 0 ? (s >> 6) : (s & 63));
                pg8::f32x4 o1[2], o2[2];
#pragma unroll
                for (int n = 0; n < 2; ++n) { const pg8::f32x4 x1 = acc[ai][0][m][n] * rstd * gg[0][n], x2 = acc[ai][1][m][n] * rstd * gg[1][n];
                    if (isv) { o1[n] = x1; o2[n] = x2; }
                    else { pg8::f32x4 c, sn;
#pragma unroll
                        for (int i = 0; i < 4; ++i) { const float rv = __builtin_amdgcn_fractf(pos * invr[n][i]); c[i] = __builtin_amdgcn_cosf(rv); sn[i] = __builtin_amdgcn_sinf(rv); }
                        o1[n] = x1 * c - x2 * sn; o2[n] = x2 * c + x1 * sn; } }
                if (isq) store_rows128((unsigned char*)(dst + (size_t)t0 * pitch), pitch * 2, fr, off0, off0 + 32, pack8(o1[0], o1[1]), pack8(o2[0], o2[1]));
                else {
                    const int t = t0 + fr, bq = t >> 11, r64 = t & 63; bf16* blk = KB + (isv ? (size_t)((WS_VB - WS_KB) / 2) : (size_t)0) + ((size_t)(bq * 4 + wc) * 32 + ((t & 2047) >> 6)) * 4096;
                    if (!isv) { bf16* kp = blk + (4 * A + (fq & 1)) * 512 + r64 * 8;
                        *(GAS v4u*)kp = pack8(o1[0], o1[1]); *(GAS v4u*)(kp + 2 * 512) = pack8(o2[0], o2[1]); }
                    else { bf16* vp = blk + (A * 4 + (r64 >> 4)) * 512 + (r64 & 15) * 32 + (fq & 1) * 8;
                        *(GAS v4u*)vp = pack8(o1[0], o1[1]); *(GAS v4u*)(vp + 16) = pack8(o2[0], o2[1]); }
                } }
    }
};
struct SchedMoe {
    pg8::GridOrder go; const char* A; const char* W; size_t wstride; const LAS unsigned char* texp;
    __device__ __forceinline__ bool next(int i, pg8::Unit& u) const { int pm, pn; if (!go.tile(i, pm, pn)) return false; pm = rfl(pm); pn = rfl(pn); const int e = rfl((int)texp[pm]);
        u.a = uptr(A + (size_t)pm * TSTEP8); u.b = uptr(W + (size_t)e * wstride + (size_t)pn * TSTEP8); u.pm = pm; u.pn = pn; u.aux = e; return true; }
};
static_assert(pg8::GATHER_LDS == T_LG2 && LDS_BYTES - pg8::GATHER_LDS >= 16384, "gather offset slots");
struct SchedMoeG {
    pg8::GridOrder go; const char* A; const char* W; size_t wstride; const LAS unsigned char* texp; const int* tokof;
    __device__ __forceinline__ bool next(int i, pg8::Unit& u) const { int pm, pn; if (!go.tile(i, pm, pn)) return false; pm = rfl(pm); pn = rfl(pn); const int e = rfl((int)texp[pm]);
        u.a = uptr(A); u.b = uptr(W + (size_t)e * wstride + (size_t)pn * TSTEP8); u.pm = pm; u.pn = pn; u.aux = e; return true; }
};
struct EpiSwiglu {
    static constexpr bool PERM = true;
    unsigned char* ACT; const float* bup;
    __device__ __forceinline__ void operator()(const pg8::f32x4 (&acc)[2][2][4][2], const pg8::Unit& u, int wr, int wc, int fr_in, int fq_in) const {
        const int ln_ = lane_id(), fr = ln_ & 15, fq = ln_ >> 4; (void)fr_in; (void)fq_in;
        const int cj = u.pn * 128 + wc * 32 + 8 * fq; const float* bb = bup + (size_t)u.aux * 2048 + cj;
        pg8::f32x4 bg[2], bl[2];
#pragma unroll
        for (int n = 0; n < 2; ++n) { bg[n] = *(const pg8::f32x4*)(bb + 4 * n); bl[n] = *(const pg8::f32x4*)(bb + 1024 + 4 * n); }
#pragma unroll
        for (int ai = 0; ai < 2; ++ai)
#pragma unroll
            for (int m = 0; m < 4; ++m) { pg8::f32x4 a[2];
#pragma unroll
                for (int n = 0; n < 2; ++n) { const pg8::f32x4 gl = acc[ai][0][m][n] + bg[n], li = acc[ai][1][m][n] + bl[n];
#pragma unroll
                    for (int i = 0; i < 4; ++i) { const float gx = fminf(gl[i], 7.0f), lx = fminf(fmaxf(li[i], -7.0f), 7.0f);
                        a[n][i] = gx * __builtin_amdgcn_rcpf(1.0f + __builtin_amdgcn_exp2f(gx * (-1.702f * 1.4426950408889634f))) * (lx + 1.0f); } }
                u32x2v o8; o8.x = pk4_fp8(a[0][0], a[0][1], a[0][2], a[0][3]); o8.y = pk4_fp8(a[1][0], a[1][1], a[1][2], a[1][3]);
                *(GAS u32x2v*)(ACT + (size_t)(u.pm * 256 + ai * 128 + wr * 64 + m * 16 + fr) * 1024 + cj) = o8; }
    }
};
struct EpiDown {
    static constexpr bool PERM = true;
    unsigned char* OUTS; const float* bdn; const float* gsort;
    __device__ __forceinline__ void operator()(const pg8::f32x4 (&acc)[2][2][4][2], const pg8::Unit& u, int wr, int wc, int fr_in, int fq_in) const {
        const int ln_ = lane_id(), fr = ln_ & 15, fq = ln_ >> 4; (void)fr_in; (void)fq_in;
        const int c0 = u.pn * 256 + wc * 64 + 16 * fq; const float* bb = bdn + (size_t)u.aux * 1024 + c0;
        pg8::f32x4 bv[2][2];
#pragma unroll
        for (int bj = 0; bj < 2; ++bj)
#pragma unroll
            for (int n = 0; n < 2; ++n) bv[bj][n] = *(const pg8::f32x4*)(bb + 8 * bj + 4 * n);
#pragma unroll
        for (int ai = 0; ai < 2; ++ai)
#pragma unroll
            for (int m = 0; m < 4; ++m) { const int row0 = u.pm * 256 + ai * 128 + wr * 64 + m * 16; const float gt = gsort[row0 + fr] * OUTS_SCALE; v4u o;
#pragma unroll
                for (int bj = 0; bj < 2; ++bj)
#pragma unroll
                    for (int n = 0; n < 2; ++n) { const pg8::f32x4 v = (acc[ai][bj][m][n] + bv[bj][n]) * gt;
                        o[bj * 2 + n] = pk4_fp8(__builtin_amdgcn_fmed3f(v[0], -448.f, 448.f), __builtin_amdgcn_fmed3f(v[1], -448.f, 448.f), __builtin_amdgcn_fmed3f(v[2], -448.f, 448.f), __builtin_amdgcn_fmed3f(v[3], -448.f, 448.f)); }
                *(GAS v4u*)(OUTS + (size_t)(row0 + fr) * 1024 + c0) = o; }
    }
};

__device__ __forceinline__ unsigned p3_swz(int row, int byte) { return (unsigned)(row * 128 + ((((byte >> 4) ^ (row ^ (row >> 4))) & 7) << 4) + (byte & 15)); }
struct P3Out { f32x16 O0, O1; float lse; };
__device__ __forceinline__ P3Out p3_wave_unit(const bf16* QA, const bf16* KA, const bf16* VTA, int g, int h, int p0, int lane) {
    const int r32 = lane & 31, hi = lane >> 5;
    const int sh = g == 0 ? 0 : (g == 1 ? 2 : 4), Lsh = 11 - sh;
    const int seqbase = p0 & ~((1 << Lsh) - 1), jq = (p0 & ((1 << Lsh) - 1)) >> 5, nch = 1 << (Lsh - 5);
    const int lo8 = (hi * 32 + r32) * 8;
    const bf16* Qg = QA + qk_chunk(g, h, p0 >> 5) + lo8;
    const bf16* Kg = KA + qk_chunk(g, h, seqbase >> 5) + lo8;
    const bf16* Vg = VTA + qk_chunk(g, h, seqbase >> 5) + lo8;
    bf16x8 qf[4], kf[5][4]; int cc[5]; bool ok[5];
#pragma unroll
    for (int d0 = 0; d0 < 4; ++d0) qf[d0] = *(const GAS bf16x8*)(Qg + d0 * 512);
#pragma unroll
    for (int ci = 0; ci < 5; ++ci) { const int c = jq - 2 + ci; ok[ci] = (c >= 0) && (c < nch); cc[ci] = c < 0 ? 0 : (c >= nch ? nch - 1 : c);
        const bf16* kp = Kg + (size_t)cc[ci] * 2048;
#pragma unroll
        for (int d0 = 0; d0 < 4; ++d0) kf[ci][d0] = *(const GAS bf16x8*)(kp + d0 * 512); }
    f32x16 S[5];
#pragma unroll
    for (int ci = 0; ci < 5; ++ci) { f32x16 a = {};
#pragma unroll
        for (int d0 = 0; d0 < 4; ++d0) a = __builtin_amdgcn_mfma_f32_32x32x16_bf16(kf[ci][d0], qf[d0], a, 0, 0, 0);
        S[ci] = a; }
    bf16x8 vf[5][2][2];
#pragma unroll
    for (int ci = 0; ci < 5; ++ci)
#pragma unroll
        for (int s2 = 0; s2 < 2; ++s2) { const bf16* vp = Vg + (size_t)cc[ci] * 2048 + s2 * 1024; vf[ci][s2][0] = *(const GAS bf16x8*)vp; vf[ci][s2][1] = *(const GAS bf16x8*)(vp + 512); }
#pragma unroll
    for (int ci = 0; ci < 5; ++ci)
#pragma unroll
        for (int i = 0; i < 16; ++i) { const int kk = 16 * (i >> 3) + 8 * hi + (i & 7);
            bool keep = ok[ci]; if (ci == 0) keep = keep && (kk >= r32); if (ci == 4) keep = keep && (kk <= r32);
            S[ci][i] = keep ? S[ci][i] : -INFINITY; }
    float mx = -INFINITY;
#pragma unroll
    for (int ci = 0; ci < 5; ++ci)
#pragma unroll
        for (int i = 0; i < 16; ++i) mx = fmaxf(mx, S[ci][i]);
    mx = fmaxf(mx, __shfl_xor(mx, 32));
    float sum = 0.f;
#pragma unroll
    for (int ci = 0; ci < 5; ++ci)
#pragma unroll
        for (int i = 0; i < 16; ++i) { const float p = __builtin_amdgcn_exp2f(S[ci][i] - mx); S[ci][i] = p; sum += p; }
    sum += __shfl_xor(sum, 32);
    P3Out R; R.O0 = f32x16{}; R.O1 = f32x16{};
#pragma unroll
    for (int ci = 0; ci < 5; ++ci)
#pragma unroll
        for (int s2 = 0; s2 < 2; ++s2) { v4u pw; pw.x = pkbf(S[ci][8 * s2 + 0], S[ci][8 * s2 + 1]); pw.y = pkbf(S[ci][8 * s2 + 2], S[ci][8 * s2 + 3]); pw.z = pkbf(S[ci][8 * s2 + 4], S[ci][8 * s2 + 5]); pw.w = pkbf(S[ci][8 * s2 + 6], S[ci][8 * s2 + 7]);
            const bf16x8 pf = __builtin_bit_cast(bf16x8, pw);
            R.O0 = __builtin_amdgcn_mfma_f32_32x32x16_bf16(vf[ci][s2][0], pf, R.O0, 0, 0, 0); R.O1 = __builtin_amdgcn_mfma_f32_32x32x16_bf16(vf[ci][s2][1], pf, R.O1, 0, 0, 0); }
    const float inv = 1.0f / sum;
#pragma unroll
    for (int i = 0; i < 16; ++i) { R.O0[i] *= inv; R.O1[i] *= inv; }
    R.lse = (mx + __builtin_amdgcn_logf(sum)) * LN2F;
    return R;
}
__device__ __forceinline__ void p3_attn_a(Frame& F) {
    unsigned char* const wsl = opaque_ptr(F.ws);
    const int lane = lane_id(); const int r32 = lane & 31, hi = lane >> 5, w = F.wave;
    const bf16* QA = (const bf16*)(wsl + WS_QA); const bf16* KA = (const bf16*)(wsl + WS_KA); const bf16* VTA = (const bf16*)(wsl + WS_VTA);
    bf16* O = (bf16*)(wsl + WS_O);
    LAS unsigned char* OL = F.lds;
    LAS float* LL = (LAS float*)(F.lds + 131072);
    for (int bu = blockIdx.x; bu < 512; bu += F.G) {
        const int b = bu >> 6, h = (bu >> 2) & 15, ch = bu & 3, tok0 = b * 2048 + 512 * ch;
#pragma unroll 1
        for (int k = 0; k < 4; ++k) { const int g = 2 - (k >> 1), wu = w + 8 * (k & 1), sh = g == 1 ? 2 : 4;
            const int p0 = b * 2048 + (wu & ((1 << sh) - 1)) * (2048 >> sh) + ((512 * ch) >> sh) + 32 * (wu >> sh);
            const P3Out R = p3_wave_unit(QA, KA, VTA, g, h, p0, lane);
            const int x = unperm_row(p0 + r32, sh) - tok0;
            LAS unsigned char* og = OL + (g - 1) * 65536;
#pragma unroll
            for (int i4 = 0; i4 < 4; ++i4) { u32x2v w0, w1; w0.x = pkbf(R.O0[4 * i4], R.O0[4 * i4 + 1]); w0.y = pkbf(R.O0[4 * i4 + 2], R.O0[4 * i4 + 3]); w1.x = pkbf(R.O1[4 * i4], R.O1[4 * i4 + 1]); w1.y = pkbf(R.O1[4 * i4 + 2], R.O1[4 * i4 + 3]);
                *(LAS u32x2v*)(og + p3_swz(x, 16 * i4 + 8 * hi)) = w0; *(LAS u32x2v*)(og + p3_swz(x, 64 + 16 * i4 + 8 * hi)) = w1; }
            if (hi == 0) LL[(g - 1) * 512 + x] = R.lse;
        }
        __syncthreads();
#pragma unroll 1
        for (int k = 0; k < 2; ++k) { const int wu = w + 8 * k, p0 = tok0 + 32 * wu, x = 32 * wu + r32;
            const P3Out R = p3_wave_unit(QA, KA, VTA, 0, h, p0, lane);
            const float l0 = R.lse, l1 = LL[x], l2 = LL[512 + x], m = fmaxf(l0, fmaxf(l1, l2));
            float w0f = __expf(l0 - m), w1f = __expf(l1 - m), w2f = __expf(l2 - m); const float iw = 1.0f / (w0f + w1f + w2f); w0f *= iw; w1f *= iw; w2f *= iw;
#pragma unroll
            for (int i4 = 0; i4 < 4; ++i4)
#pragma unroll
                for (int db = 0; db < 2; ++db) { const unsigned off = p3_swz(x, 64 * db + 16 * i4 + 8 * hi);
                    const u32x2v a1 = *(const LAS u32x2v*)(OL + off), a2 = *(const LAS u32x2v*)(OL + 65536 + off);
                    const f32x16& Og = db == 0 ? R.O0 : R.O1; u32x2v o;
                    o.x = pkbf(Og[4 * i4] * w0f + bflo(a1.x) * w1f + bflo(a2.x) * w2f, Og[4 * i4 + 1] * w0f + bfhi(a1.x) * w1f + bfhi(a2.x) * w2f);
                    o.y = pkbf(Og[4 * i4 + 2] * w0f + bflo(a1.y) * w1f + bflo(a2.y) * w2f, Og[4 * i4 + 3] * w0f + bfhi(a1.y) * w1f + bfhi(a2.y) * w2f);
                    *(LAS u32x2v*)(OL + off) = o; }
            LDS_WAIT(); asm volatile("" ::: "memory");
#pragma unroll
            for (int s4 = 0; s4 < 4; ++s4) { const int q = 8 * s4 + (lane >> 3), xr = 32 * wu + q; const v4u o = *(const LAS v4u*)(OL + p3_swz(xr, 16 * (lane & 7)));
                *(GAS v4u*)(O + (size_t)(tok0 + xr) * 1024 + h * 64 + 8 * (lane & 7)) = o; }
        }
        __syncthreads();
    }
}
__device__ __forceinline__ void p6a(Frame& F, const Args& args, int layer, const float* xin) {
    unsigned char* const wsl = opaque_ptr(F.ws);
    const int lane = lane_id(); const int w = F.wave;
    const int tokb = blockIdx.x * 64, b = tokb >> 11;
    const float* MOD = (const float*)(wsl + WS_MOD);
    const float* m0 = MOD + (size_t)((layer * 2 + 0) * 8 + b) * 3072; const float* m1 = MOD + (size_t)((layer * 2 + 1) * 8 + b) * 3072;
    const bf16* Y = (const bf16*)(wsl + WS_Y); bf16* XA = (bf16*)(wsl + WS_XA); unsigned char* H2N8 = wsl + WS_H1;
    const bf16* WH = (const bf16*)(wsl + WS_WRT) + (size_t)layer * 32 * 1024; const bf16* WL = WH + 65536;
    const float* br = args.in[IN_BROUTER] + layer * 32;
    LAS int* SEL = (LAS int*)(F.lds + T_SEL); LAS float* GTE = (LAS float*)(F.lds + T_GTE); LAS int* RNK = (LAS int*)(F.lds + T_RNK); LAS float* LG = (LAS float*)(F.lds + T_LG);
    const int th = w & 1, eh = (w >> 1) & 1, kh = w >> 2, l16 = lane & 15, kg = lane >> 4;
    const LAS unsigned char* ah = F.lds + (16 * th + l16) * RT_PITCH + kg * 16 + kh * 1024; const LAS unsigned char* al = ah + RT_LO;
    bf16x8 b_h[16], b_l[16];
    { const bf16* bh = WH + (size_t)(16 * eh + l16) * 1024 + kg * 8 + kh * 512; const bf16* bl = WL + (size_t)(16 * eh + l16) * 1024 + kg * 8 + kh * 512;
#pragma unroll
      for (int ks = 0; ks < 16; ++ks) { b_h[ks] = *(const GAS bf16x8*)(bh + ks * 32); b_l[ks] = *(const GAS bf16x8*)(bl + ks * 32); } }
    for (int rnd = 0; rnd < 2; ++rnd) {
        SEC_BEGIN(1);
#pragma unroll
        for (int tt = 0; tt < 4; ++tt) { const int row = w * 4 + tt, rl = rnd * 32 + row, t = tokb + rl;
            f32x4 y[4], x[4]; float ss = 0.f;
#pragma unroll
            for (int j = 0; j < 4; ++j) { const u32x2v yy = *(const GAS u32x2v*)(Y + (size_t)t * D + 4 * lane + 256 * j); y[j] = (f32x4){bflo(yy.x), bfhi(yy.x), bflo(yy.y), bfhi(yy.y)};
                if (layer == 0) x[j] = *(const GAS f32x4*)(xin + (size_t)t * D + 4 * lane + 256 * j);
                else { const u32x2v xx = *(const GAS u32x2v*)((const bf16*)xin + (size_t)t * D + 4 * lane + 256 * j); x[j] = (f32x4){bflo(xx.x), bfhi(xx.x), bflo(xx.y), bfhi(xx.y)}; }
                ss += dot4(y[j], y[j]); }
            const float rstd1 = rsqrtf(wave_sum(ss) * (1.f / D) + NORM_EPS);
            float ss2 = 0.f;
#pragma unroll
            for (int j = 0; j < 4; ++j) { const int c = 4 * lane + 256 * j; const f32x4 A1 = *(const f32x4*)(m0 + 2048 + c) * *(const f32x4*)(args.in[IN_GPOSTMIX] + layer * 1024 + c);
                x[j] = x[j] + A1 * (y[j] * rstd1); { u32x2v px; px.x = pkbf(x[j][0], x[j][1]); px.y = pkbf(x[j][2], x[j][3]); *(GAS u32x2v*)(XA + (size_t)t * D + c) = px; } ss2 += dot4(x[j], x[j]); }
            const float rstd2 = rsqrtf(wave_sum(ss2) * (1.f / D) + NORM_EPS);
#pragma unroll
            for (int j = 0; j < 4; ++j) { const int c = 4 * lane + 256 * j; const f32x4 A2 = *(const f32x4*)(args.in[IN_GPREFFN] + layer * 1024 + c) * (*(const f32x4*)(m1 + 1024 + c) + 1.0f), S2 = *(const f32x4*)(m1 + c);
                const f32x4 hh = x[j] * rstd2 * A2 + S2; u32x2v ph, pl; ph.x = pkbf(hh[0], hh[1]); ph.y = pkbf(hh[2], hh[3]);
                pl.x = pkbf(hh[0] - bflo(ph.x), hh[1] - bfhi(ph.x)); pl.y = pkbf(hh[2] - bflo(ph.y), hh[3] - bfhi(ph.y));
                *(GAS unsigned*)(H2N8 + (size_t)t * D + c) = pk4_fp8(hh[0], hh[1], hh[2], hh[3]);
                *(LAS u32x2v*)(F.lds + row * RT_PITCH + c * 2) = ph; *(LAS u32x2v*)(F.lds + RT_LO + row * RT_PITCH + c * 2) = pl; }
        }
        __syncthreads();
        SEC_END(1); SEC_BEGIN(2);
        {
            f32x4 acc = {0.f, 0.f, 0.f, 0.f};
#pragma unroll
            for (int ks = 0; ks < 16; ++ks) { const bf16x8 a_h = *(const LAS bf16x8*)(ah + ks * 64), a_l = *(const LAS bf16x8*)(al + ks * 64);
                acc = __builtin_amdgcn_mfma_f32_16x16x32_bf16(a_l, b_h[ks], acc, 0, 0, 0); acc = __builtin_amdgcn_mfma_f32_16x16x32_bf16(a_h, b_l[ks], acc, 0, 0, 0); acc = __builtin_amdgcn_mfma_f32_16x16x32_bf16(a_h, b_h[ks], acc, 0, 0, 0); }
            LAS float* lgp = kh == 0 ? LG : (LAS float*)(F.lds + T_LG2);
#pragma unroll
            for (int i = 0; i < 4; ++i) lgp[(16 * th + 4 * kg + i) * 32 + 16 * eh + l16] = acc[i];
        }
        __syncthreads();
        SEC_END(2); SEC_BEGIN(3);
        { const int l16 = lane & 15, row = w * 4 + (lane >> 4);
            const LAS float* LG2 = (const LAS float*)(F.lds + T_LG2);
            float v0 = (LG[row * 32 + l16] + LG2[row * 32 + l16]) + br[l16], v1 = (LG[row * 32 + 16 + l16] + LG2[row * 32 + 16 + l16]) + br[16 + l16]; const int i0 = l16, i1 = l16 + 16;
            float selv[4]; int seli[4];
#pragma unroll
            for (int kk = 0; kk < 4; ++kk) { float bv = v0; int bi = i0; if (v1 > bv) { bv = v1; bi = i1; }
#pragma unroll
                for (int off = 8; off > 0; off >>= 1) { const float ov = __shfl_xor(bv, off); const int oi = __shfl_xor(bi, off); if (ov > bv || (ov == bv && oi < bi)) { bv = ov; bi = oi; } }
                selv[kk] = bv; seli[kk] = bi; if (bi == i0) v0 = -INFINITY; if (bi == i1) v1 = -INFINITY; }
            const float p1 = __expf(selv[1] - selv[0]), p2 = __expf(selv[2] - selv[0]), p3 = __expf(selv[3] - selv[0]), ip = 1.0f / (1.0f + p1 + p2 + p3);
            if (l16 == 0) { const int rl = rnd * 32 + row;
                SEL[rl * 4 + 0] = seli[0]; SEL[rl * 4 + 1] = seli[1]; SEL[rl * 4 + 2] = seli[2]; SEL[rl * 4 + 3] = seli[3];
                GTE[rl * 4 + 0] = ip; GTE[rl * 4 + 1] = p1 * ip; GTE[rl * 4 + 2] = p2 * ip; GTE[rl * 4 + 3] = p3 * ip; }
        }
        SEC_END(3);
    }
    SEC_BEGIN(4);
    __syncthreads();
    if (w == 0) {
        const int s0 = SEL[lane * 4 + 0], s1 = SEL[lane * 4 + 1], s2 = SEL[lane * 4 + 2], s3 = SEL[lane * 4 + 3];
        int r0 = 0, r1 = 0, r2 = 0, r3 = 0, cnt = 0;
        const unsigned long long below = (1ull << lane) - 1ull;
        for (int e = 0; e < 32; ++e) { const bool has = (s0 == e) | (s1 == e) | (s2 == e) | (s3 == e); const unsigned long long mk = __ballot(has); const int rk = __popcll(mk & below);
            if (s0 == e) r0 = rk; if (s1 == e) r1 = rk; if (s2 == e) r2 = rk; if (s3 == e) r3 = rk; if (lane == e) cnt = __popcll(mk); }
        RNK[lane * 4 + 0] = r0; RNK[lane * 4 + 1] = r1; RNK[lane * 4 + 2] = r2; RNK[lane * 4 + 3] = r3;
        if (lane < 32) ((int*)(wsl + WS_HIST))[blockIdx.x * 32 + lane] = cnt;
    }
    SEC_END(4);
}
__device__ __forceinline__ void moe_tile_table(Frame& F, const int* tot  ) {
    if (F.wave == 0) { const int lane = lane_id(); LAS unsigned char* TEXP = (LAS unsigned char*)(F.lds + T_TEXP);
        const int nt = lane < 32 ? ((tot[lane & 31] + 255) >> 8) : 0; int inc = nt;
#pragma unroll
        for (int o = 1; o < 32; o <<= 1) { const int v = __shfl_up(inc, o); if ((lane & 31) >= o) inc += v; }
        const int first = inc - nt;
        for (int q = 0; q < nt; ++q) TEXP[first + q] = (unsigned char)lane;
        if (lane == 31) *(LAS int*)(F.lds + T_MT) = inc; }
}
__device__ __forceinline__ void p6b(Frame& F) {
    unsigned char* const wsl = opaque_ptr(F.ws);
    const int lane = lane_id(); const int w = F.wave, tokb = blockIdx.x * 64;
    LAS int* SEL = (LAS int*)(F.lds + T_SEL); LAS float* GTE = (LAS float*)(F.lds + T_GTE); LAS int* RNK = (LAS int*)(F.lds + T_RNK);
    LAS int* TOT = (LAS int*)(F.lds + T_TOT); LAS int* BEF = (LAS int*)(F.lds + T_BEF); LAS int* MYOFF = (LAS int*)(F.lds + T_MYOFF);
    const int* HIST = (const int*)(wsl + WS_HIST);
    const int tid = F.wave * 64 + lane;
    SEC_BEGIN(5);
    {
        LAS int* PT = (LAS int*)(F.lds + 65536); LAS int* PB = PT + 512;
        const int e = tid & 31, part = tid >> 5; int c[16];
#pragma unroll
        for (int k = 0; k < 16; ++k) c[k] = HIST[(part * 16 + k) * 32 + e];
        int tot = 0, bef = 0;
#pragma unroll
        for (int k = 0; k < 16; ++k) { tot += c[k]; bef += (part * 16 + k < (int)blockIdx.x) ? c[k] : 0; }
        PT[part * 32 + e] = tot; PB[part * 32 + e] = bef;
        __syncthreads();
        if (tid < 32) { int t2 = 0, b2 = 0;
#pragma unroll
            for (int k = 0; k < 16; ++k) { t2 += PT[k * 32 + tid]; b2 += PB[k * 32 + tid]; }
            TOT[tid] = t2; BEF[tid] = b2; if (blockIdx.x == 0) ((int*)(wsl + WS_TOT))[tid] = t2; }
    }
    __syncthreads();
    if (w == 0) { const int nt = lane < 32 ? ((TOT[lane & 31] + 255) >> 8) : 0; int inc = nt;
#pragma unroll
        for (int o = 1; o < 32; o <<= 1) { const int v = __shfl_up(inc, o); if ((lane & 31) >= o) inc += v; }
        if (lane < 32) MYOFF[lane] = (inc - nt) * 256 + BEF[lane];
        LAS unsigned char* TEXP = (LAS unsigned char*)(F.lds + T_TEXP); const int first = inc - nt;
        for (int q = 0; q < nt; ++q) TEXP[first + q] = (unsigned char)lane;
        if (lane == 31) *(LAS int*)(F.lds + T_MT) = inc; }
    __syncthreads();
    int* TOKOF = (int*)(wsl + WS_XS); float* GS = (float*)(wsl + WS_GSORT); int* POSOF = (int*)(wsl + WS_POSOF);
    SEC_END(5); SEC_BEGIN(6);
    if (tid < 256) { const int e = SEL[tid]; const int pos = MYOFF[e] + RNK[tid];
        TOKOF[pos] = tokb + (tid >> 2); GS[pos] = GTE[tid]; POSOF[tokb * 4 + tid] = pos; }
    if (blockIdx.x < 32) { const int e = blockIdx.x, cnt = TOT[e], base = MYOFF[e] - BEF[e], end = (cnt + 255) & ~255;
        for (int i = cnt + tid; i < end; i += NWAVES * 64) TOKOF[base + i] = 0; }
    asm volatile("s_waitcnt vmcnt(0)" ::: "memory");
    SEC_END(6);
}
__device__ __forceinline__ void p9_post(Frame& F, const Args& args, int layer) {
    unsigned char* const wsl = opaque_ptr(F.ws);
    const int lane = lane_id(); const int gw = blockIdx.x * NWAVES + F.wave, NGW = F.G * NWAVES;
    const bool last = layer == 1;
    const float* MOD = (const float*)(wsl + WS_MOD);
    const unsigned char* OUTS = wsl + WS_OUTS; const int* POSOF = (const int*)(wsl + WS_POSOF); bf16* XA = (bf16*)(wsl + WS_XA); bf16* H0 = (bf16*)(wsl + WS_H0);
    for (int t0 = gw * 8; t0 < T; t0 += NGW * 8) {
        const int b = t0 >> 11;
        const float* m1 = MOD + (size_t)((layer * 2 + 1) * 8 + b) * 3072; const float* mn = MOD + (size_t)((1 * 2 + 0) * 8 + b) * 3072;
        f32x4 A3[4], A4[4], S4[4];
#pragma unroll
        for (int j = 0; j < 4; ++j) { const int c = 4 * lane + 256 * j;
            A3[j] = *(const f32x4*)(m1 + 2048 + c) * *(const f32x4*)(args.in[IN_GPOSTFFN] + layer * 1024 + c);
            A4[j] = *(const f32x4*)(args.in[IN_GPREMIX] + 1024 + c) * (*(const f32x4*)(mn + 1024 + c) + 1.0f); S4[j] = *(const f32x4*)(mn + c); }
        const int posv = POSOF[t0 * 4 + (lane & 31)];
        for (int i0 = 0; i0 < 8; i0 += 2) {
            unsigned q[2][4][4]; u32x2v xr[2][4];
#pragma unroll
            for (int u = 0; u < 2; ++u) { const int t = t0 + i0 + u;
#pragma unroll
                for (int k = 0; k < 4; ++k) { const int p = __builtin_amdgcn_readlane(posv, (i0 + u) * 4 + k);
#pragma unroll
                    for (int j = 0; j < 4; ++j) q[u][k][j] = *(const GAS unsigned*)(OUTS + (size_t)p * 1024 + 4 * lane + 256 * j); }
#pragma unroll
                for (int j = 0; j < 4; ++j) xr[u][j] = *(const GAS u32x2v*)(XA + (size_t)t * D + 4 * lane + 256 * j); }
#pragma unroll
            for (int u = 0; u < 2; ++u) { const int t = t0 + i0 + u;
                f32x4 y[4]; float ss = 0.f;
#pragma unroll
                for (int j = 0; j < 4; ++j) { const unsigned a = q[u][0][j], bq = q[u][1][j], cq = q[u][2][j], dq = q[u][3][j];
                    const f32x2v al = __builtin_amdgcn_cvt_pk_f32_fp8(a, false), ah = __builtin_amdgcn_cvt_pk_f32_fp8(a, true), bl = __builtin_amdgcn_cvt_pk_f32_fp8(bq, false), bh = __builtin_amdgcn_cvt_pk_f32_fp8(bq, true);
                    const f32x2v cl = __builtin_amdgcn_cvt_pk_f32_fp8(cq, false), ch = __builtin_amdgcn_cvt_pk_f32_fp8(cq, true), dl = __builtin_amdgcn_cvt_pk_f32_fp8(dq, false), dh = __builtin_amdgcn_cvt_pk_f32_fp8(dq, true);
                    y[j] = (f32x4){((al[0] + bl[0]) + cl[0]) + dl[0], ((al[1] + bl[1]) + cl[1]) + dl[1], ((ah[0] + bh[0]) + ch[0]) + dh[0], ((ah[1] + bh[1]) + ch[1]) + dh[1]} * (1.0f / OUTS_SCALE);
                    ss += dot4(y[j], y[j]); }
                const float rstd = rsqrtf(wave_sum(ss) * (1.f / D) + NORM_EPS);
                f32x4 x[4]; float ss2 = 0.f;
#pragma unroll
                for (int j = 0; j < 4; ++j) { const u32x2v xx = xr[u][j]; x[j] = (f32x4){bflo(xx.x), bfhi(xx.x), bflo(xx.y), bfhi(xx.y)} + A3[j] * (y[j] * rstd); ss2 += dot4(x[j], x[j]); }
                if (last) {
#pragma unroll
                    for (int j = 0; j < 4; ++j) *(GAS f32x4*)(F.out + (size_t)t * D + 4 * lane + 256 * j) = x[j];
                } else {
                    const float rstd2 = rsqrtf(wave_sum(ss2) * (1.f / D) + NORM_EPS);
#pragma unroll
                    for (int j = 0; j < 4; ++j) { const int c = 4 * lane + 256 * j; { u32x2v px; px.x = pkbf(x[j][0], x[j][1]); px.y = pkbf(x[j][2], x[j][3]); *(GAS u32x2v*)(XA + (size_t)t * D + c) = px; }
                        const f32x4 hh = x[j] * rstd2 * A4[j] + S4[j]; u32x2v pw; pw.x = pkbf(hh[0], hh[1]); pw.y = pkbf(hh[2], hh[3]); *(GAS u32x2v*)(H0 + (size_t)t * D + c) = pw; }
                }
            }
        }
    }
}
constexpr int N_PHASES = 19;
#define COMMON_PHASES(layer, pb) \
    const int P_OUT = pb + 3, P_T1 = pb + 4, P_T2 = pb + 5, P_UP = pb + 6, P_DN = pb + 7, P_POST = pb + 8; \
    if (IN(P_OUT)) for (int rep_ = 0; rep_ < 1 + DUPF(P_OUT); ++rep_) { if (rep_) __syncthreads(); \
        SchedPlain S; S.go.init(64, 4, F.G, (int)blockIdx.x); S.A = (const char*)(ws + WS_O); S.B = (const char*)(ws + (layer == 0 ? WS_WOUTA : WS_WOUTB)); \
        EpiPlain E{(bf16*)(ws + WS_Y), 1024}; \
        pg8::gemm_phase<EpiPlain, SchedPlain, true, true>(F.lds, (const char*)ws, 1024, S, E, F.wave); \
    } SEAM(P_OUT); \
    if (IN(P_T1)) for (int rep_ = 0; rep_ < 1 + DUPF(P_T1); ++rep_) { if (rep_) __syncthreads(); p6a(F, args, layer, layer == 0 ? args.in[IN_X] : (const float*)(ws + WS_XA)); } SEAM(P_T1); \
    if (IN(P_T2)) for (int rep_ = 0; rep_ < 1 + DUPF(P_T2); ++rep_) { if (rep_) __syncthreads(); p6b(F); } SEAM(P_T2); \
    if (IN(P_UP)) for (int rep_ = 0; rep_ < 1 + DUPF(P_UP); ++rep_) { if (rep_) __syncthreads(); \
        SchedMoeG S; S.go.init(*(LAS int*)(F.lds + T_MT), 8, F.G, (int)blockIdx.x); S.A = (const char*)(ws + WS_H1); S.W = (const char*)(ws + WS_WUP) + (size_t)layer * 32 * 2048 * 1024; S.wstride = (size_t)2048 * 1024; \
        S.texp = (const LAS unsigned char*)(F.lds + T_TEXP); S.tokof = (const int*)(ws + WS_XS); \
        EpiSwiglu E{ws + WS_ACT, args.in[IN_BUP] + (size_t)layer * 32 * 2048}; \
        pg8::gemm_phase<EpiSwiglu, SchedMoeG, true, true, true, true>(F.lds, (const char*)ws, 512, S, E, F.wave); \
    } SEAM(P_UP); \
    if (IN(P_DN)) for (int rep_ = 0; rep_ < 1 + DUPF(P_DN); ++rep_) { if (rep_) __syncthreads(); \
        SchedMoe S; S.go.init(*(LAS int*)(F.lds + T_MT), 4, F.G, (int)blockIdx.x); S.A = (const char*)(ws + WS_ACT); S.W = (const char*)(ws + WS_WDOWN) + (size_t)layer * 32 * 1024 * 1024; S.wstride = (size_t)1024 * 1024; \
        S.texp = (const LAS unsigned char*)(F.lds + T_TEXP); \
        EpiDown E{ws + WS_OUTS, args.in[IN_BDOWN] + (size_t)layer * 32 * 1024, (const float*)(ws + WS_GSORT)}; \
        pg8::gemm_phase<EpiDown, SchedMoe, true, true, true>(F.lds, (const char*)ws, 512, S, E, F.wave); \
    } SEAM(P_DN); \
    if (IN(P_POST)) for (int rep_ = 0; rep_ < 1 + (DUPF(10) && layer == 1); ++rep_) { if (rep_) __syncthreads(); p9_post(F, args, layer); }
__global__ void __launch_bounds__(NWAVES * 64, 2) mega_fwd(Args args) {
    extern __shared__ __attribute__((aligned(16))) unsigned char lds[];
    Frame F;
    F.lds = (LAS unsigned char*)lds;
    F.MISC = (volatile LAS unsigned*)(F.lds + MISC_OFF);
    F.wave = __builtin_amdgcn_readfirstlane((int)threadIdx.x >> 6);
    F.G = gridDim.x; { const int bx = blockIdx.x; F.vcu = (bx % 8) * (F.G / 8) + bx / 8; }
    F.out = args.out; F.ws = args.ws; F.ctl = (gu32*)(args.ws + WS_CTL);
    for (int u = threadIdx.x; u < (LDS_BYTES - LDSCTL_OFF) / 4; u += NWAVES * 64) ((LAS unsigned*)(F.lds + LDSCTL_OFF))[u] = 0u;
    __syncthreads();
    XcdBarrier bar = xcd_barrier_post((unsigned*)(F.ctl + CW_BAR) + args.li * XCD_BAR_WORDS, F.MISC + 8);
    const int lo = args.ph_lo, hi = args.ph_hi;
#ifndef DUP_MASK
#define DUP_MASK 0u
#endif
#define DUPF(k) ((int)((DUP_MASK >> (k)) & 1u))
#ifndef PHMASK
#define PHMASK 0xFFFFFFFFu
#endif
#define IN(k) (((PHMASK >> ((k) > 10 ? (k) - 8 : (k))) & 1u) && lo <= (k) && (k) < hi)
#define SEAM(k) do { if (IN(k) && IN((k) + 1)) { xcd_barrier(bar); if (DUPF(20)) xcd_barrier(bar); } } while (0)

    if (IN(0)) for (int rep_ = 0; rep_ < 1 + DUPF(0); ++rep_) { if (rep_) __syncthreads(); p0_prologue(F, args); } SEAM(0);
    if (IN(1)) for (int rep_ = 0; rep_ < 1 + DUPF(1); ++rep_) { if (rep_) __syncthreads(); p1_prenorm0(F, args); } SEAM(1);

    { unsigned char* ws = opaque_ptr(args.ws);
        if (IN(2)) for (int rep_ = 0; rep_ < 1 + DUPF(2); ++rep_) { if (rep_) __syncthreads();
            { SchedInaQK S; S.go.init(64, 24, F.G, (int)blockIdx.x); S.h0 = (const char*)(ws + WS_H0); S.w = (const char*)(ws + WS_WINA_QK);
              EpiRopeA E{(bf16*)(ws + WS_QA), (bf16*)(ws + WS_KA)};
              pg8::gemm_phase<EpiRopeA, SchedInaQK, true, true, true>(F.lds, (const char*)ws, 512, S, E, F.wave); }
            { SchedInaV S; S.go.init(12, 64, F.G, (int)blockIdx.x); S.h0 = (const char*)(ws + WS_H0); S.w = (const char*)(ws + WS_WINA_V);
              EpiVt E{(bf16*)(ws + WS_VTA)};
              pg8::gemm_phase<EpiVt, SchedInaV, true, true, true>(F.lds, (const char*)ws, 512, S, E, F.wave); }
        } SEAM(2);
        if (IN(3)) for (int rep_ = 0; rep_ < 1 + DUPF(3); ++rep_) { if (rep_) __syncthreads(); p3_attn_a(F); } do { if (IN(3) && IN(5)) xcd_barrier(bar); } while (0);
    }
    { unsigned char* ws = opaque_ptr(args.ws); COMMON_PHASES(0, 2) }
    SEAM(10);
    { unsigned char* ws = opaque_ptr(args.ws);
        if (IN(11)) for (int rep_ = 0; rep_ < 1 + DUPF(11); ++rep_) { if (rep_) __syncthreads();
            SchedPlain S; S.go.init(64, 6, F.G, (int)blockIdx.x); S.A = (const char*)(ws + WS_H0); S.B = (const char*)(ws + WS_WINB);
            EpiInB E{(bf16*)(ws + WS_QB), (bf16*)(ws + WS_KB), (bf16*)(ws + WS_VB), args.in[IN_GQB], args.in[IN_GKB]};
            pg8::gemm_phase<EpiInB, SchedPlain, true, true>(F.lds, (const char*)ws, 1024, S, E, F.wave);
        } SEAM(11);
        if (IN(12)) for (int rep_ = 0; rep_ < 1 + DUPF(12); ++rep_) { if (rep_) __syncthreads();
            const int xcd = F.vcu >> 5, j = F.vcu & 31;
            for (int i = 0; i < 4; ++i) { const int pair = xcd * 4 + i, b = pair >> 2, kvh = pair & 3, hq = kvh * 4 + (j >> 3), qb = j & 7;
                attn_body::attn_unit<8>(b, hq, kvh, qb, (const attn_body::bf16*)(ws + WS_QB), (const attn_body::bf16*)(ws + WS_KB), (const attn_body::bf16*)(ws + WS_VB), (attn_body::bf16*)(ws + WS_O), (char*)lds, F.wave); }
        } SEAM(12);
    }
    { unsigned char* ws = opaque_ptr(args.ws); COMMON_PHASES(1, 10) }
    if (PSEC > 0) { __syncthreads(); const unsigned long long te_ = __builtin_amdgcn_s_memrealtime(); const unsigned dd_ = F.MISC[16]; while (__builtin_amdgcn_s_memrealtime() - te_ < dd_) __builtin_amdgcn_s_sleep(8); }
#undef IN
#undef SEAM
#undef COMMON_PHASES
}
static int g_grid = 0;
static bool mega_setup() {
    if (g_grid == 0) {
        int dev = 0, cus = 0;
        if (hipGetDevice(&dev) != hipSuccess || hipDeviceGetAttribute(&cus, hipDeviceAttributeMultiprocessorCount, dev) != hipSuccess) { g_grid = -1; return false; }
        if (hipFuncSetAttribute((const void*)mega_fwd, hipFuncAttributeMaxDynamicSharedMemorySize, LDS_BYTES) != hipSuccess) { fprintf(stderr, "hipFuncSetAttribute failed\n"); g_grid = -1; return false; }
        int per_cu = 0;
        if (hipOccupancyMaxActiveBlocksPerMultiprocessor(&per_cu, (const void*)mega_fwd, NWAVES * 64, LDS_BYTES) != hipSuccess || per_cu < 1) { fprintf(stderr, "occupancy query: %d\n", per_cu); }
        (void)hipGetLastError();
        if (cus != 256) { fprintf(stderr, "built for 256 CUs, found %d\n", cus); g_grid = -1; return false; }
        g_grid = 256;
    }
    return g_grid > 0;
}
static void mega_launch(void* const* d_in, float* out, unsigned char* ws, int lo, int hi, int li, hipStream_t stream) {
    Args a{};
    for (int i = 0; i < 20; ++i) a.in[i] = (const float*)d_in[i];
    a.out = out; a.ws = ws; a.ph_lo = lo; a.ph_hi = hi; a.li = li; a.pad = 0;
    hipLaunchKernelGGL(mega_fwd, dim3(g_grid), dim3(NWAVES * 64), LDS_BYTES, stream, a);
}
extern "C" void kernel_launch(void* const* d_in, const int* in_sizes, int n_in, void* d_out, int out_size, void* d_ws, size_t ws_size, hipStream_t stream) {
    if (n_in != 20 || ws_size < WS_END || out_size != T * D) { fprintf(stderr, "kernel_launch: unexpected n_in %d / ws %zu / out %d\n", n_in, ws_size, out_size); return; }
    if (!mega_setup()) return;
    unsigned char* ws = (unsigned char*)d_ws;
    (void)hipMemsetAsync(ws + WS_CTL, 0, CTL_ZERO_BYTES, stream);
    mega_launch(d_in, (float*)d_out, ws, 0, N_PHASES, 0, stream);
}
```

```cpp
#include <hip/hip_runtime.h>
#include <cstdio>
#include <cstdint>
#include <cmath>
#define GAS __attribute__((address_space(1)))
#define LAS __attribute__((address_space(3)))
typedef unsigned short bf16;
typedef unsigned v4u __attribute__((ext_vector_type(4)));
typedef float f32x4 __attribute__((ext_vector_type(4)));
typedef short bf16x8 __attribute__((ext_vector_type(8)));
typedef GAS unsigned gu32;
typedef GAS unsigned long long gu64;
#define RLX_AGENT __ATOMIC_RELAXED, __HIP_MEMORY_SCOPE_AGENT
#define LDS_WAIT() asm volatile("s_waitcnt lgkmcnt(0)" ::: "memory")
#define VM_WAIT() asm volatile("s_waitcnt vmcnt(0)" ::: "memory")
__device__ __forceinline__ unsigned long long rt() { return __builtin_amdgcn_s_memrealtime(); }
__device__ __forceinline__ unsigned f2bf(float f) { unsigned u = __builtin_bit_cast(unsigned, f); return (u + 0x7fffu + ((u >> 16) & 1u)) >> 16; }
__device__ __forceinline__ unsigned pk2(float lo, float hi) { return f2bf(lo) | (f2bf(hi) << 16); }

#define XB_TMO      128
#define XB_XCNT(j)  (256  + 64 * (j))
#define XB_XSUB(j)  (1280 + 64 * (j))
#define XB_XGEN(j)  (2304 + 64 * (j))
#define XB_TOP      3328
#define XB_TOPGEN   3392
#define XCD_BAR_WORDS 3456
#define XB_SPIN_CAP (1u << 18)

__device__ __forceinline__ unsigned xb_ld(unsigned* p)              { return __hip_atomic_load(p, __ATOMIC_RELAXED, __HIP_MEMORY_SCOPE_AGENT); }
__device__ __forceinline__ unsigned xb_add(unsigned* p, unsigned v) { return __hip_atomic_fetch_add(p, v, __ATOMIC_RELAXED, __HIP_MEMORY_SCOPE_AGENT); }
__device__ __forceinline__ unsigned xb_xcc_id() { return (unsigned)__builtin_amdgcn_s_getreg((3 << 11) | 20) & 0xFu; }
#define XB_SPIN(cond, bar) do { unsigned _sp = 0; while (cond) { __builtin_amdgcn_s_sleep(1); \
    if ((++_sp & 255u) == 0u) { if (xb_ld(&(bar)[XB_TMO])) break; if (_sp > XB_SPIN_CAP) { atomicAdd(&(bar)[XB_TMO], 1u); break; } } } } while (0)

struct XcdBarrier {
    unsigned* bar; unsigned x;
    volatile LAS unsigned* st;
};

__device__ __forceinline__ XcdBarrier xcd_barrier_post(unsigned* bar, volatile LAS unsigned* st) {
    XcdBarrier b; b.bar = bar; b.x = xb_xcc_id(); b.st = st;
    if (threadIdx.x == 0) (void)xb_add(&bar[XB_XCNT(b.x)], 1u);
    return b;
}
__device__ __forceinline__ void xcd_barrier_complete(unsigned* bar, unsigned x, unsigned& nloc, unsigned& nx) {
    const unsigned G = gridDim.x * gridDim.y * gridDim.z;
    unsigned sum, cnt, mine, sp = 0u;
    for (;;) {
        sum = 0u; cnt = 0u; mine = 0u;
#pragma unroll
        for (unsigned j = 0; j < 16; ++j) { const unsigned c = xb_ld(&bar[XB_XCNT(j)]); sum += c; cnt += (c > 0u) ? 1u : 0u; mine = (j == x) ? c : mine; }
        if (sum == G) break;
        __builtin_amdgcn_s_sleep(1);
        if ((++sp & 255u) == 0u) { if (xb_ld(&bar[XB_TMO])) break; if (sp > XB_SPIN_CAP) { atomicAdd(&bar[XB_TMO], 1u); break; } }
    }
    nloc = mine > 0u ? mine : 1u; nx = cnt > 0u ? cnt : 1u;
}

__device__ __forceinline__ void xcd_barrier(const XcdBarrier& b) {
    asm volatile("s_waitcnt vmcnt(0)" ::: "memory");
    __syncthreads();
    if (threadIdx.x == 0) {
        unsigned* bar = b.bar;
        __builtin_amdgcn_s_waitcnt(0);
        unsigned nloc = b.st[0], nx = b.st[1];
        if (nloc == 0u) { xcd_barrier_complete(bar, b.x, nloc, nx); b.st[0] = nloc; b.st[1] = nx; }
        const unsigned old = xb_add(&bar[XB_XSUB(b.x)], 1u);
        const unsigned gen = old / nloc;
        if (old + 1u == (gen + 1u) * nloc) {
            __builtin_amdgcn_fence(__ATOMIC_RELEASE, "agent");
            asm volatile("s_waitcnt vmcnt(0)" ::: "memory");
            const unsigned og = xb_add(&bar[XB_TOP], 1u);
            const unsigned tg = og / nx;
            if (og + 1u == (tg + 1u) * nx) xb_add(&bar[XB_TOPGEN], 1u);
            else XB_SPIN(xb_ld(&bar[XB_TOPGEN]) == tg, bar);
            __builtin_amdgcn_fence(__ATOMIC_ACQUIRE, "agent");
            xb_add(&bar[XB_XGEN(b.x)], 1u);
            asm volatile("s_waitcnt vmcnt(0)" ::: "memory");
        } else {
            XB_SPIN(xb_ld(&bar[XB_XGEN(b.x)]) == gen, bar);
            __builtin_amdgcn_fence(__ATOMIC_ACQUIRE, "agent");
            asm volatile("s_waitcnt vmcnt(0)" ::: "memory");
        }
    }
    __syncthreads();
}
namespace pg8 {
#define PG8_LAS __attribute__((address_space(3)))
typedef unsigned short bf16_t;
typedef short bf16x8 __attribute__((ext_vector_type(8)));
typedef float f32x4 __attribute__((ext_vector_type(4)));
typedef unsigned u32x4 __attribute__((ext_vector_type(4)));
typedef int v4i_t __attribute__((ext_vector_type(4)));
typedef int v8i_t __attribute__((ext_vector_type(8)));
constexpr int BM = 256, BK = 64, HALF = 128, HTB = HALF * BK * 2  , STAGE_BYTES = 8 * HTB, NXCD = 8, WGM = 8;

__host__ __device__ __forceinline__ int lds_byte(int r, int c) { const int st = (r >> 4) * 2 + (c >> 5), rr = r & 15, cc = c & 31, ob = rr * 64 + cc * 2; return st * 1024 + (ob ^ (((ob >> 9) & 1) << 5)); }
__host__ __device__ __forceinline__ void stage_rc(int b, int& R, int& C) { const int st = b / 1024, sb = b % 1024, swz = sb ^ (((sb >> 9) & 1) << 5); R = (st >> 1) * 16 + swz / 64; C = (st & 1) * 32 + (swz % 64) / 2; }
__host__ __device__ __forceinline__ int perm32(int rho) { const int n = rho >> 4, i = rho & 15; return 8 * (i >> 2) + 4 * n + (i & 3); }

constexpr int GATHER_LDS = 147456;
typedef unsigned v4u_t __attribute__((ext_vector_type(4)));
struct Unit { const char* a; const char* b; int pm, pn, aux; };
typedef unsigned u32x2 __attribute__((ext_vector_type(2)));
__device__ __forceinline__ unsigned cvt_pk_bf16(float lo, float hi) { unsigned r; asm volatile("v_cvt_pk_bf16_f32 %0, %1, %2" : "=v"(r) : "v"(lo), "v"(hi)); return r; }
struct GridOrder {
    int nM, nN, nwg, G, c;
    __device__ __forceinline__ void init(int nM_, int nN_, int G_, int c_) { nM = nM_; nN = nN_; nwg = nM * nN; G = G_; c = c_; }
    __device__ __forceinline__ bool tile(int i, int& pm, int& pn) const {
        const int L = i * G + c; if (L >= nwg) return false;
        int wgid = L; { const int q = nwg / NXCD, r = nwg % NXCD, xcd = wgid % NXCD, off = wgid / NXCD; wgid = (xcd < r ? xcd * (q + 1) : r * (q + 1) + (xcd - r) * q) + off; }
        const int nig = WGM * nN, gid = wgid / nig, fm = gid * WGM, gsz = (nM - fm) < WGM ? (nM - fm) : WGM;
        pm = fm + ((wgid % nig) % gsz); pn = (wgid % nig) / gsz; return true;
    }
};

template <class Epi, class Sched, bool ALIGN_EPI = false, bool SP2 = false, bool F8 = false, bool GATHER = false>
__device__ __forceinline__ void gemm_phase(PG8_LAS unsigned char* lds, const char* rbase  , const int K, const Sched& S, const Epi& E, const int wid_in  ) {
    static_assert(!GATHER || SP2, "the gathered A tile is wired into the SP2 schedule only");
    int lane; asm volatile("v_mbcnt_lo_u32_b32 %0, -1, 0\n\tv_mbcnt_hi_u32_b32 %0, -1, %0" : "=v"(lane));
    const int wid = wid_in, tid = wid * 64 + lane, wr = wid >> 2, wc = wid & 3, fr = lane & 15, fq = lane >> 4;
    const int nt = K / BK;
    int sc_ab = 122 | (127 << 8); asm volatile("" : "+v"(sc_ab));
    const __amdgpu_buffer_rsrc_t rsrc = __builtin_amdgcn_make_buffer_rsrc((void*)rbase, 0, 0xffffffff, 0x00020000);
    unsigned voffA[2], voffB[2];
#pragma unroll
    for (int i = 0; i < 2; ++i) { int R, C; stage_rc(tid * 16 + i * 8192, R, C); const int Rb = Epi::PERM ? ((R & ~31) + perm32(R & 31)) : R;
        voffA[i] = (unsigned)(R * K + C) * 2u; voffB[i] = (unsigned)(Rb * K + C) * 2u; }
    const size_t kstep = (size_t)(BK * 2);
    const size_t hstep = (size_t)HALF * K * 2;
    const size_t hstepA = GATHER ? (size_t)0 : hstep;
    const unsigned ldsw = (unsigned)wid * 1024u;
    const int aoff = lds_byte(wr * 64 + fr, fq * 8), boff = lds_byte(wc * 32 + fr, fq * 8);
#define PG8_SA(b, h) (((b) * 2 + (h)) * HTB)
#define PG8_SB(b, h) ((4 + (b) * 2 + (h)) * HTB)
#define PG8_STAGE(bufoff, gbase, voff) do { const unsigned _so = (unsigned)((const char*)(gbase) - rbase); _Pragma("unroll") for (int _i = 0; _i < 2; ++_i) \
        __builtin_amdgcn_raw_ptr_buffer_load_lds(rsrc, (PG8_LAS unsigned*)(lds + (bufoff) + ldsw + _i * 8192), 16, (voff)[_i], _so, 0, 0); } while (0)
#define PG8_GSLOT(set_, h_) (lds + GATHER_LDS + (set_) * 8192 + tid * 16 + (h_) * 8)
#define PG8_GQ(q_, h_, nx_) u32x2 q_; if constexpr (GATHER) q_ = *(const PG8_LAS u32x2*)PG8_GSLOT((ui & 1) ^ ((nx_) ? 1 : 0), h_); else q_ = (u32x2){voffA[0], voffA[1]}
#define PG8_STAGE_Q(bufoff, gbase, q_) do { const unsigned _so = (unsigned)((const char*)(gbase) - rbase); \
        __builtin_amdgcn_raw_ptr_buffer_load_lds(rsrc, (PG8_LAS unsigned*)(lds + (bufoff) + ldsw), 16, (q_).x, _so, 0, 0); \
        __builtin_amdgcn_raw_ptr_buffer_load_lds(rsrc, (PG8_LAS unsigned*)(lds + (bufoff) + ldsw + 8192), 16, (q_).y, _so, 0, 0); } while (0)
#define PG8_GCALC(dst, pm_) do { int l2_; asm volatile("v_mbcnt_lo_u32_b32 %0, -1, 0\n\tv_mbcnt_hi_u32_b32 %0, -1, %0" : "=v"(l2_)); const int t2_ = wid * 64 + l2_;     \
        const __attribute__((address_space(1))) int* tk_ = (const __attribute__((address_space(1))) int*)S.tokof + (pm_) * 256; \
        _Pragma("unroll") for (int _h = 0; _h < 2; ++_h) _Pragma("unroll") for (int _i = 0; _i < 2; ++_i) { int R_, C_; stage_rc(t2_ * 16 + _i * 8192, R_, C_); \
        dst[_h * 2 + _i] = (unsigned)tk_[_h * 128 + R_] * (unsigned)(K * 2) + (unsigned)C_ * 2u; } } while (0)
#define PG8_LD8(p) __builtin_shufflevector(*(const PG8_LAS v4i_t*)(p), *(const PG8_LAS v4i_t*)((p) + 1024), 0, 1, 2, 3, 4, 5, 6, 7)
#define PG8_LDA(dst, b, h) do { if constexpr (F8) { _Pragma("unroll") for (int m = 0; m < 4; ++m) dst##8[m] = PG8_LD8(lds + PG8_SA(b, h) + aoff + m * 2048); } else { \
        _Pragma("unroll") for (int m = 0; m < 4; ++m) _Pragma("unroll") for (int k = 0; k < 2; ++k) dst[m][k] = *(const PG8_LAS bf16x8*)(lds + PG8_SA(b, h) + aoff + m * 2048 + k * 1024); } } while (0)
#define PG8_LDB(dst, b, h) do { if constexpr (F8) { _Pragma("unroll") for (int n = 0; n < 2; ++n) dst##8[n] = PG8_LD8(lds + PG8_SB(b, h) + boff + n * 2048); } else { \
        _Pragma("unroll") for (int n = 0; n < 2; ++n) _Pragma("unroll") for (int k = 0; k < 2; ++k) dst[n][k] = *(const PG8_LAS bf16x8*)(lds + PG8_SB(b, h) + boff + n * 2048 + k * 1024); } } while (0)
#define PG8_MMA(ai, bj, At, Bt) do { __builtin_amdgcn_s_setprio(1); if constexpr (F8) { _Pragma("unroll") for (int m = 0; m < 4; ++m) _Pragma("unroll") for (int n = 0; n < 2; ++n) \
        acc[ai][bj][m][n] = __builtin_amdgcn_mfma_scale_f32_16x16x128_f8f6f4(Bt##8[n], At##8[m], acc[ai][bj][m][n], 0, 0, 0, sc_ab, 1, sc_ab); } else { \
        _Pragma("unroll") for (int m = 0; m < 4; ++m) _Pragma("unroll") for (int n = 0; n < 2; ++n) _Pragma("unroll") for (int k = 0; k < 2; ++k) \
        acc[ai][bj][m][n] = __builtin_amdgcn_mfma_f32_16x16x32_bf16(Bt[n][k], At[m][k], acc[ai][bj][m][n], 0, 0, 0); } __builtin_amdgcn_s_setprio(0); } while (0)
#define PG8_WAIT_V(n) asm volatile("s_waitcnt vmcnt(" #n ")" ::: "memory")
#define PG8_WAIT_L(n) asm volatile("s_waitcnt lgkmcnt(" #n ")" ::: "memory")
#define PG8_BAR __builtin_amdgcn_s_barrier()
#define PG8_SCHED __builtin_amdgcn_sched_barrier(0)
    Unit cur, nxt; int ui = 0;
    if (!S.next(0, cur)) return;
    f32x4 acc[2][2][4][2];
#pragma unroll
    for (int a = 0; a < 2; ++a)
#pragma unroll
        for (int b = 0; b < 2; ++b)
#pragma unroll
            for (int m = 0; m < 4; ++m)
#pragma unroll
                for (int n = 0; n < 2; ++n) acc[a][b][m][n] = (f32x4){0.f, 0.f, 0.f, 0.f};
    bf16x8 At[4][2], B0[2][2], B1[2][2]; v8i_t At8[4], B08[2], B18[2];
    const char* cA = cur.a; const char* cB = cur.b;
    if constexpr (SP2) {
        u32x2 p0 = (u32x2){voffA[0], voffA[1]}, p1 = p0;
        if constexpr (GATHER) { v4u_t g4; PG8_GCALC(g4, cur.pm); *(PG8_LAS v4u_t*)PG8_GSLOT(0, 0) = g4; p0 = (u32x2){g4[0], g4[1]}; p1 = (u32x2){g4[2], g4[3]}; }
        PG8_STAGE(PG8_SB(0, 0), cB, voffB); PG8_STAGE(PG8_SB(0, 1), cB + hstep, voffB); PG8_STAGE_Q(PG8_SA(0, 0), cA, p0); PG8_STAGE_Q(PG8_SA(0, 1), cA + hstepA, p1);
        if (wr == 1) PG8_BAR;
        PG8_WAIT_V(2); PG8_BAR;
        PG8_STAGE(PG8_SB(1, 0), cB + kstep, voffB); PG8_STAGE_Q(PG8_SA(1, 0), cA + kstep, p0); PG8_STAGE(PG8_SB(1, 1), cB + hstep + kstep, voffB);
        PG8_WAIT_V(6); PG8_BAR;
    } else {
        PG8_STAGE(PG8_SB(0, 0), cB, voffB); PG8_STAGE(PG8_SA(0, 0), cA, voffA); PG8_STAGE(PG8_SB(0, 1), cB + hstep, voffB); PG8_STAGE(PG8_SA(0, 1), cA + hstep, voffA);
        if (wr == 1) PG8_BAR;
        PG8_WAIT_V(4); PG8_BAR;
        PG8_STAGE(PG8_SB(1, 0), cB + kstep, voffB); PG8_STAGE(PG8_SA(1, 0), cA + kstep, voffA); PG8_STAGE(PG8_SB(1, 1), cB + hstep + kstep, voffB);
        PG8_WAIT_V(6); PG8_BAR;
    }
    for (;;) {
        const bool has_next = S.next(ui + 1, nxt);
        if constexpr (GATHER) { v4u_t g4 = *(const PG8_LAS v4u_t*)PG8_GSLOT(ui & 1, 0); if (has_next) PG8_GCALC(g4, nxt.pm); *(PG8_LAS v4u_t*)PG8_GSLOT((ui & 1) ^ 1, 0) = g4; }
        const char* nA = has_next ? nxt.a : cA; const char* nB = has_next ? nxt.b : cB;
#pragma nounroll
        for (int t = 0; t < nt; t += 2) {
            const bool last = (t == nt - 2);
            const char* a1 = cA + (size_t)(t + 1) * kstep;
            const char* a2 = last ? nA : cA + (size_t)(t + 2) * kstep; const char* b2 = last ? nB : cB + (size_t)(t + 2) * kstep;
            const char* a3 = a2 + kstep; const char* b3 = b2 + kstep;
            if constexpr (SP2) {
            PG8_GQ(q1, 1, false); PG8_LDB(B0, 0, 0); PG8_LDB(B1, 0, 1); PG8_SCHED; PG8_LDA(At, 0, 0); PG8_STAGE_Q(PG8_SA(1, 1), a1 + hstepA, q1);
            PG8_WAIT_V(8); PG8_WAIT_L(0); PG8_BAR; PG8_MMA(0, 0, At, B0); PG8_MMA(0, 1, At, B1); PG8_BAR; PG8_SCHED;
            PG8_GQ(q2, 0, last); PG8_LDA(At, 0, 1); PG8_STAGE(PG8_SB(0, 0), b2, voffB); PG8_STAGE(PG8_SB(0, 1), b2 + hstep, voffB); PG8_STAGE_Q(PG8_SA(0, 0), a2, q2);
            PG8_WAIT_V(8); PG8_WAIT_L(0); PG8_BAR; PG8_MMA(1, 0, At, B0); PG8_MMA(1, 1, At, B1); PG8_BAR; PG8_SCHED;
            PG8_GQ(q3, 1, last); PG8_LDB(B0, 1, 0); PG8_LDB(B1, 1, 1); PG8_SCHED; PG8_LDA(At, 1, 0); PG8_STAGE_Q(PG8_SA(0, 1), a2 + hstepA, q3);
            PG8_WAIT_V(8); PG8_WAIT_L(0); PG8_BAR; PG8_MMA(0, 0, At, B0); PG8_MMA(0, 1, At, B1); PG8_BAR; PG8_SCHED;
            PG8_GQ(q4, 0, last); PG8_LDA(At, 1, 1); PG8_STAGE(PG8_SB(1, 0), b3, voffB); PG8_STAGE(PG8_SB(1, 1), b3 + hstep, voffB); PG8_STAGE_Q(PG8_SA(1, 0), a3, q4);
            PG8_WAIT_V(8); PG8_WAIT_L(0); PG8_BAR; PG8_MMA(1, 0, At, B0); PG8_MMA(1, 1, At, B1); PG8_BAR; PG8_SCHED;
            } else {
            PG8_LDB(B0, 0, 0); PG8_SCHED; PG8_LDA(At, 0, 0); PG8_STAGE(PG8_SA(1, 1), a1 + hstep, voffA);
            PG8_WAIT_L(8); PG8_BAR; PG8_WAIT_L(0); PG8_MMA(0, 0, At, B0); PG8_BAR; PG8_SCHED;
            PG8_LDB(B1, 0, 1); PG8_STAGE(PG8_SB(0, 0), b2, voffB);
            PG8_BAR; PG8_WAIT_L(0); PG8_MMA(0, 1, At, B1); PG8_BAR;
            PG8_LDA(At, 0, 1); PG8_STAGE(PG8_SA(0, 0), a2, voffA);
            PG8_BAR; PG8_WAIT_L(0); PG8_MMA(1, 0, At, B0); PG8_BAR; PG8_SCHED;
            PG8_STAGE(PG8_SB(0, 1), b2 + hstep, voffB);
            PG8_WAIT_V(6); PG8_BAR; PG8_MMA(1, 1, At, B1); PG8_BAR;
            PG8_LDB(B0, 1, 0); PG8_SCHED; PG8_LDA(At, 1, 0); PG8_STAGE(PG8_SA(0, 1), a2 + hstep, voffA);
            PG8_WAIT_L(8); PG8_BAR; PG8_WAIT_L(0); PG8_MMA(0, 0, At, B0); PG8_BAR; PG8_SCHED;
            PG8_LDB(B1, 1, 1); PG8_STAGE(PG8_SB(1, 0), b3, voffB);
            PG8_BAR; PG8_WAIT_L(0); PG8_MMA(0, 1, At, B1); PG8_BAR;
            PG8_LDA(At, 1, 1); PG8_STAGE(PG8_SA(1, 0), a3, voffA);
            PG8_BAR; PG8_WAIT_L(0); PG8_MMA(1, 0, At, B0); PG8_BAR; PG8_SCHED;
            PG8_STAGE(PG8_SB(1, 1), b3 + hstep, voffB);
            PG8_WAIT_V(6); PG8_BAR; PG8_MMA(1, 1, At, B1); PG8_BAR;
            }
        }
        if constexpr (ALIGN_EPI) { if (wr == 0) PG8_BAR; }
        E(acc, cur, wr, wc, fr, fq);
        if (!has_next) break;
#pragma unroll
        for (int a = 0; a < 2; ++a)
#pragma unroll
            for (int b = 0; b < 2; ++b)
#pragma unroll
                for (int m = 0; m < 4; ++m)
#pragma unroll
                    for (int n = 0; n < 2; ++n) acc[a][b][m][n] = (f32x4){0.f, 0.f, 0.f, 0.f};
        cur = nxt; cA = nA; cB = nB; ++ui;
        if constexpr (ALIGN_EPI) { if (wr == 1) PG8_BAR; }
    }
    PG8_WAIT_V(0);
    if constexpr (!ALIGN_EPI) { if (wr == 0) PG8_BAR; }
    PG8_BAR;
#undef PG8_SA
#undef PG8_SB
#undef PG8_STAGE
#undef PG8_STAGE_Q
#undef PG8_GQ
#undef PG8_GSLOT
#undef PG8_GCALC
#undef PG8_LDA
#undef PG8_LDB
#undef PG8_MMA
#undef PG8_LD8
#undef PG8_WAIT_V
#undef PG8_WAIT_L
#undef PG8_BAR
#undef PG8_SCHED
}
}

#include <hip/hip_bf16.h>
namespace attn_body {
using bf16=__hip_bfloat16;
using bf16x8=__attribute__((ext_vector_type(8)))short;
using s16x4=__attribute__((ext_vector_type(4)))short;
using f32x16=__attribute__((ext_vector_type(16)))float;
using u32x4=__attribute__((ext_vector_type(4)))unsigned;
constexpr int BATCH=8,NHEAD=16,SEQ=2048,D=64,QP=1024,KVP=256;
constexpr int NW=8,QBLK=32,QB=QBLK*NW,KVBLK=64,NQB=SEQ/QB;
constexpr int ATTN_UNIT_ROWS=QB;
__device__ __forceinline__ int crow(int r,int hi){return (r&3)+8*(r>>2)+4*hi;}
#define SBAR() __builtin_amdgcn_sched_barrier(0)
__device__ __forceinline__ void cmask(f32x16&p0,f32x16&p1,int jb,int qrel,int hi){
  const float NEG=-INFINITY; int kb=64*jb+4*hi;
  #pragma unroll
  for(int r=0;r<16;++r){int kv=kb+(r&3)+8*(r>>2); if(kv>qrel)p0[r]=NEG; if(kv+32>qrel)p1[r]=NEG;}
}

constexpr int NSLOT=3, SLOTB=8192;
constexpr int LDS_K=0, LDS_V=NSLOT*SLOTB, LDS_WS=2*NSLOT*SLOTB, LDS_OST=LDS_WS+NW*64*4, LDS_BYTES=LDS_OST+NW*4096;
constexpr float C2=0.125f*1.4426950408889634f;
__device__ __forceinline__ void glds16(const void*gsrc,unsigned lds_dst){unsigned keep;
  asm volatile("s_mov_b32 %0, m0\n\ts_mov_b32 m0, %2\n\ts_nop 0\n\tglobal_load_lds_dwordx4 %1, off\n\ts_mov_b32 m0, %0":"=&s"(keep):"v"(gsrc),"s"(lds_dst):"memory");}
__device__ __forceinline__ float max3f(float a,float b,float c){float r;asm("v_max3_f32 %0, %1, %2, %3":"=v"(r):"v"(a),"v"(b),"v"(c));return r;}
__device__ __forceinline__ float max2f(float a,float b){float r;asm("v_max_f32_e32 %0, %1, %2":"=v"(r):"v"(a),"v"(b));return r;}
__device__ __forceinline__ float fadd_s(float a,float b){float r;asm("v_add_f32_e32 %0, %1, %2":"=v"(r):"v"(a),"v"(b));return r;}
__device__ __forceinline__ float fsub_s(float a,float b){float r;asm("v_sub_f32_e32 %0, %1, %2":"=v"(r):"v"(a),"v"(b));return r;}
typedef float f32x2_t __attribute__((ext_vector_type(2))); typedef __bf16 bf16x2_t __attribute__((ext_vector_type(2)));
__device__ __forceinline__ unsigned cvtpk_s(float lo,float hi){f32x2_t v={lo,hi};bf16x2_t b=__builtin_convertvector(v,bf16x2_t);return __builtin_bit_cast(unsigned,b);}
#define WAIT_BAR(N) asm volatile("s_waitcnt vmcnt(" #N ") lgkmcnt(0)\n\ts_barrier":::"memory")

__device__ __forceinline__ void qkt(f32x16&p0,f32x16&p1,const char*Kslot,const bf16x8*qr,const f32x16&negm,int r32,int hi){
  const char*kb=Kslot+hi*1024+r32*16;
  #pragma unroll
  for(int d0=0;d0<4;++d0){
    const bf16x8 b0=*reinterpret_cast<const bf16x8*>(kb+d0*2048);
    const bf16x8 b1=*reinterpret_cast<const bf16x8*>(kb+d0*2048+512);
    if(d0==0){p0=__builtin_amdgcn_mfma_f32_32x32x16_bf16(b0,qr[0],negm,0,0,0);p1=__builtin_amdgcn_mfma_f32_32x32x16_bf16(b1,qr[0],negm,0,0,0);}
    else{p0=__builtin_amdgcn_mfma_f32_32x32x16_bf16(b0,qr[d0],p0,0,0,0);p1=__builtin_amdgcn_mfma_f32_32x32x16_bf16(b1,qr[d0],p1,0,0,0);}}
}
typedef __attribute__((address_space(3))) const char* lds_cptr;
typedef short v4i16_t __attribute__((ext_vector_type(4)));
__device__ __forceinline__ void kload8(bf16x8*kf,lds_cptr kp){
  kf[0]=*(const __attribute__((address_space(3))) bf16x8*)(kp);      kf[1]=*(const __attribute__((address_space(3))) bf16x8*)(kp+512);
  kf[2]=*(const __attribute__((address_space(3))) bf16x8*)(kp+2048); kf[3]=*(const __attribute__((address_space(3))) bf16x8*)(kp+2560);
  kf[4]=*(const __attribute__((address_space(3))) bf16x8*)(kp+4096); kf[5]=*(const __attribute__((address_space(3))) bf16x8*)(kp+4608);
  kf[6]=*(const __attribute__((address_space(3))) bf16x8*)(kp+6144); kf[7]=*(const __attribute__((address_space(3))) bf16x8*)(kp+6656);
}
__device__ __forceinline__ void kload2(bf16x8*kf,lds_cptr kp,int j){ kf[2*j]=*(const __attribute__((address_space(3))) bf16x8*)(kp+j*2048); kf[2*j+1]=*(const __attribute__((address_space(3))) bf16x8*)(kp+j*2048+512); }
__device__ __forceinline__ s16x4 vtr(lds_cptr p){ return __builtin_bit_cast(s16x4,__builtin_amdgcn_ds_read_tr16_b64_v4i16((__attribute__((address_space(3))) v4i16_t*)p)); }
__device__ __forceinline__ float rowmax(const f32x16&p0,const f32x16&p1){
  float a=max3f(p0[0],p0[1],p1[0]),b=max3f(p0[2],p0[3],p1[1]);a=max3f(a,p1[2],p1[3]);
  #pragma unroll
  for(int r=4;r<16;r+=4){a=max3f(a,p0[r],p0[r+1]);b=max3f(b,p0[r+2],p0[r+3]);a=max3f(a,p1[r],p1[r+1]);b=max3f(b,p1[r+2],p1[r+3]);}
  const float m=max2f(a,b);
  auto rr=__builtin_amdgcn_permlane32_swap(__float_as_uint(m),__float_as_uint(m),false,false);
  return max2f(__uint_as_float(rr[0]),__uint_as_float(rr[1]));
}
__device__ __forceinline__ void pv(f32x16*o,int vb,bf16x8 pa0,bf16x8 pa1,bf16x8 pa2,bf16x8 pa3){
  #pragma unroll
  for(int d0=0;d0<2;++d0){s16x4 lo[4],hi[4];
    #pragma unroll
    for(int ks=0;ks<4;++ks){
      asm volatile("ds_read_b64_tr_b16 %0,%1 offset:%c2":"=&v"(lo[ks]):"v"(vb),"i"(d0*4096+ks*1024):"memory");
      asm volatile("ds_read_b64_tr_b16 %0,%1 offset:%c2":"=&v"(hi[ks]):"v"(vb),"i"(d0*4096+ks*1024+512):"memory");}
    asm volatile("s_waitcnt lgkmcnt(0)":::"memory");SBAR();
    #define PK(k) (bf16x8){lo[k][0],lo[k][1],lo[k][2],lo[k][3],hi[k][0],hi[k][1],hi[k][2],hi[k][3]}
    o[d0]=__builtin_amdgcn_mfma_f32_32x32x16_bf16(pa0,PK(0),o[d0],0,0,0);
    o[d0]=__builtin_amdgcn_mfma_f32_32x32x16_bf16(pa1,PK(1),o[d0],0,0,0);
    o[d0]=__builtin_amdgcn_mfma_f32_32x32x16_bf16(pa2,PK(2),o[d0],0,0,0);
    o[d0]=__builtin_amdgcn_mfma_f32_32x32x16_bf16(pa3,PK(3),o[d0],0,0,0);
    #undef PK
  }
}

#ifndef ATTN_STORE16
#define ATTN_STORE16(p,v) (*(u32x4*)(p)=(v))
#endif
template<int THRL> __device__ __forceinline__ void attn_unit(int b,int h,int kvh,int qb,const bf16*Q,const bf16*__restrict__ K,const bf16*__restrict__ V,bf16*O,char*shm,const int wid_in){
  int lane; asm volatile("v_mbcnt_lo_u32_b32 %0, -1, 0\n\tv_mbcnt_hi_u32_b32 %0, -1, %0":"=v"(lane)); const int r32=lane&31,hi=lane>>5; const int wid=wid_in;
  const long rowbase=(long)b*SEQ; const int q0=qb*QB;
  const bf16*Qw=Q+(rowbase+q0+wid*QBLK)*QP+h*D;
  const bf16*Kh=K+((long)(b*4+kvh)*(SEQ/KVBLK))*4096,*Vh=V+((long)(b*4+kvh)*(SEQ/KVBLK))*4096;
  const unsigned lds0=(unsigned)(uintptr_t)shm;
  float*wsf=(float*)(shm+LDS_WS)+wid*64;
  const bf16*ksrc=Kh+wid*512+lane*8;
  const bf16*vsrc=Vh+wid*512+lane*8;
  const unsigned kdst=lds0+LDS_K+wid*1024, vdst=lds0+LDS_V+wid*1024;
  #define DMA_K(t,slot) glds16(ksrc+(long)(t)*4096,(unsigned)__builtin_amdgcn_readfirstlane(kdst+(slot)))
  #define DMA_V(t,slot) glds16(vsrc+(long)(t)*4096,(unsigned)__builtin_amdgcn_readfirstlane(vdst+(slot)))
  const int vb0=(int)(lds0+LDS_V)+((lane>>4)&1)*32+(lane&3)*8+(4*hi+((lane&15)>>2))*64;
  const char*Kbase=shm+LDS_K; bf16x8 kf[8];
  const lds_cptr shm3=(lds_cptr)shm; const lds_cptr kp0=shm3+LDS_K+hi*1024+r32*16; const lds_cptr vp0=shm3+LDS_V+((lane>>4)&1)*32+(lane&3)*8+(4*hi+((lane&15)>>2))*64;
  constexpr int NT=SEQ/KVBLK;
  DMA_K(0,0);DMA_V(0,0);DMA_K(1,SLOTB);
  bf16x8 qr[4];
  #pragma unroll
  for(int d0=0;d0<4;++d0)qr[d0]=*reinterpret_cast<const bf16x8*>(&Qw[(long)r32*QP+d0*16+hi*8]);
  float mhat=0.f,l_reg=0.f;f32x16 o[2];o[0]=f32x16{};o[1]=f32x16{};f32x16 negm=f32x16{};asm volatile("":"+v"(negm));
  #define CMASK(P0,P1,t) do{}while(0)
  bool resc=false;
  #define START(P0,P1) do{ const float rm=rowmax(P0,P1); resc=false; \
    { const float dl=rm; mhat=fadd_s(mhat,dl); \
      _Pragma("unroll") for(int r=0;r<16;++r){P0[r]=fsub_s(P0[r],dl);P1[r]=fsub_s(P1[r],dl);} \
      _Pragma("unroll") for(int r=0;r<16;++r)negm[r]=-mhat; asm volatile("":"+v"(negm)); } \
    _Pragma("unroll") for(int r=0;r<16;++r)P0[r]=__builtin_amdgcn_exp2f(P0[r]); }while(0)
  #define RESC() do{ if(resc){ asm volatile("s_waitcnt lgkmcnt(0)":::"memory"); \
      _Pragma("unroll") for(int d_=0;d_<2;++d_) _Pragma("unroll") for(int r=0;r<16;++r)o[d_][r]*=wsf[crow(r,hi)]; } }while(0)
  f32x16 pA0,pA1,pB0,pB1;
  int sl_prev=0,sl_cur=0,sl_next=SLOTB;
  #define ROT() do{sl_prev=sl_cur;sl_cur=sl_next;sl_next=(sl_next==(NSLOT-1)*SLOTB)?0:sl_next+SLOTB;}while(0)
  DMA_K(2,2*SLOTB);
  WAIT_BAR(3);
  qkt(pA0,pA1,Kbase,qr,negm,r32,hi);asm volatile("s_nop 15\n\ts_nop 7":"+v"(pA0),"+v"(pA1));CMASK(pA0,pA1,0);
  START(pA0,pA1);
  _Pragma("unroll") for(int r=0;r<16;++r)pA1[r]=__builtin_amdgcn_exp2f(pA1[r]);
  WAIT_BAR(0);
  DMA_K(3,0);DMA_V(1,SLOTB);
  ROT();
  kload8(kf,kp0+sl_cur);
  WAIT_BAR(2);
  s16x4 vlo[8],vhi[8]; u32x4 pw0,pw1,pw2,pw3;
  #define PKW(P,B) cvtpk_s(P[B],P[B+1])
  #define PAF(k) __builtin_bit_cast(bf16x8,pw##k)
  #define VFR(i) (bf16x8){vlo[i][0],vlo[i][1],vlo[i][2],vlo[i][3],vhi[i][0],vhi[i][1],vhi[i][2],vhi[i][3]}
  #define PIN(x) asm volatile("":"+v"(x))
  #define MX3(a,b,c) __builtin_fmaxf(__builtin_fmaxf((a),(b)),(c))
  #define GAPA(MF,A0,A1,A2,A3,W0,W1,PW) do{ MF; sacc+=A0; sacc+=A1; sacc+=A2; sacc+=A3; PIN(sacc); W0; W1; PIN(PW); SBAR(); }while(0)
  #define EX(v) __builtin_amdgcn_exp2f(v)
  #define GAPB(MF,X,B) do{ MF; X[B]=EX(X[B]); X[B+1]=EX(X[B+1]); X[B+2]=EX(X[B+2]); X[B+3]=EX(X[B+3]); PIN(X); SBAR(); }while(0)
  #define VRD(i) do{ vlo[i]=vtr(vp_+(((i)>>2)*4096+((i)&3)*1024)); vhi[i]=vtr(vp_+(((i)>>2)*4096+((i)&3)*1024+512)); }while(0)
  #define KRD(G,j) do{ if(G){ kload2(kf,kp0+sl_next,j); SBAR(); } }while(0)
  #define STEP(C0,C1,P0,P1,t,GK,GV,GL) do{ SBAR(); \
    const lds_cptr vp_=vp0+sl_prev; \
    VRD(0); SBAR(); float sacc=(P0[0]+P0[1]); \
    GAPA(C0=__builtin_amdgcn_mfma_f32_32x32x16_bf16(kf[0],qr[0],negm,0,0,0), P0[2],P0[3],P0[4],P0[5],     pw0[0]=PKW(P0,0), pw0[1]=PKW(P0,2), pw0); \
    VRD(4); SBAR(); GAPA(C1=__builtin_amdgcn_mfma_f32_32x32x16_bf16(kf[1],qr[0],negm,0,0,0), P0[6],P0[7],P0[8],P0[9],     pw0[2]=PKW(P0,4), pw0[3]=PKW(P0,6), pw0); \
    VRD(1); SBAR(); GAPA(C0=__builtin_amdgcn_mfma_f32_32x32x16_bf16(kf[2],qr[1],C0,0,0,0),   P0[10],P0[11],P0[12],P0[13], pw1[0]=PKW(P0,8), pw1[1]=PKW(P0,10), pw1); \
    VRD(5); SBAR(); GAPA(C1=__builtin_amdgcn_mfma_f32_32x32x16_bf16(kf[3],qr[1],C1,0,0,0),   P0[14],P0[15],P1[0],P1[1],   pw1[2]=PKW(P0,12),pw1[3]=PKW(P0,14), pw1); \
    VRD(2); SBAR(); GAPA(C0=__builtin_amdgcn_mfma_f32_32x32x16_bf16(kf[4],qr[2],C0,0,0,0),   P1[2],P1[3],P1[4],P1[5],     pw2[0]=PKW(P1,0), pw2[1]=PKW(P1,2), pw2); \
    VRD(6); SBAR(); GAPA(C1=__builtin_amdgcn_mfma_f32_32x32x16_bf16(kf[5],qr[2],C1,0,0,0),   P1[6],P1[7],P1[8],P1[9],     pw2[2]=PKW(P1,4), pw2[3]=PKW(P1,6), pw2); \
    VRD(3); SBAR(); GAPA(C0=__builtin_amdgcn_mfma_f32_32x32x16_bf16(kf[6],qr[3],C0,0,0,0),   P1[10],P1[11],P1[12],P1[13], pw3[0]=PKW(P1,8), pw3[1]=PKW(P1,10), pw3); \
    VRD(7); SBAR(); GAPA(C1=__builtin_amdgcn_mfma_f32_32x32x16_bf16(kf[7],qr[3],C1,0,0,0),   P1[14],P1[15],0.f,0.f,       pw3[2]=PKW(P1,12),pw3[3]=PKW(P1,14), pw3); \
    l_reg+=sacc; \
    if(GK){DMA_K((t)+3,sl_cur);} if(GV){DMA_V((t)+1,sl_next);} \
    CMASK(C0,C1,t); \
    { float a=MX3(C0[0],C0[1],C1[0]),b=MX3(C0[2],C0[3],C1[1]); a=MX3(a,C1[2],C1[3]); \
      _Pragma("unroll") for(int r=4;r<16;r+=4){a=MX3(a,C0[r],C0[r+1]);b=MX3(b,C0[r+2],C0[r+3]);a=MX3(a,C1[r],C1[r+1]);b=MX3(b,C1[r+2],C1[r+3]);} \
      float rm=__builtin_fmaxf(a,b); { auto rr=__builtin_amdgcn_permlane32_swap(__float_as_uint(rm),__float_as_uint(rm),false,false); rm=__builtin_fmaxf(__uint_as_float(rr[0]),__uint_as_float(rr[1])); } \
      resc=false; \
      if(__builtin_expect(__any(rm>(float)THRL),0)){ const float dl=__builtin_fmaxf(rm,0.f); mhat+=dl; \
        _Pragma("unroll") for(int r=0;r<16;++r){C0[r]-=dl;C1[r]-=dl;} \
        _Pragma("unroll") for(int r=0;r<16;++r)negm[r]=-mhat; asm volatile("":"+v"(negm)); \
        const float f=__builtin_amdgcn_exp2f(-dl); l_reg*=f; if(hi==0)wsf[r32]=f; resc=true; } } \
    SBAR(); \
    GAPB(o[0]=__builtin_amdgcn_mfma_f32_32x32x16_bf16(PAF(0),VFR(0),o[0],0,0,0), C0,0); \
    GAPB(o[1]=__builtin_amdgcn_mfma_f32_32x32x16_bf16(PAF(0),VFR(4),o[1],0,0,0), C0,4); \
    KRD(GL,0); GAPB(o[0]=__builtin_amdgcn_mfma_f32_32x32x16_bf16(PAF(1),VFR(1),o[0],0,0,0), C0,8); \
    KRD(GL,1); GAPB(o[1]=__builtin_amdgcn_mfma_f32_32x32x16_bf16(PAF(1),VFR(5),o[1],0,0,0), C0,12); \
    KRD(GL,2); GAPB(o[0]=__builtin_amdgcn_mfma_f32_32x32x16_bf16(PAF(2),VFR(2),o[0],0,0,0), C1,0); \
    KRD(GL,3); GAPB(o[1]=__builtin_amdgcn_mfma_f32_32x32x16_bf16(PAF(2),VFR(6),o[1],0,0,0), C1,4); \
    GAPB(o[0]=__builtin_amdgcn_mfma_f32_32x32x16_bf16(PAF(3),VFR(3),o[0],0,0,0), C1,8); \
    GAPB(o[1]=__builtin_amdgcn_mfma_f32_32x32x16_bf16(PAF(3),VFR(7),o[1],0,0,0), C1,12); \
    }while(0)
  int t=1;
  #undef CMASK
  #define CMASK(P0,P1,t) do{}while(0)
  for(;t+5<NT;t+=2){
    STEP(pB0,pB1,pA0,pA1,t,true,true,true);     WAIT_BAR(2); RESC(); ROT();
    STEP(pA0,pA1,pB0,pB1,t+1,true,true,true);   WAIT_BAR(2); RESC(); ROT();
  }
  #undef CMASK
  #define CMASK(P0,P1,t) do{}while(0)
  #define ENDW(tt) do{ if((tt)+3<NT){WAIT_BAR(2);} else if((tt)+2<NT){WAIT_BAR(1);} else {WAIT_BAR(0);} }while(0)
  for(;t+1<NT;t+=2){
    STEP(pB0,pB1,pA0,pA1,t,(t+3<NT),(t+1<NT),(t+1<NT));       ENDW(t);   RESC(); ROT();
    STEP(pA0,pA1,pB0,pB1,t+1,(t+4<NT),(t+2<NT),(t+2<NT));     ENDW(t+1); RESC(); ROT();
  }
  STEP(pB0,pB1,pA0,pA1,NT-1,false,false,false); RESC();
  { float sacc=pB0[0]+pB0[1]; _Pragma("unroll") for(int r=2;r<16;++r)sacc+=pB0[r]; _Pragma("unroll") for(int r=0;r<16;++r)sacc+=pB1[r]; l_reg+=sacc;
    pw0=(u32x4){PKW(pB0,0),PKW(pB0,2),PKW(pB0,4),PKW(pB0,6)};pw1=(u32x4){PKW(pB0,8),PKW(pB0,10),PKW(pB0,12),PKW(pB0,14)};pw2=(u32x4){PKW(pB1,0),PKW(pB1,2),PKW(pB1,4),PKW(pB1,6)};pw3=(u32x4){PKW(pB1,8),PKW(pB1,10),PKW(pB1,12),PKW(pB1,14)};
    SBAR(); pv(o,vb0+sl_cur,PAF(0),PAF(1),PAF(2),PAF(3)); }
  #undef PKW
  #undef PAF
  #undef VFR
  #undef PIN
  #undef MX3
  #undef GAPA
  #undef GAPB
  #undef EX
  #undef VRD
  #undef KRD
  #undef STEP
  #undef ENDW
  {auto rr=__builtin_amdgcn_permlane32_swap(__float_as_uint(l_reg),__float_as_uint(l_reg),false,false);l_reg=__uint_as_float(rr[0])+__uint_as_float(rr[1]);}
  if(hi==0)wsf[32+r32]=l_reg;asm volatile("s_waitcnt lgkmcnt(0)":::"memory");
  float rli[16];
  #pragma unroll
  for(int r=0;r<16;++r)rli[r]=__builtin_amdgcn_rcpf(wsf[32+crow(r,hi)]);
  bf16*Ow=O+(rowbase+q0+wid*QBLK)*QP+h*D;
  { bf16*stg=(bf16*)(shm+LDS_OST)+wid*2048;
    #pragma unroll
    for(int r=0;r<16;++r){const int orow=crow(r,hi);
      #pragma unroll
      for(int d0=0;d0<2;++d0)stg[orow*64+d0*32+r32]=__float2bfloat16(o[d0][r]*rli[r]);}
    asm volatile("s_waitcnt lgkmcnt(0)":::"memory");
    #pragma unroll
    for(int i=0;i<4;++i){const int row=i*8+(lane>>3),ch=lane&7; const u32x4 v=*(const u32x4*)(stg+row*64+ch*8); ATTN_STORE16(Ow+(long)row*QP+ch*8,v);} }
  asm volatile("s_waitcnt lgkmcnt(0)\n\ts_barrier":::"memory");
  #undef DMA_K
  #undef DMA_V
  #undef CMASK
  #undef START
  #undef RESC
  #undef ROT
}
constexpr int ATTN_LDS_BYTES=LDS_BYTES;

#undef SBAR
#undef WAIT_BAR
}
constexpr int T = 16384, D = 1024, SEQ = 2048, NBATCH = 8, NEXP = 32;
constexpr float C2F = 0.125f * 1.4426950408889634f;
constexpr float LN2F = 0.6931471805599453f;
constexpr float NORM_EPS = 1e-6f;
constexpr size_t MiB = 1u << 20;
constexpr size_t WS_CTL = 0, CTL_ZERO_BYTES = 1 * MiB;
constexpr size_t WS_MOD = 1 * MiB;
constexpr size_t WS_ROPEA = 2 * MiB;
constexpr size_t WS_ROPEB = 3 * MiB;
constexpr size_t WS_WRT = 3 * MiB + 65536;
constexpr size_t WS_HIST = 4 * MiB;
constexpr size_t WS_TOT = 4 * MiB + 65536;
constexpr size_t WS_GSORT = 5 * MiB;
constexpr size_t WS_POSOF = 5 * MiB + 524288;
constexpr size_t WS_LSE = 6 * MiB;
constexpr size_t WS_WINA_QK = 16 * MiB, WS_WINA_V = 28 * MiB, WS_WOUTA = 34 * MiB, WS_WINB = 36 * MiB, WS_WOUTB = 39 * MiB;
constexpr size_t WS_WUP = 48 * MiB, WS_WDOWN = 304 * MiB;
constexpr size_t WS_XA = 432 * MiB;
constexpr size_t WS_H0 = 496 * MiB, WS_H1 = 528 * MiB, WS_H2 = 560 * MiB;
constexpr size_t WS_QA = 592 * MiB, WS_KA = 688 * MiB, WS_VTA = 784 * MiB;
constexpr size_t WS_OG = 880 * MiB;
constexpr size_t WS_O = 976 * MiB, WS_Y = 1008 * MiB;
constexpr size_t WS_XS = 592 * MiB, WS_ACT = 736 * MiB, WS_OUTS = 880 * MiB;
constexpr size_t WS_QB = 880 * MiB, WS_KB = 912 * MiB, WS_VB = 920 * MiB;
constexpr size_t WS_END = 1040 * MiB;
static_assert(WS_H2 - WS_H1 == WS_H1 - WS_H0, "H0/H1/H2 equally spaced");
constexpr int MAXROWS = 73728, MAXTILES = 288;
constexpr size_t TSTEP = (size_t)256 * 1024 * 2;
constexpr size_t TSTEP8 = (size_t)256 * 1024;
constexpr float W8_SCALE = 32.0f;
constexpr int CW_TMO = 0, CW_CODE = 1, CW_BAR = 4096, CW_CMP = 200000;
constexpr int RING_BYTES = 131072;
constexpr int TBL_OFF = 135168;
constexpr int RT_PITCH = 2064, RT_LO = 32 * RT_PITCH, T_LG = 139264;
constexpr int T_SEL = TBL_OFF, T_GTE = TBL_OFF + 1024, T_RNK = TBL_OFF + 2048, T_TOT = TBL_OFF + 3072, T_BEF = T_TOT + 128, T_PBASE = T_BEF + 128, T_MYOFF = T_PBASE + 128, T_TEXP = T_MYOFF + 128, T_MT = T_TEXP + 512;
constexpr int LDSCTL_OFF = 143360, MISC_OFF = LDSCTL_OFF + 320;
constexpr int LDS_BYTES = 163840;
constexpr int T_LG2 = 147456;
constexpr int NWAVES = 8;

typedef unsigned u32x2v __attribute__((ext_vector_type(2)));
typedef float f32x2v __attribute__((ext_vector_type(2)));
typedef float f32x16 __attribute__((ext_vector_type(16)));
typedef float f32x2t __attribute__((ext_vector_type(2)));
typedef __bf16 bf16x2t __attribute__((ext_vector_type(2)));
__device__ __forceinline__ unsigned pkbf(float lo, float hi) { f32x2t v = {lo, hi}; bf16x2t b = __builtin_convertvector(v, bf16x2t); return __builtin_bit_cast(unsigned, b); }
constexpr float OUTS_SCALE = 8.0f;
__device__ __forceinline__ unsigned pk4_fp8(float a, float b, float c, float d) { unsigned w = 0; w = __builtin_amdgcn_cvt_pk_fp8_f32(a, b, w, false); w = __builtin_amdgcn_cvt_pk_fp8_f32(c, d, w, true); return w; }
__device__ __forceinline__ float bflo(unsigned u) { return __builtin_bit_cast(float, u << 16); }
__device__ __forceinline__ float bfhi(unsigned u) { return __builtin_bit_cast(float, u & 0xffff0000u); }
__device__ __forceinline__ v4u pack8(f32x4 a, f32x4 b) { v4u w; w.x = pkbf(a[0], a[1]); w.y = pkbf(a[2], a[3]); w.z = pkbf(b[0], b[1]); w.w = pkbf(b[2], b[3]); return w; }
__device__ __forceinline__ float wave_sum(float v) {
#pragma unroll
    for (int o = 1; o < 64; o <<= 1) v += __shfl_xor(v, o);
    return v;
}
__device__ __forceinline__ float hsum4(f32x4 v) { return (v[0] + v[1]) + (v[2] + v[3]); }
__device__ __forceinline__ float dot4(f32x4 a, f32x4 b) { return (a[0] * b[0] + a[1] * b[1]) + (a[2] * b[2] + a[3] * b[3]); }
__device__ __forceinline__ int perm_row(int t, int sh) { const int s = t & 2047; return (t & ~2047) + ((s & ((1 << sh) - 1)) << (11 - sh)) + (s >> sh); }
__device__ __forceinline__ int unperm_row(int p, int sh) { const int pp = p & 2047, Lsh = 11 - sh; return (p & ~2047) + ((pp & ((1 << Lsh) - 1)) << sh) + (pp >> Lsh); }

__host__ __device__ __forceinline__ int swap23(int r) { return (r & 0x13) | ((r & 4) << 1) | ((r & 8) >> 1); }
__host__ __device__ __forceinline__ size_t qk_chunk(int g, int h, int blk) { return ((size_t)(g * 16 + h) * 512 + blk) * 2048; }
struct Args { const float* in[20]; float* out; unsigned char* ws; int ph_lo, ph_hi, li, pad; };
__device__ __forceinline__ int lane_id() { int l; asm volatile("v_mbcnt_lo_u32_b32 %0, -1, 0\n\tv_mbcnt_hi_u32_b32 %0, -1, %0" : "=v"(l)); return l; }
__device__ __forceinline__ unsigned char* opaque_ptr(unsigned char* p) { asm volatile("" : "+s"(p)); return p; }
#ifndef PSEC
#define PSEC 0
#endif
#define SEC_BEGIN(id) unsigned long long tsec_##id = 0; if ((id) == PSEC) tsec_##id = __builtin_amdgcn_s_memrealtime()
#define SEC_END(id) do { if ((id) == PSEC && F.wave == 0 && lane_id() == 0) F.MISC[16] += (unsigned)(__builtin_amdgcn_s_memrealtime() - tsec_##id); } while (0)
struct Frame {
    LAS unsigned char* lds;
    volatile LAS unsigned* MISC;
    gu32* ctl;
    int wave, G, vcu;
    float* out; unsigned char* ws;
};
enum { IN_X = 0, IN_C, IN_WMOD, IN_BMOD, IN_GPREMIX, IN_GPOSTMIX, IN_GPREFFN, IN_GPOSTFFN, IN_WINA, IN_WOUTA, IN_WINB, IN_GQB, IN_GKB, IN_WOUTB, IN_WROUTER, IN_BROUTER, IN_WUP, IN_BUP, IN_WDOWN, IN_BDOWN };

struct RmNat { __device__ __forceinline__ int operator()(int c) const { return c; } };
struct RmInA { unsigned char* qk; unsigned char* v;
    __device__ __forceinline__ unsigned char* row(int c) const { const int g = c / 3072, rem = c - g * 3072, j = rem >> 10, cc = rem & 1023;
        if (j < 2) { const int hq4 = cc >> 8, wc = (cc >> 6) & 3, bj = (cc >> 5) & 1, t = cc & 31; return qk + (size_t)(g * 2048 + (j * 4 + hq4) * 256 + 128 * bj + 32 * wc + t) * 1024; }
        return v + (size_t)(g * 1024 + cc) * 1024; } };
__device__ __forceinline__ int rm_inb(int c) { const int pn = c >> 8, cc = c & 255, wc = cc >> 6, dm = cc & 63, bj = (dm >> 4) & 1, fq = 2 * (dm >> 5) + ((dm >> 3) & 1), n = (dm >> 2) & 1, i = dm & 3; return pn * 256 + 128 * bj + 32 * wc + 8 * fq + 4 * n + i; }
__device__ __forceinline__ int rm_lin(int c) { const int pn = c >> 8, cc = c & 255, wc = cc >> 6, bj = (cc >> 5) & 1, t = cc & 31; return pn * 256 + 128 * bj + 32 * wc + t; }
__device__ __forceinline__ int rm_dn(int c) { const int pn = c >> 8, cc = c & 255, wc = cc >> 6, fq = (cc >> 4) & 3, bj = (cc >> 3) & 1, r = cc & 7; return pn * 256 + 128 * bj + 32 * wc + 8 * fq + r; }
__device__ __forceinline__ int rm_up(int c) { const int bj = c >> 10, pn = (c & 1023) >> 7, jj = c & 127; return pn * 256 + 128 * bj + jj; }
constexpr int I_UP = 64 * 32 * 8, I_DN = 64 * 16 * 8, I_INA = 144 * 8, I_OUT = 16 * 16, I_INB = 24 * 16;
constexpr int NITEMS = I_UP + I_DN + I_INA + 2 * I_OUT + I_INB;
struct CvtItem { const float* src; int ldw; int kind, le, k0, n0; };
__device__ __forceinline__ CvtItem cvt_decode(const Args& args, int it) {
    CvtItem c; int r = it;
    if (r < I_UP) { c.kind = 0; c.le = r >> 8; const int q = r & 255; c.k0 = (q >> 5) * 128; c.n0 = (q & 31) * 64; c.ldw = 2048; c.src = args.in[IN_WUP] + (size_t)c.le * 1024 * 2048; }
    else if ((r -= I_UP) < I_DN) { c.kind = 1; c.le = r >> 7; const int q = r & 127; c.k0 = (q >> 4) * 128; c.n0 = (q & 15) * 64; c.ldw = 1024; c.src = args.in[IN_WDOWN] + (size_t)c.le * 1024 * 1024; }
    else if ((r -= I_DN) < I_INA) { c.kind = 2; c.le = 0; c.k0 = (r / 144) * 128; c.n0 = (r % 144) * 64; c.ldw = 9216; c.src = args.in[IN_WINA]; }
    else if ((r -= I_INA) < I_OUT) { c.kind = 3; c.le = 0; c.k0 = (r >> 4) * 64; c.n0 = (r & 15) * 64; c.ldw = 1024; c.src = args.in[IN_WOUTA]; }
    else if ((r -= I_OUT) < I_OUT) { c.kind = 4; c.le = 0; c.k0 = (r >> 4) * 64; c.n0 = (r & 15) * 64; c.ldw = 1024; c.src = args.in[IN_WOUTB]; }
    else { r -= I_OUT; c.kind = 5; c.le = 0; c.k0 = (r / 24) * 64; c.n0 = (r % 24) * 64; c.ldw = 1536; c.src = args.in[IN_WINB]; }
    return c;
}
__device__ __forceinline__ void cvt_load(const CvtItem& c, int half, f32x4 (&v)[16], int lane) {
    const float* p = c.src + (size_t)(c.k0 + 64 * half + 4 * (lane >> 4)) * c.ldw + c.n0 + 4 * (lane & 15);
#pragma unroll
    for (int i = 0; i < 16; ++i) v[i] = __builtin_nontemporal_load((const GAS f32x4*)(p + (size_t)(16 * (i >> 2) + (i & 3)) * c.ldw));
}
__device__ __forceinline__ unsigned char* cvt_row(const CvtItem& c, unsigned char* ws, int cidx) {
    switch (c.kind) {
    case 0: return ws + WS_WUP + ((size_t)c.le * 2048 + rm_up(cidx)) * 1024;
    case 1: return ws + WS_WDOWN + ((size_t)c.le * 1024 + rm_dn(cidx)) * 1024;
    case 2: { const RmInA rm{ws + WS_WINA_QK, ws + WS_WINA_V}; return rm.row(cidx); }
    case 3: return ws + WS_WOUTA + (size_t)rm_lin(cidx) * 2048;
    case 4: return ws + WS_WOUTB + (size_t)rm_lin(cidx) * 2048;
    default: return ws + WS_WINB + (size_t)rm_inb(cidx) * 2048;
    }
}
__device__ __forceinline__ void cvt_pack8(const f32x4 (&v)[16], int half, LAS unsigned* scr, int lane) {
    const int lr = lane >> 4, lc = 4 * (lane & 15);
#pragma unroll
    for (int j = 0; j < 4; ++j)
#pragma unroll
        for (int q = 0; q < 4; ++q) scr[(lc + q) * 33 + 16 * half + 4 * j + lr] = pk4_fp8(v[4 * j][q] * W8_SCALE, v[4 * j + 1][q] * W8_SCALE, v[4 * j + 2][q] * W8_SCALE, v[4 * j + 3][q] * W8_SCALE);
}
__device__ __forceinline__ void cvt_store8(const CvtItem& c, unsigned char* ws, LAS unsigned* scr, int lane) {
    LDS_WAIT(); asm volatile("" ::: "memory");
    const int cq = lane & 7;
#pragma unroll
    for (int s = 0; s < 8; ++s) { const int nl = 8 * s + (lane >> 3); const LAS unsigned* q = scr + nl * 33 + 4 * cq;
        v4u o; o.x = q[0]; o.y = q[1]; o.z = q[2]; o.w = q[3];
        *(GAS v4u*)(cvt_row(c, ws, c.n0 + nl) + c.k0 + 16 * cq) = o; }
    LDS_WAIT(); asm volatile("" ::: "memory");
}
__device__ __forceinline__ void cvt_finish16(const CvtItem& c, const f32x4 (&v)[16], unsigned char* ws, LAS float* scr, int lane) {
    const int lr = lane >> 4, lc = 4 * (lane & 15);
#pragma unroll
    for (int i = 0; i < 16; ++i) { LAS float* p = scr + (16 * (i >> 2) + 4 * lr + (i & 3)) * 65 + lc; p[0] = v[i][0]; p[1] = v[i][1]; p[2] = v[i][2]; p[3] = v[i][3]; }
    LDS_WAIT(); asm volatile("" ::: "memory");
    const int cq = lane & 7;
#pragma unroll
    for (int s = 0; s < 8; ++s) { const int nl = 8 * s + (lane >> 3); const LAS float* q = scr + (8 * cq) * 65 + nl;
        v4u o; o.x = pkbf(q[0], q[65]); o.y = pkbf(q[2 * 65], q[3 * 65]); o.z = pkbf(q[4 * 65], q[5 * 65]); o.w = pkbf(q[6 * 65], q[7 * 65]);
        *(GAS v4u*)(cvt_row(c, ws, c.n0 + nl) + (size_t)(c.k0 + 8 * cq) * 2) = o; }
    LDS_WAIT(); asm volatile("" ::: "memory");
}
constexpr int N_DEFER = 8192 + 4096, NP0 = NITEMS - N_DEFER;
template <int MODE> __device__ __forceinline__ int cvt_map(int idx) {
    if (MODE == 0) return idx < 8192 ? idx : (idx < 12288 ? I_UP + (idx - 8192) : I_UP + I_DN + (idx - 12288));
    return idx < 8192 ? 8192 + idx : I_UP + 4096 + (idx - 8192);
}
template <int MODE> __device__ __forceinline__ void cvt_stream(Frame& F, const Args& args, int it, const int stride, const int end) {
    unsigned char* ws = opaque_ptr(F.ws);
    LAS float* scr = (LAS float*)(F.lds + F.wave * 16640);
    const int lane = lane_id();
    f32x4 va[16], vb[16];
    if (it >= end) return;
    CvtItem ca = cvt_decode(args, cvt_map<MODE>(it)); int ha = 0;
    cvt_load(ca, ha, va, lane);
    for (;;) {
        CvtItem cb = ca; int hb = ha + 1; bool haveb = true;
        if (!(ca.kind < 3 && ha == 0)) { it += stride; hb = 0; haveb = it < end; if (haveb) cb = cvt_decode(args, cvt_map<MODE>(it)); }
        if (haveb) cvt_load(cb, hb, vb, lane);
        if (ca.kind < 3) { cvt_pack8(va, ha, (LAS unsigned*)scr, lane); if (ha == 1) cvt_store8(ca, ws, (LAS unsigned*)scr, lane); } else cvt_finish16(ca, va, ws, scr, lane);
        if (!haveb) break;
        CvtItem cc = cb; int hc = hb + 1; bool havec = true;
        if (!(cb.kind < 3 && hb == 0)) { it += stride; hc = 0; havec = it < end; if (havec) cc = cvt_decode(args, cvt_map<MODE>(it)); }
        if (havec) cvt_load(cc, hc, va, lane);
        if (cb.kind < 3) { cvt_pack8(vb, hb, (LAS unsigned*)scr, lane); if (hb == 1) cvt_store8(cb, ws, (LAS unsigned*)scr, lane); } else cvt_finish16(cb, vb, ws, scr, lane);
        if (!havec) break;
        ca = cc; ha = hc;
    }
}
#ifndef Q_UP
#define Q_UP 20
#endif
#ifndef Q_DN
#define Q_DN 15
#endif
#ifndef Q_INB
#define Q_INB 8
#endif
__device__ __forceinline__ int pocket_end(const Frame& F, int cur, int Gp, int quota) { const int e = cur + (F.G - Gp) * NWAVES * quota; return e > N_DEFER ? N_DEFER : e; }
__device__ __forceinline__ void pocket_convert(Frame& F, const Args& args, int cur, int Gp, int quota) {
    cvt_stream<1>(F, args, cur + ((int)blockIdx.x - Gp) * NWAVES + F.wave, (F.G - Gp) * NWAVES, pocket_end(F, cur, Gp, quota));
}
__device__ __forceinline__ void p0_prologue(Frame& F, const Args& args) {
    unsigned char* const wsl = opaque_ptr(F.ws);
    unsigned char* ws = wsl;
    const int gtid = blockIdx.x * 512 + (F.wave * 64 + lane_id());
    if (gtid < 65536) { const int l = gtid >> 15, e = (gtid >> 10) & 31, k = gtid & 1023; const float wv = args.in[IN_WROUTER][((size_t)l * 1024 + k) * 32 + e];
        const unsigned hb = pkbf(wv, 0.f) & 0xffffu; const float hf_ = __builtin_bit_cast(float, hb << 16); const unsigned lb = pkbf(wv - hf_, 0.f) & 0xffffu;
        ((bf16*)(ws + WS_WRT))[gtid] = (bf16)hb; ((bf16*)(ws + WS_WRT + 131072))[gtid] = (bf16)lb; }
    if (blockIdx.x < 192) {
        const int is = blockIdx.x / 48, n0 = (blockIdx.x % 48) * 64;
        LAS float* sil = (LAS float*)F.lds;
        LAS float* red = (LAS float*)(F.lds + 32768);
        const int w = F.wave, lane = lane_id();
#pragma unroll
        for (int b = 0; b < 8; ++b)
#pragma unroll
            for (int q = 0; q < 2; ++q) { const int kk = lane * 2 + q; const float cv = args.in[IN_C][b * 1024 + 128 * w + kk]; sil[(w * 8 + b) * 128 + kk] = cv / (1.f + expf(-cv)); }
        LDS_WAIT(); asm volatile("" ::: "memory");
        const float* wm = args.in[IN_WMOD] + (size_t)is * 1024 * 3072 + (size_t)(128 * w) * 3072 + n0 + lane;
        float acc[8] = {0.f, 0.f, 0.f, 0.f, 0.f, 0.f, 0.f, 0.f};
#pragma unroll 8
        for (int kk = 0; kk < 128; ++kk) { const float wv = wm[(size_t)kk * 3072];
#pragma unroll
            for (int b = 0; b < 8; ++b) acc[b] += sil[(w * 8 + b) * 128 + kk] * wv; }
#pragma unroll
        for (int b = 0; b < 8; ++b) red[(w * 8 + b) * 64 + lane] = acc[b];
        __syncthreads();
        { const int b = (F.wave * 64 + lane_id()) >> 6, col = (F.wave * 64 + lane_id()) & 63; float s = 0.f;
#pragma unroll
          for (int ww = 0; ww < 8; ++ww) s += red[(ww * 8 + b) * 64 + col];
          ((float*)(ws + WS_MOD))[(size_t)(is * 8 + b) * 3072 + n0 + col] = s + args.in[IN_BMOD][is * 3072 + n0 + col]; }
        __syncthreads();
    }
    cvt_stream<0>(F, args, blockIdx.x * NWAVES + F.wave, F.G * NWAVES, NP0);
}

__device__ __forceinline__ void p1_prenorm0(Frame& F, const Args& args) {
    unsigned char* const wsl = opaque_ptr(F.ws);
    const int lane = lane_id(); const int gw = blockIdx.x * NWAVES + F.wave, NGW = F.G * NWAVES;
    unsigned char* H0 = wsl + WS_H0; unsigned char* H1 = wsl + WS_H1; unsigned char* H2 = wsl + WS_H2;
    for (int t0 = gw * 8; t0 < T; t0 += NGW * 8) {
        const int b = t0 >> 11;
        const float* m0 = (const float*)(wsl + WS_MOD) + (size_t)(0 * 8 + b) * 3072;
        f32x4 gs[4], sh[4];
#pragma unroll
        for (int j = 0; j < 4; ++j) { const int c = 16 * lane + 4 * j; const f32x4 g = *(const f32x4*)(args.in[IN_GPREMIX] + c), sc = *(const f32x4*)(m0 + 1024 + c); gs[j] = g * (sc + 1.0f); sh[j] = *(const f32x4*)(m0 + c); }
        for (int i0 = 0; i0 < 8; i0 += 4) {
            f32x4 v[4][4];
#pragma unroll
            for (int u = 0; u < 4; ++u)
#pragma unroll
                for (int j = 0; j < 4; ++j) v[u][j] = *(const GAS f32x4*)(args.in[IN_X] + (size_t)(t0 + i0 + u) * D + 16 * lane + 4 * j);
#pragma unroll
            for (int u = 0; u < 4; ++u) { const int t = t0 + i0 + u; float ss = 0.f;
#pragma unroll
                for (int j = 0; j < 4; ++j) ss += dot4(v[u][j], v[u][j]);
                const float rstd = rsqrtf(wave_sum(ss) * (1.f / D) + NORM_EPS);
                v4u w;
#pragma unroll
                for (int j = 0; j < 4; ++j) { const f32x4 h = v[u][j] * rstd * gs[j] + sh[j]; w[j] = pk4_fp8(h[0], h[1], h[2], h[3]); }
                *(GAS v4u*)(H0 + (size_t)t * 1024 + 16 * lane) = w; *(GAS v4u*)(H1 + (size_t)perm_row(t, 2) * 1024 + 16 * lane) = w; *(GAS v4u*)(H2 + (size_t)perm_row(t, 4) * 1024 + 16 * lane) = w; }
        }
    }
}

__device__ __forceinline__ int rfl(int v) { return __builtin_amdgcn_readfirstlane(v); }
__device__ __forceinline__ const char* uptr(const char* p) { const unsigned long long v = (unsigned long long)p; const unsigned lo = __builtin_amdgcn_readfirstlane((unsigned)v), hi = __builtin_amdgcn_readfirstlane((unsigned)(v >> 32)); return (const char*)(((unsigned long long)hi << 32) | lo); }
__device__ __forceinline__ void store_rows128(unsigned char* seg0  , size_t pitch, int fr, int off0  , int off1  , v4u p0, v4u p1) {
    const bool odd = fr & 1; const v4u snd = odd ? p0 : p1; v4u rcv;
#pragma unroll
    for (int e = 0; e < 4; ++e) rcv[e] = (unsigned)__builtin_amdgcn_update_dpp(0, (int)snd[e], 0xB1  , 0xF, 0xF, false);
    const v4u a = odd ? rcv : p0, b = odd ? p1 : rcv;
    const int off = odd ? off1 : off0;
    *(GAS v4u*)(seg0 + (size_t)(odd ? fr - 1 : fr) * pitch + off) = a; *(GAS v4u*)(seg0 + (size_t)(odd ? fr : fr + 1) * pitch + off) = b;
}
typedef pg8::f32x4 (&AccRef)[2][2][4][2];
struct SchedPlain {
    pg8::GridOrder go; const char* A; const char* B;
    __device__ __forceinline__ bool next(int i, pg8::Unit& u) const { int pm, pn; if (!go.tile(i, pm, pn)) return false; pm = rfl(pm); pn = rfl(pn); u.a = uptr(A + (size_t)pm * TSTEP); u.b = uptr(B + (size_t)pn * TSTEP); u.pm = pm; u.pn = pn; u.aux = 0; return true; }
};
struct EpiPlain {
    static constexpr bool PERM = true;
    bf16* O; size_t ldc;
    __device__ __forceinline__ void operator()(const pg8::f32x4 (&acc)[2][2][4][2], const pg8::Unit& u, int wr, int wc, int fr_in, int fq_in) const {
        const int ln_ = lane_id(), fr = ln_ & 15, fq = ln_ >> 4; (void)fr_in; (void)fq_in;
#pragma unroll
        for (int ai = 0; ai < 2; ++ai)
#pragma unroll
            for (int m = 0; m < 4; ++m) store_rows128((unsigned char*)(O + (size_t)(u.pm * 256 + ai * 128 + wr * 64 + m * 16) * ldc + u.pn * 256 + wc * 64), ldc * 2, fr, 16 * fq, 64 + 16 * fq,
                                                      pack8(acc[ai][0][m][0], acc[ai][0][m][1]), pack8(acc[ai][1][m][0], acc[ai][1][m][1]));
    }
};
struct SchedInaQK {
    pg8::GridOrder go; const char* h0; const char* w;
    __device__ __forceinline__ bool next(int i, pg8::Unit& u) const { int pm, pv; if (!go.tile(i, pm, pv)) return false; pm = rfl(pm); pv = rfl(pv); const int g = pv >> 3, pn = pv & 7;
        const char* hg = h0 + (size_t)g * (WS_H1 - WS_H0); u.a = uptr(hg + (size_t)pm * TSTEP8); u.b = uptr(w + (size_t)(g * 2048 + pn * 256) * 1024); u.pm = pm; u.pn = pn; u.aux = g; return true; }
};
struct EpiRopeA {
    static constexpr bool PERM = true;
    bf16* QA; bf16* KA;
    __device__ __forceinline__ void operator()(const pg8::f32x4 (&acc)[2][2][4][2], const pg8::Unit& u, int wr, int wc, int fr_in, int fq_in) const {
        const int ln_ = lane_id(), fr = ln_ & 15, fq = ln_ >> 4; (void)fr_in; (void)fq_in;
        const int g = u.aux, j = u.pn >> 2, head = (u.pn & 3) * 4 + wc, sh = g == 0 ? 0 : (g == 1 ? 2 : 4);
        bf16* dst = (j == 0 ? QA : KA);
        const float sc = j == 0 ? C2F : 1.0f;
        float invr[2][4];
#pragma unroll
        for (int n = 0; n < 2; ++n)
#pragma unroll
            for (int i = 0; i < 4; ++i) invr[n][i] = __builtin_amdgcn_exp2f((float)(8 * fq + 4 * n + i) * (-13.287712379549449f / 32.0f)) * 0.15915494309189535f;
#pragma unroll
        for (int ai = 0; ai < 2; ++ai)
#pragma unroll
            for (int m = 0; m < 4; ++m) { const int p = u.pm * 256 + ai * 128 + wr * 64 + m * 16 + fr; const float pos = (float)(unperm_row(p, sh) & 2047);
                pg8::f32x4 o1[2], o2[2];
#pragma unroll
                for (int n = 0; n < 2; ++n) { pg8::f32x4 c, sn;
#pragma unroll
                    for (int i = 0; i < 4; ++i) { const float rv = __builtin_amdgcn_fractf(pos * invr[n][i]); c[i] = __builtin_amdgcn_cosf(rv); sn[i] = __builtin_amdgcn_sinf(rv); }
                    const pg8::f32x4 x1 = acc[ai][0][m][n], x2 = acc[ai][1][m][n];
                    o1[n] = (x1 * c - x2 * sn) * sc; o2[n] = (x2 * c + x1 * sn) * sc; }
                const int r = p & 31, slot = j == 0 ? r : swap23(r);
                bf16* cp2 = dst + qk_chunk(g, head, p >> 5) + (size_t)(((fq >> 1) * 2 + (fq & 1)) * 32 + slot) * 8;
                *(GAS v4u*)cp2 = pack8(o1[0], o1[1]); *(GAS v4u*)(cp2 + 2 * 2 * 32 * 8) = pack8(o2[0], o2[1]); }
    }
};
struct SchedInaV {
    pg8::GridOrder go; const char* h0; const char* w;
    __device__ __forceinline__ bool next(int i, pg8::Unit& u) const { int pv, pn; if (!go.tile(i, pv, pn)) return false; pv = rfl(pv); pn = rfl(pn); const int g = pv >> 2, pmf = pv & 3;
        const char* hg = h0 + (size_t)g * (WS_H1 - WS_H0); u.a = uptr(w + (size_t)(g * 1024 + pmf * 256) * 1024); u.b = uptr(hg + (size_t)pn * TSTEP8); u.pm = pmf; u.pn = pn; u.aux = g; return true; }
};
struct EpiVt {
    static constexpr bool PERM = true;
    bf16* VT;
    __device__ __forceinline__ void operator()(const pg8::f32x4 (&acc)[2][2][4][2], const pg8::Unit& u, int wr, int wc, int fr_in, int fq_in) const {
        const int ln_ = lane_id(), fr = ln_ & 15, fq = ln_ >> 4; (void)fr_in; (void)fq_in;
#pragma unroll
        for (int ai = 0; ai < 2; ++ai)
#pragma unroll
            for (int m = 0; m < 4; ++m) { const int f = u.pm * 256 + ai * 128 + wr * 64 + m * 16 + fr, h = f >> 6, db = (f >> 5) & 1, dd = f & 31;
                bf16* cp2 = VT + (size_t)((((fq >> 1) * 2 + db) * 2 + (fq & 1)) * 32 + dd) * 8;
#pragma unroll
                for (int bj = 0; bj < 2; ++bj) *(GAS v4u*)(cp2 + qk_chunk(u.aux, h, u.pn * 8 + bj * 4 + wc)) = pack8(acc[ai][bj][m][0], acc[ai][bj][m][1]); }
    }
};
struct EpiInB {
    static constexpr bool PERM = true;
    bf16* QB; bf16* KB; bf16* VB; const float* gq; const float* gk;
    __device__ __forceinline__ void operator()(const pg8::f32x4 (&acc)[2][2][4][2], const pg8::Unit& u, int wr, int wc, int fr_in, int fq_in) const {
        const int ln_ = lane_id(), fr = ln_ & 15, fq = ln_ >> 4; (void)fr_in; (void)fq_in;
        const int pn = u.pn, A = fq >> 1, f8 = 8 * (fq & 1), off0 = 64 * A + 2 * f8;
        const bool isq = pn < 4, isv = pn == 5; const float* gv = isq ? gq : gk; const float sc = isq ? C2F : 1.0f;
        bf16* dst = QB + (pn * 4 + wc) * 64; const size_t pitch = 1024;
        pg8::f32x4 gg[2][2];
#pragma unroll
        for (int bj = 0; bj < 2; ++bj)
#pragma unroll
            for (int n = 0; n < 2; ++n) gg[bj][n] = isv ? (pg8::f32x4){1.f, 1.f, 1.f, 1.f} : *(const pg8::f32x4*)(gv + 32 * A + 16 * bj + f8 + 4 * n);
        float invr[2][4];
#pragma unroll
        for (int n = 0; n < 2; ++n)
#pragma unroll
            for (int i = 0; i < 4; ++i) invr[n][i] = __builtin_amdgcn_exp2f((float)(f8 + 4 * n + i) * (-13.287712379549449f / 16.0f)) * 0.15915494309189535f;
#pragma unroll
        for (int ai = 0; ai < 2; ++ai)
#pragma unroll
            for (int m = 0; m < 4; ++m) { const int t0 = u.pm * 256 + ai * 128 + wr * 64 + m * 16, s = (t0 + fr) & 2047;
                float ss = 0.f;
#pragma unroll
                for (int bj = 0; bj < 2; ++bj)
#pragma unroll
                    for (int n = 0; n < 2; ++n) { const pg8::f32x4 x = acc[ai][bj][m][n]; ss += (x[0] * x[0] + x[1] * x[1]) + (x[2] * x[2] + x[3] * x[3]); }
                ss += __shfl_xor(ss, 16); ss += __shfl_xor(ss, 32);
                const float rstd = isv ? 1.0f : rsqrtf(ss * (1.f / 64.f) + NORM_EPS) * sc;
                const float pos = (float)(A == 0 ? (s >> 6) : (s & 63));
                pg8::f32x4 o1[2], o2[2];
#pragma unroll
                for (int n = 0; n < 2; ++n) { const pg8::f32x4 x1 = acc[ai][0][m][n] * rstd * gg[0][n], x2 = acc[ai][1][m][n] * rstd * gg[1][n];
                    if (isv) { o1[n] = x1; o2[n] = x2; }
                    else { pg8::f32x4 c, sn;
#pragma unroll
                        for (int i = 0; i < 4; ++i) { const float rv = __builtin_amdgcn_fractf(pos * invr[n][i]); c[i] = __builtin_amdgcn_cosf(rv); sn[i] = __builtin_amdgcn_sinf(rv); }
                        o1[n] = x1 * c - x2 * sn; o2[n] = x2 * c + x1 * sn; } }
                if (isq) store_rows128((unsigned char*)(dst + (size_t)t0 * pitch), pitch * 2, fr, off0, off0 + 32, pack8(o1[0], o1[1]), pack8(o2[0], o2[1]));
                else {
                    const int t = t0 + fr, bq = t >> 11, r64 = t & 63; bf16* blk = KB + (isv ? (size_t)((WS_VB - WS_KB) / 2) : (size_t)0) + ((size_t)(bq * 4 + wc) * 32 + ((t & 2047) >> 6)) * 4096;
                    if (!isv) { bf16* kp = blk + (4 * A + (fq & 1)) * 512 + r64 * 8;
                        *(GAS v4u*)kp = pack8(o1[0], o1[1]); *(GAS v4u*)(kp + 2 * 512) = pack8(o2[0], o2[1]); }
                    else { bf16* vp = blk + (A * 4 + (r64 >> 4)) * 512 + (r64 & 15) * 32 + (fq & 1) * 8;
                        *(GAS v4u*)vp = pack8(o1[0], o1[1]); *(GAS v4u*)(vp + 16) = pack8(o2[0], o2[1]); }
                } }
    }
};
struct SchedMoe {
    pg8::GridOrder go; const char* A; const char* W; size_t wstride; const LAS unsigned char* texp;
    __device__ __forceinline__ bool next(int i, pg8::Unit& u) const { int pm, pn; if (!go.tile(i, pm, pn)) return false; pm = rfl(pm); pn = rfl(pn); const int e = rfl((int)texp[pm]);
        u.a = uptr(A + (size_t)pm * TSTEP8); u.b = uptr(W + (size_t)e * wstride + (size_t)pn * TSTEP8); u.pm = pm; u.pn = pn; u.aux = e; return true; }
};
static_assert(pg8::GATHER_LDS == T_LG2 && LDS_BYTES - pg8::GATHER_LDS >= 16384, "gather offset slots");
struct SchedMoeG {
    pg8::GridOrder go; const char* A; const char* W; size_t wstride; const LAS unsigned char* texp; const int* tokof;
    __device__ __forceinline__ bool next(int i, pg8::Unit& u) const { int pm, pn; if (!go.tile(i, pm, pn)) return false; pm = rfl(pm); pn = rfl(pn); const int e = rfl((int)texp[pm]);
        u.a = uptr(A); u.b = uptr(W + (size_t)e * wstride + (size_t)pn * TSTEP8); u.pm = pm; u.pn = pn; u.aux = e; return true; }
};
struct EpiSwiglu {
    static constexpr bool PERM = true;
    unsigned char* ACT; const float* bup;
    __device__ __forceinline__ void operator()(const pg8::f32x4 (&acc)[2][2][4][2], const pg8::Unit& u, int wr, int wc, int fr_in, int fq_in) const {
        const int ln_ = lane_id(), fr = ln_ & 15, fq = ln_ >> 4; (void)fr_in; (void)fq_in;
        const int cj = u.pn * 128 + wc * 32 + 8 * fq; const float* bb = bup + (size_t)u.aux * 2048 + cj;
        pg8::f32x4 bg[2], bl[2];
#pragma unroll
        for (int n = 0; n < 2; ++n) { bg[n] = *(const pg8::f32x4*)(bb + 4 * n); bl[n] = *(const pg8::f32x4*)(bb + 1024 + 4 * n); }
#pragma unroll
        for (int ai = 0; ai < 2; ++ai)
#pragma unroll
            for (int m = 0; m < 4; ++m) { pg8::f32x4 a[2];
#pragma unroll
                for (int n = 0; n < 2; ++n) { const pg8::f32x4 gl = acc[ai][0][m][n] + bg[n], li = acc[ai][1][m][n] + bl[n];
#pragma unroll
                    for (int i = 0; i < 4; ++i) { const float gx = fminf(gl[i], 7.0f), lx = fminf(fmaxf(li[i], -7.0f), 7.0f);
                        a[n][i] = gx * __builtin_amdgcn_rcpf(1.0f + __builtin_amdgcn_exp2f(gx * (-1.702f * 1.4426950408889634f))) * (lx + 1.0f); } }
                u32x2v o8; o8.x = pk4_fp8(a[0][0], a[0][1], a[0][2], a[0][3]); o8.y = pk4_fp8(a[1][0], a[1][1], a[1][2], a[1][3]);
                *(GAS u32x2v*)(ACT + (size_t)(u.pm * 256 + ai * 128 + wr * 64 + m * 16 + fr) * 1024 + cj) = o8; }
    }
};
struct EpiDown {
    static constexpr bool PERM = true;
    unsigned char* OUTS; const float* bdn; const float* gsort;
    __device__ __forceinline__ void operator()(const pg8::f32x4 (&acc)[2][2][4][2], const pg8::Unit& u, int wr, int wc, int fr_in, int fq_in) const {
        const int ln_ = lane_id(), fr = ln_ & 15, fq = ln_ >> 4; (void)fr_in; (void)fq_in;
        const int c0 = u.pn * 256 + wc * 64 + 16 * fq; const float* bb = bdn + (size_t)u.aux * 1024 + c0;
        pg8::f32x4 bv[2][2];
#pragma unroll
        for (int bj = 0; bj < 2; ++bj)
#pragma unroll
            for (int n = 0; n < 2; ++n) bv[bj][n] = *(const pg8::f32x4*)(bb + 8 * bj + 4 * n);
#pragma unroll
        for (int ai = 0; ai < 2; ++ai)
#pragma unroll
            for (int m = 0; m < 4; ++m) { const int row0 = u.pm * 256 + ai * 128 + wr * 64 + m * 16; const float gt = gsort[row0 + fr] * OUTS_SCALE; v4u o;
#pragma unroll
                for (int bj = 0; bj < 2; ++bj)
#pragma unroll
                    for (int n = 0; n < 2; ++n) { const pg8::f32x4 v = (acc[ai][bj][m][n] + bv[bj][n]) * gt;
                        o[bj * 2 + n] = pk4_fp8(__builtin_amdgcn_fmed3f(v[0], -448.f, 448.f), __builtin_amdgcn_fmed3f(v[1], -448.f, 448.f), __builtin_amdgcn_fmed3f(v[2], -448.f, 448.f), __builtin_amdgcn_fmed3f(v[3], -448.f, 448.f)); }
                *(GAS v4u*)(OUTS + (size_t)(row0 + fr) * 1024 + c0) = o; }
    }
};

__device__ __forceinline__ unsigned p3_swz(int row, int byte) { return (unsigned)(row * 128 + ((((byte >> 4) ^ (row ^ (row >> 4))) & 7) << 4) + (byte & 15)); }
struct P3Out { f32x16 O0, O1; float lse; };
__device__ __forceinline__ P3Out p3_wave_unit(const bf16* QA, const bf16* KA, const bf16* VTA, int g, int h, int p0, int lane) {
    const int r32 = lane & 31, hi = lane >> 5;
    const int sh = g == 0 ? 0 : (g == 1 ? 2 : 4), Lsh = 11 - sh;
    const int seqbase = p0 & ~((1 << Lsh) - 1), jq = (p0 & ((1 << Lsh) - 1)) >> 5, nch = 1 << (Lsh - 5);
    const int lo8 = (hi * 32 + r32) * 8;
    const bf16* Qg = QA + qk_chunk(g, h, p0 >> 5) + lo8;
    const bf16* Kg = KA + qk_chunk(g, h, seqbase >> 5) + lo8;
    const bf16* Vg = VTA + qk_chunk(g, h, seqbase >> 5) + lo8;
    bf16x8 qf[4], kf[5][4]; int cc[5]; bool ok[5];
#pragma unroll
    for (int d0 = 0; d0 < 4; ++d0) qf[d0] = *(const GAS bf16x8*)(Qg + d0 * 512);
#pragma unroll
    for (int ci = 0; ci < 5; ++ci) { const int c = jq - 2 + ci; ok[ci] = (c >= 0) && (c < nch); cc[ci] = c < 0 ? 0 : (c >= nch ? nch - 1 : c);
        const bf16* kp = Kg + (size_t)cc[ci] * 2048;
#pragma unroll
        for (int d0 = 0; d0 < 4; ++d0) kf[ci][d0] = *(const GAS bf16x8*)(kp + d0 * 512); }
    f32x16 S[5];
#pragma unroll
    for (int ci = 0; ci < 5; ++ci) { f32x16 a = {};
#pragma unroll
        for (int d0 = 0; d0 < 4; ++d0) a = __builtin_amdgcn_mfma_f32_32x32x16_bf16(kf[ci][d0], qf[d0], a, 0, 0, 0);
        S[ci] = a; }
    bf16x8 vf[5][2][2];
#pragma unroll
    for (int ci = 0; ci < 5; ++ci)
#pragma unroll
        for (int s2 = 0; s2 < 2; ++s2) { const bf16* vp = Vg + (size_t)cc[ci] * 2048 + s2 * 1024; vf[ci][s2][0] = *(const GAS bf16x8*)vp; vf[ci][s2][1] = *(const GAS bf16x8*)(vp + 512); }
#pragma unroll
    for (int ci = 0; ci < 5; ++ci)
#pragma unroll
        for (int i = 0; i < 16; ++i) { const int kk = 16 * (i >> 3) + 8 * hi + (i & 7);
            bool keep = ok[ci]; if (ci == 0) keep = keep && (kk >= r32); if (ci == 4) keep = keep && (kk <= r32);
            S[ci][i] = keep ? S[ci][i] : -INFINITY; }
    float mx = -INFINITY;
#pragma unroll
    for (int ci = 0; ci < 5; ++ci)
#pragma unroll
        for (int i = 0; i < 16; ++i) mx = fmaxf(mx, S[ci][i]);
    mx = fmaxf(mx, __shfl_xor(mx, 32));
    float sum = 0.f;
#pragma unroll
    for (int ci = 0; ci < 5; ++ci)
#pragma unroll
        for (int i = 0; i < 16; ++i) { const float p = __builtin_amdgcn_exp2f(S[ci][i] - mx); S[ci][i] = p; sum += p; }
    sum += __shfl_xor(sum, 32);
    P3Out R; R.O0 = f32x16{}; R.O1 = f32x16{};
#pragma unroll
    for (int ci = 0; ci < 5; ++ci)
#pragma unroll
        for (int s2 = 0; s2 < 2; ++s2) { v4u pw; pw.x = pkbf(S[ci][8 * s2 + 0], S[ci][8 * s2 + 1]); pw.y = pkbf(S[ci][8 * s2 + 2], S[ci][8 * s2 + 3]); pw.z = pkbf(S[ci][8 * s2 + 4], S[ci][8 * s2 + 5]); pw.w = pkbf(S[ci][8 * s2 + 6], S[ci][8 * s2 + 7]);
            const bf16x8 pf = __builtin_bit_cast(bf16x8, pw);
            R.O0 = __builtin_amdgcn_mfma_f32_32x32x16_bf16(vf[ci][s2][0], pf, R.O0, 0, 0, 0); R.O1 = __builtin_amdgcn_mfma_f32_32x32x16_bf16(vf[ci][s2][1], pf, R.O1, 0, 0, 0); }
    const float inv = 1.0f / sum;
#pragma unroll
    for (int i = 0; i < 16; ++i) { R.O0[i] *= inv; R.O1[i] *= inv; }
    R.lse = (mx + __builtin_amdgcn_logf(sum)) * LN2F;
    return R;
}
__device__ __forceinline__ void p3_attn_a(Frame& F) {
    unsigned char* const wsl = opaque_ptr(F.ws);
    const int lane = lane_id(); const int r32 = lane & 31, hi = lane >> 5, w = F.wave;
    const bf16* QA = (const bf16*)(wsl + WS_QA); const bf16* KA = (const bf16*)(wsl + WS_KA); const bf16* VTA = (const bf16*)(wsl + WS_VTA);
    bf16* O = (bf16*)(wsl + WS_O);
    LAS unsigned char* OL = F.lds;
    LAS float* LL = (LAS float*)(F.lds + 131072);
    for (int bu = blockIdx.x; bu < 512; bu += F.G) {
        const int b = bu >> 6, h = (bu >> 2) & 15, ch = bu & 3, tok0 = b * 2048 + 512 * ch;
#pragma unroll 1
        for (int k = 0; k < 4; ++k) { const int g = 2 - (k >> 1), wu = w + 8 * (k & 1), sh = g == 1 ? 2 : 4;
            const int p0 = b * 2048 + (wu & ((1 << sh) - 1)) * (2048 >> sh) + ((512 * ch) >> sh) + 32 * (wu >> sh);
            const P3Out R = p3_wave_unit(QA, KA, VTA, g, h, p0, lane);
            const int x = unperm_row(p0 + r32, sh) - tok0;
            LAS unsigned char* og = OL + (g - 1) * 65536;
#pragma unroll
            for (int i4 = 0; i4 < 4; ++i4) { u32x2v w0, w1; w0.x = pkbf(R.O0[4 * i4], R.O0[4 * i4 + 1]); w0.y = pkbf(R.O0[4 * i4 + 2], R.O0[4 * i4 + 3]); w1.x = pkbf(R.O1[4 * i4], R.O1[4 * i4 + 1]); w1.y = pkbf(R.O1[4 * i4 + 2], R.O1[4 * i4 + 3]);
                *(LAS u32x2v*)(og + p3_swz(x, 16 * i4 + 8 * hi)) = w0; *(LAS u32x2v*)(og + p3_swz(x, 64 + 16 * i4 + 8 * hi)) = w1; }
            if (hi == 0) LL[(g - 1) * 512 + x] = R.lse;
        }
        __syncthreads();
#pragma unroll 1
        for (int k = 0; k < 2; ++k) { const int wu = w + 8 * k, p0 = tok0 + 32 * wu, x = 32 * wu + r32;
            const P3Out R = p3_wave_unit(QA, KA, VTA, 0, h, p0, lane);
            const float l0 = R.lse, l1 = LL[x], l2 = LL[512 + x], m = fmaxf(l0, fmaxf(l1, l2));
            float w0f = __expf(l0 - m), w1f = __expf(l1 - m), w2f = __expf(l2 - m); const float iw = 1.0f / (w0f + w1f + w2f); w0f *= iw; w1f *= iw; w2f *= iw;
#pragma unroll
            for (int i4 = 0; i4 < 4; ++i4)
#pragma unroll
                for (int db = 0; db < 2; ++db) { const unsigned off = p3_swz(x, 64 * db + 16 * i4 + 8 * hi);
                    const u32x2v a1 = *(const LAS u32x2v*)(OL + off), a2 = *(const LAS u32x2v*)(OL + 65536 + off);
                    const f32x16& Og = db == 0 ? R.O0 : R.O1; u32x2v o;
                    o.x = pkbf(Og[4 * i4] * w0f + bflo(a1.x) * w1f + bflo(a2.x) * w2f, Og[4 * i4 + 1] * w0f + bfhi(a1.x) * w1f + bfhi(a2.x) * w2f);
                    o.y = pkbf(Og[4 * i4 + 2] * w0f + bflo(a1.y) * w1f + bflo(a2.y) * w2f, Og[4 * i4 + 3] * w0f + bfhi(a1.y) * w1f + bfhi(a2.y) * w2f);
                    *(LAS u32x2v*)(OL + off) = o; }
            LDS_WAIT(); asm volatile("" ::: "memory");
#pragma unroll
            for (int s4 = 0; s4 < 4; ++s4) { const int q = 8 * s4 + (lane >> 3), xr = 32 * wu + q; const v4u o = *(const LAS v4u*)(OL + p3_swz(xr, 16 * (lane & 7)));
                *(GAS v4u*)(O + (size_t)(tok0 + xr) * 1024 + h * 64 + 8 * (lane & 7)) = o; }
        }
        __syncthreads();
    }
}
__device__ __forceinline__ void p6a(Frame& F, const Args& args, int layer, const float* xin) {
    unsigned char* const wsl = opaque_ptr(F.ws);
    const int lane = lane_id(); const int w = F.wave;
    const int tokb = blockIdx.x * 64, b = tokb >> 11;
    const float* MOD = (const float*)(wsl + WS_MOD);
    const float* m0 = MOD + (size_t)((layer * 2 + 0) * 8 + b) * 3072; const float* m1 = MOD + (size_t)((layer * 2 + 1) * 8 + b) * 3072;
    const bf16* Y = (const bf16*)(wsl + WS_Y); bf16* XA = (bf16*)(wsl + WS_XA); unsigned char* H2N8 = wsl + WS_H1;
    const bf16* WH = (const bf16*)(wsl + WS_WRT) + (size_t)layer * 32 * 1024; const bf16* WL = WH + 65536;
    const float* br = args.in[IN_BROUTER] + layer * 32;
    LAS int* SEL = (LAS int*)(F.lds + T_SEL); LAS float* GTE = (LAS float*)(F.lds + T_GTE); LAS int* RNK = (LAS int*)(F.lds + T_RNK); LAS float* LG = (LAS float*)(F.lds + T_LG);
    const int th = w & 1, eh = (w >> 1) & 1, kh = w >> 2, l16 = lane & 15, kg = lane >> 4;
    const LAS unsigned char* ah = F.lds + (16 * th + l16) * RT_PITCH + kg * 16 + kh * 1024; const LAS unsigned char* al = ah + RT_LO;
    bf16x8 b_h[16], b_l[16];
    { const bf16* bh = WH + (size_t)(16 * eh + l16) * 1024 + kg * 8 + kh * 512; const bf16* bl = WL + (size_t)(16 * eh + l16) * 1024 + kg * 8 + kh * 512;
#pragma unroll
      for (int ks = 0; ks < 16; ++ks) { b_h[ks] = *(const GAS bf16x8*)(bh + ks * 32); b_l[ks] = *(const GAS bf16x8*)(bl + ks * 32); } }
    for (int rnd = 0; rnd < 2; ++rnd) {
        SEC_BEGIN(1);
#pragma unroll
        for (int tt = 0; tt < 4; ++tt) { const int row = w * 4 + tt, rl = rnd * 32 + row, t = tokb + rl;
            f32x4 y[4], x[4]; float ss = 0.f;
#pragma unroll
            for (int j = 0; j < 4; ++j) { const u32x2v yy = *(const GAS u32x2v*)(Y + (size_t)t * D + 4 * lane + 256 * j); y[j] = (f32x4){bflo(yy.x), bfhi(yy.x), bflo(yy.y), bfhi(yy.y)};
                if (layer == 0) x[j] = *(const GAS f32x4*)(xin + (size_t)t * D + 4 * lane + 256 * j);
                else { const u32x2v xx = *(const GAS u32x2v*)((const bf16*)xin + (size_t)t * D + 4 * lane + 256 * j); x[j] = (f32x4){bflo(xx.x), bfhi(xx.x), bflo(xx.y), bfhi(xx.y)}; }
                ss += dot4(y[j], y[j]); }
            const float rstd1 = rsqrtf(wave_sum(ss) * (1.f / D) + NORM_EPS);
            float ss2 = 0.f;
#pragma unroll
            for (int j = 0; j < 4; ++j) { const int c = 4 * lane + 256 * j; const f32x4 A1 = *(const f32x4*)(m0 + 2048 + c) * *(const f32x4*)(args.in[IN_GPOSTMIX] + layer * 1024 + c);
                x[j] = x[j] + A1 * (y[j] * rstd1); { u32x2v px; px.x = pkbf(x[j][0], x[j][1]); px.y = pkbf(x[j][2], x[j][3]); *(GAS u32x2v*)(XA + (size_t)t * D + c) = px; } ss2 += dot4(x[j], x[j]); }
            const float rstd2 = rsqrtf(wave_sum(ss2) * (1.f / D) + NORM_EPS);
#pragma unroll
            for (int j = 0; j < 4; ++j) { const int c = 4 * lane + 256 * j; const f32x4 A2 = *(const f32x4*)(args.in[IN_GPREFFN] + layer * 1024 + c) * (*(const f32x4*)(m1 + 1024 + c) + 1.0f), S2 = *(const f32x4*)(m1 + c);
                const f32x4 hh = x[j] * rstd2 * A2 + S2; u32x2v ph, pl; ph.x = pkbf(hh[0], hh[1]); ph.y = pkbf(hh[2], hh[3]);
                pl.x = pkbf(hh[0] - bflo(ph.x), hh[1] - bfhi(ph.x)); pl.y = pkbf(hh[2] - bflo(ph.y), hh[3] - bfhi(ph.y));
                *(GAS unsigned*)(H2N8 + (size_t)t * D + c) = pk4_fp8(hh[0], hh[1], hh[2], hh[3]);
                *(LAS u32x2v*)(F.lds + row * RT_PITCH + c * 2) = ph; *(LAS u32x2v*)(F.lds + RT_LO + row * RT_PITCH + c * 2) = pl; }
        }
        __syncthreads();
        SEC_END(1); SEC_BEGIN(2);
        {
            f32x4 acc = {0.f, 0.f, 0.f, 0.f};
#pragma unroll
            for (int ks = 0; ks < 16; ++ks) { const bf16x8 a_h = *(const LAS bf16x8*)(ah + ks * 64), a_l = *(const LAS bf16x8*)(al + ks * 64);
                acc = __builtin_amdgcn_mfma_f32_16x16x32_bf16(a_l, b_h[ks], acc, 0, 0, 0); acc = __builtin_amdgcn_mfma_f32_16x16x32_bf16(a_h, b_l[ks], acc, 0, 0, 0); acc = __builtin_amdgcn_mfma_f32_16x16x32_bf16(a_h, b_h[ks], acc, 0, 0, 0); }
            LAS float* lgp = kh == 0 ? LG : (LAS float*)(F.lds + T_LG2);
#pragma unroll
            for (int i = 0; i < 4; ++i) lgp[(16 * th + 4 * kg + i) * 32 + 16 * eh + l16] = acc[i];
        }
        __syncthreads();
        SEC_END(2); SEC_BEGIN(3);
        { const int l16 = lane & 15, row = w * 4 + (lane >> 4);
            const LAS float* LG2 = (const LAS float*)(F.lds + T_LG2);
            float v0 = (LG[row * 32 + l16] + LG2[row * 32 + l16]) + br[l16], v1 = (LG[row * 32 + 16 + l16] + LG2[row * 32 + 16 + l16]) + br[16 + l16]; const int i0 = l16, i1 = l16 + 16;
            float selv[4]; int seli[4];
#pragma unroll
            for (int kk = 0; kk < 4; ++kk) { float bv = v0; int bi = i0; if (v1 > bv) { bv = v1; bi = i1; }
#pragma unroll
                for (int off = 8; off > 0; off >>= 1) { const float ov = __shfl_xor(bv, off); const int oi = __shfl_xor(bi, off); if (ov > bv || (ov == bv && oi < bi)) { bv = ov; bi = oi; } }
                selv[kk] = bv; seli[kk] = bi; if (bi == i0) v0 = -INFINITY; if (bi == i1) v1 = -INFINITY; }
            const float p1 = __expf(selv[1] - selv[0]), p2 = __expf(selv[2] - selv[0]), p3 = __expf(selv[3] - selv[0]), ip = 1.0f / (1.0f + p1 + p2 + p3);
            if (l16 == 0) { const int rl = rnd * 32 + row;
                SEL[rl * 4 + 0] = seli[0]; SEL[rl * 4 + 1] = seli[1]; SEL[rl * 4 + 2] = seli[2]; SEL[rl * 4 + 3] = seli[3];
                GTE[rl * 4 + 0] = ip; GTE[rl * 4 + 1] = p1 * ip; GTE[rl * 4 + 2] = p2 * ip; GTE[rl * 4 + 3] = p3 * ip; }
        }
        SEC_END(3);
    }
    SEC_BEGIN(4);
    __syncthreads();
    if (w == 0) {
        const int s0 = SEL[lane * 4 + 0], s1 = SEL[lane * 4 + 1], s2 = SEL[lane * 4 + 2], s3 = SEL[lane * 4 + 3];
        int r0 = 0, r1 = 0, r2 = 0, r3 = 0, cnt = 0;
        const unsigned long long below = (1ull << lane) - 1ull;
        for (int e = 0; e < 32; ++e) { const bool has = (s0 == e) | (s1 == e) | (s2 == e) | (s3 == e); const unsigned long long mk = __ballot(has); const int rk = __popcll(mk & below);
            if (s0 == e) r0 = rk; if (s1 == e) r1 = rk; if (s2 == e) r2 = rk; if (s3 == e) r3 = rk; if (lane == e) cnt = __popcll(mk); }
        RNK[lane * 4 + 0] = r0; RNK[lane * 4 + 1] = r1; RNK[lane * 4 + 2] = r2; RNK[lane * 4 + 3] = r3;
        if (lane < 32) ((int*)(wsl + WS_HIST))[blockIdx.x * 32 + lane] = cnt;
    }
    SEC_END(4);
}
__device__ __forceinline__ void moe_tile_table(Frame& F, const int* tot  ) {
    if (F.wave == 0) { const int lane = lane_id(); LAS unsigned char* TEXP = (LAS unsigned char*)(F.lds + T_TEXP);
        const int nt = lane < 32 ? ((tot[lane & 31] + 255) >> 8) : 0; int inc = nt;
#pragma unroll
        for (int o = 1; o < 32; o <<= 1) { const int v = __shfl_up(inc, o); if ((lane & 31) >= o) inc += v; }
        const int first = inc - nt;
        for (int q = 0; q < nt; ++q) TEXP[first + q] = (unsigned char)lane;
        if (lane == 31) *(LAS int*)(F.lds + T_MT) = inc; }
}
__device__ __forceinline__ void p6b(Frame& F) {
    unsigned char* const wsl = opaque_ptr(F.ws);
    const int lane = lane_id(); const int w = F.wave, tokb = blockIdx.x * 64;
    LAS int* SEL = (LAS int*)(F.lds + T_SEL); LAS float* GTE = (LAS float*)(F.lds + T_GTE); LAS int* RNK = (LAS int*)(F.lds + T_RNK);
    LAS int* TOT = (LAS int*)(F.lds + T_TOT); LAS int* BEF = (LAS int*)(F.lds + T_BEF); LAS int* MYOFF = (LAS int*)(F.lds + T_MYOFF);
    const int* HIST = (const int*)(wsl + WS_HIST);
    const int tid = F.wave * 64 + lane;
    SEC_BEGIN(5);
    {
        LAS int* PT = (LAS int*)(F.lds + 65536); LAS int* PB = PT + 512;
        const int e = tid & 31, part = tid >> 5; int c[16];
#pragma unroll
        for (int k = 0; k < 16; ++k) c[k] = HIST[(part * 16 + k) * 32 + e];
        int tot = 0, bef = 0;
#pragma unroll
        for (int k = 0; k < 16; ++k) { tot += c[k]; bef += (part * 16 + k < (int)blockIdx.x) ? c[k] : 0; }
        PT[part * 32 + e] = tot; PB[part * 32 + e] = bef;
        __syncthreads();
        if (tid < 32) { int t2 = 0, b2 = 0;
#pragma unroll
            for (int k = 0; k < 16; ++k) { t2 += PT[k * 32 + tid]; b2 += PB[k * 32 + tid]; }
            TOT[tid] = t2; BEF[tid] = b2; if (blockIdx.x == 0) ((int*)(wsl + WS_TOT))[tid] = t2; }
    }
    __syncthreads();
    if (w == 0) { const int nt = lane < 32 ? ((TOT[lane & 31] + 255) >> 8) : 0; int inc = nt;
#pragma unroll
        for (int o = 1; o < 32; o <<= 1) { const int v = __shfl_up(inc, o); if ((lane & 31) >= o) inc += v; }
        if (lane < 32) MYOFF[lane] = (inc - nt) * 256 + BEF[lane];
        LAS unsigned char* TEXP = (LAS unsigned char*)(F.lds + T_TEXP); const int first = inc - nt;
        for (int q = 0; q < nt; ++q) TEXP[first + q] = (unsigned char)lane;
        if (lane == 31) *(LAS int*)(F.lds + T_MT) = inc; }
    __syncthreads();
    int* TOKOF = (int*)(wsl + WS_XS); float* GS = (float*)(wsl + WS_GSORT); int* POSOF = (int*)(wsl + WS_POSOF);
    SEC_END(5); SEC_BEGIN(6);
    if (tid < 256) { const int e = SEL[tid]; const int pos = MYOFF[e] + RNK[tid];
        TOKOF[pos] = tokb + (tid >> 2); GS[pos] = GTE[tid]; POSOF[tokb * 4 + tid] = pos; }
    if (blockIdx.x < 32) { const int e = blockIdx.x, cnt = TOT[e], base = MYOFF[e] - BEF[e], end = (cnt + 255) & ~255;
        for (int i = cnt + tid; i < end; i += NWAVES * 64) TOKOF[base + i] = 0; }
    asm volatile("s_waitcnt vmcnt(0)" ::: "memory");
    SEC_END(6);
}
__device__ __forceinline__ void p9_post(Frame& F, const Args& args, int layer) {
    unsigned char* const wsl = opaque_ptr(F.ws);
    const int lane = lane_id(); const int gw = blockIdx.x * NWAVES + F.wave, NGW = F.G * NWAVES;
    const bool last = layer == 1;
    const float* MOD = (const float*)(wsl + WS_MOD);
    const unsigned char* OUTS = wsl + WS_OUTS; const int* POSOF = (const int*)(wsl + WS_POSOF); bf16* XA = (bf16*)(wsl + WS_XA); bf16* H0 = (bf16*)(wsl + WS_H0);
    for (int t0 = gw * 8; t0 < T; t0 += NGW * 8) {
        const int b = t0 >> 11;
        const float* m1 = MOD + (size_t)((layer * 2 + 1) * 8 + b) * 3072; const float* mn = MOD + (size_t)((1 * 2 + 0) * 8 + b) * 3072;
        f32x4 A3[4], A4[4], S4[4];
#pragma unroll
        for (int j = 0; j < 4; ++j) { const int c = 4 * lane + 256 * j;
            A3[j] = *(const f32x4*)(m1 + 2048 + c) * *(const f32x4*)(args.in[IN_GPOSTFFN] + layer * 1024 + c);
            A4[j] = *(const f32x4*)(args.in[IN_GPREMIX] + 1024 + c) * (*(const f32x4*)(mn + 1024 + c) + 1.0f); S4[j] = *(const f32x4*)(mn + c); }
        const int posv = POSOF[t0 * 4 + (lane & 31)];
        for (int i0 = 0; i0 < 8; i0 += 2) {
            unsigned q[2][4][4]; u32x2v xr[2][4];
#pragma unroll
            for (int u = 0; u < 2; ++u) { const int t = t0 + i0 + u;
#pragma unroll
                for (int k = 0; k < 4; ++k) { const int p = __builtin_amdgcn_readlane(posv, (i0 + u) * 4 + k);
#pragma unroll
                    for (int j = 0; j < 4; ++j) q[u][k][j] = *(const GAS unsigned*)(OUTS + (size_t)p * 1024 + 4 * lane + 256 * j); }
#pragma unroll
                for (int j = 0; j < 4; ++j) xr[u][j] = *(const GAS u32x2v*)(XA + (size_t)t * D + 4 * lane + 256 * j); }
#pragma unroll
            for (int u = 0; u < 2; ++u) { const int t = t0 + i0 + u;
                f32x4 y[4]; float ss = 0.f;
#pragma unroll
                for (int j = 0; j < 4; ++j) { const unsigned a = q[u][0][j], bq = q[u][1][j], cq = q[u][2][j], dq = q[u][3][j];
                    const f32x2v al = __builtin_amdgcn_cvt_pk_f32_fp8(a, false), ah = __builtin_amdgcn_cvt_pk_f32_fp8(a, true), bl = __builtin_amdgcn_cvt_pk_f32_fp8(bq, false), bh = __builtin_amdgcn_cvt_pk_f32_fp8(bq, true);
                    const f32x2v cl = __builtin_amdgcn_cvt_pk_f32_fp8(cq, false), ch = __builtin_amdgcn_cvt_pk_f32_fp8(cq, true), dl = __builtin_amdgcn_cvt_pk_f32_fp8(dq, false), dh = __builtin_amdgcn_cvt_pk_f32_fp8(dq, true);
                    y[j] = (f32x4){((al[0] + bl[0]) + cl[0]) + dl[0], ((al[1] + bl[1]) + cl[1]) + dl[1], ((ah[0] + bh[0]) + ch[0]) + dh[0], ((ah[1] + bh[1]) + ch[1]) + dh[1]} * (1.0f / OUTS_SCALE);
                    ss += dot4(y[j], y[j]); }
                const float rstd = rsqrtf(wave_sum(ss) * (1.f / D) + NORM_EPS);
                f32x4 x[4]; float ss2 = 0.f;
#pragma unroll
                for (int j = 0; j < 4; ++j) { const u32x2v xx = xr[u][j]; x[j] = (f32x4){bflo(xx.x), bfhi(xx.x), bflo(xx.y), bfhi(xx.y)} + A3[j] * (y[j] * rstd); ss2 += dot4(x[j], x[j]); }
                if (last) {
#pragma unroll
                    for (int j = 0; j < 4; ++j) *(GAS f32x4*)(F.out + (size_t)t * D + 4 * lane + 256 * j) = x[j];
                } else {
                    const float rstd2 = rsqrtf(wave_sum(ss2) * (1.f / D) + NORM_EPS);
#pragma unroll
                    for (int j = 0; j < 4; ++j) { const int c = 4 * lane + 256 * j; { u32x2v px; px.x = pkbf(x[j][0], x[j][1]); px.y = pkbf(x[j][2], x[j][3]); *(GAS u32x2v*)(XA + (size_t)t * D + c) = px; }
                        const f32x4 hh = x[j] * rstd2 * A4[j] + S4[j]; u32x2v pw; pw.x = pkbf(hh[0], hh[1]); pw.y = pkbf(hh[2], hh[3]); *(GAS u32x2v*)(H0 + (size_t)t * D + c) = pw; }
                }
            }
        }
    }
}
constexpr int N_PHASES = 19;
#define COMMON_PHASES(layer, pb) \
    const int P_OUT = pb + 3, P_T1 = pb + 4, P_T2 = pb + 5, P_UP = pb + 6, P_DN = pb + 7, P_POST = pb + 8; \
    if (IN(P_OUT)) for (int rep_ = 0; rep_ < 1 + DUPF(P_OUT); ++rep_) { if (rep_) __syncthreads(); \
        SchedPlain S; S.go.init(64, 4, F.G, (int)blockIdx.x); S.A = (const char*)(ws + WS_O); S.B = (const char*)(ws + (layer == 0 ? WS_WOUTA : WS_WOUTB)); \
        EpiPlain E{(bf16*)(ws + WS_Y), 1024}; \
        pg8::gemm_phase<EpiPlain, SchedPlain, true, true>(F.lds, (const char*)ws, 1024, S, E, F.wave); \
    } SEAM(P_OUT); \
    if (IN(P_T1)) for (int rep_ = 0; rep_ < 1 + DUPF(P_T1); ++rep_) { if (rep_) __syncthreads(); p6a(F, args, layer, layer == 0 ? args.in[IN_X] : (const float*)(ws + WS_XA)); } SEAM(P_T1); \
    if (IN(P_T2)) for (int rep_ = 0; rep_ < 1 + DUPF(P_T2); ++rep_) { if (rep_) __syncthreads(); p6b(F); if (layer == 1) { __syncthreads(); cvt_stream<1>(F, args, (int)F.MISC[24] + (int)blockIdx.x * NWAVES + F.wave, F.G * NWAVES, N_DEFER); } } SEAM(P_T2); \
    if (IN(P_UP)) for (int rep_ = 0; rep_ < 1 + DUPF(P_UP); ++rep_) { if (rep_) __syncthreads(); \
        const int mt_ = *(LAS int*)(F.lds + T_MT), cur_ = (int)F.MISC[24]; int Gp = F.G; \
        if (layer == 0) { const int un_ = mt_ * 8, rd_ = (un_ + F.G - 1) / F.G; Gp = ((un_ + rd_ - 1) / rd_ + 7) & ~7; if (Gp > F.G) Gp = F.G; Gp = rfl(Gp); } \
        if ((int)blockIdx.x < Gp) { \
        SchedMoeG S; S.go.init(mt_, 8, Gp, (int)blockIdx.x); S.A = (const char*)(ws + WS_H1); S.W = (const char*)(ws + WS_WUP) + (size_t)layer * 32 * 2048 * 1024; S.wstride = (size_t)2048 * 1024; \
        S.texp = (const LAS unsigned char*)(F.lds + T_TEXP); S.tokof = (const int*)(ws + WS_XS); \
        EpiSwiglu E{ws + WS_ACT, args.in[IN_BUP] + (size_t)layer * 32 * 2048}; \
        pg8::gemm_phase<EpiSwiglu, SchedMoeG, true, true, true, true>(F.lds, (const char*)ws, 512, S, E, F.wave); \
        } else if (layer == 0) pocket_convert(F, args, cur_, Gp, Q_UP); \
        if (layer == 0) { __syncthreads(); if (threadIdx.x == 0) F.MISC[24] = (unsigned)pocket_end(F, cur_, Gp, Q_UP); } \
    } SEAM(P_UP); \
    if (IN(P_DN)) for (int rep_ = 0; rep_ < 1 + DUPF(P_DN); ++rep_) { if (rep_) __syncthreads(); \
        const int mt_ = *(LAS int*)(F.lds + T_MT), cur_ = (int)F.MISC[24]; int Gp = F.G; \
        if (layer == 0) { const int un_ = mt_ * 4, rd_ = (un_ + F.G - 1) / F.G; Gp = ((un_ + rd_ - 1) / rd_ + 7) & ~7; if (Gp > F.G) Gp = F.G; Gp = rfl(Gp); } \
        if ((int)blockIdx.x < Gp) { \
        SchedMoe S; S.go.init(mt_, 4, Gp, (int)blockIdx.x); S.A = (const char*)(ws + WS_ACT); S.W = (const char*)(ws + WS_WDOWN) + (size_t)layer * 32 * 1024 * 1024; S.wstride = (size_t)1024 * 1024; \
        S.texp = (const LAS unsigned char*)(F.lds + T_TEXP); \
        EpiDown E{ws + WS_OUTS, args.in[IN_BDOWN] + (size_t)layer * 32 * 1024, (const float*)(ws + WS_GSORT)}; \
        pg8::gemm_phase<EpiDown, SchedMoe, true, true, true>(F.lds, (const char*)ws, 512, S, E, F.wave); \
        } else if (layer == 0) pocket_convert(F, args, cur_, Gp, Q_DN); \
        if (layer == 0) { __syncthreads(); if (threadIdx.x == 0) F.MISC[24] = (unsigned)pocket_end(F, cur_, Gp, Q_DN); } \
    } SEAM(P_DN); \
    if (IN(P_POST)) for (int rep_ = 0; rep_ < 1 + (DUPF(10) && layer == 1); ++rep_) { if (rep_) __syncthreads(); p9_post(F, args, layer); }
__global__ void __launch_bounds__(NWAVES * 64, 2) mega_fwd(Args args) {
    extern __shared__ __attribute__((aligned(16))) unsigned char lds[];
    Frame F;
    F.lds = (LAS unsigned char*)lds;
    F.MISC = (volatile LAS unsigned*)(F.lds + MISC_OFF);
    F.wave = __builtin_amdgcn_readfirstlane((int)threadIdx.x >> 6);
    F.G = gridDim.x; { const int bx = blockIdx.x; F.vcu = (bx % 8) * (F.G / 8) + bx / 8; }
    F.out = args.out; F.ws = args.ws; F.ctl = (gu32*)(args.ws + WS_CTL);
    for (int u = threadIdx.x; u < (LDS_BYTES - LDSCTL_OFF) / 4; u += NWAVES * 64) ((LAS unsigned*)(F.lds + LDSCTL_OFF))[u] = 0u;
    __syncthreads();
    XcdBarrier bar = xcd_barrier_post((unsigned*)(F.ctl + CW_BAR) + args.li * XCD_BAR_WORDS, F.MISC + 8);
    const int lo = args.ph_lo, hi = args.ph_hi;
#ifndef DUP_MASK
#define DUP_MASK 0u
#endif
#define DUPF(k) ((int)((DUP_MASK >> (k)) & 1u))
#ifndef PHMASK
#define PHMASK 0xFFFFFFFFu
#endif
#define IN(k) (((PHMASK >> ((k) > 10 ? (k) - 8 : (k))) & 1u) && lo <= (k) && (k) < hi)
#define SEAM(k) do { if (IN(k) && IN((k) + 1)) { xcd_barrier(bar); if (DUPF(20)) xcd_barrier(bar); } } while (0)

    if (IN(0)) for (int rep_ = 0; rep_ < 1 + DUPF(0); ++rep_) { if (rep_) __syncthreads(); p0_prologue(F, args); } SEAM(0);
    if (IN(1)) for (int rep_ = 0; rep_ < 1 + DUPF(1); ++rep_) { if (rep_) __syncthreads(); p1_prenorm0(F, args); } SEAM(1);

    { unsigned char* ws = opaque_ptr(args.ws);
        if (IN(2)) for (int rep_ = 0; rep_ < 1 + DUPF(2); ++rep_) { if (rep_) __syncthreads();
            { SchedInaQK S; S.go.init(64, 24, F.G, (int)blockIdx.x); S.h0 = (const char*)(ws + WS_H0); S.w = (const char*)(ws + WS_WINA_QK);
              EpiRopeA E{(bf16*)(ws + WS_QA), (bf16*)(ws + WS_KA)};
              pg8::gemm_phase<EpiRopeA, SchedInaQK, true, true, true>(F.lds, (const char*)ws, 512, S, E, F.wave); }
            { SchedInaV S; S.go.init(12, 64, F.G, (int)blockIdx.x); S.h0 = (const char*)(ws + WS_H0); S.w = (const char*)(ws + WS_WINA_V);
              EpiVt E{(bf16*)(ws + WS_VTA)};
              pg8::gemm_phase<EpiVt, SchedInaV, true, true, true>(F.lds, (const char*)ws, 512, S, E, F.wave); }
        } SEAM(2);
        if (IN(3)) for (int rep_ = 0; rep_ < 1 + DUPF(3); ++rep_) { if (rep_) __syncthreads(); p3_attn_a(F); } do { if (IN(3) && IN(5)) xcd_barrier(bar); } while (0);
    }
    { unsigned char* ws = opaque_ptr(args.ws); COMMON_PHASES(0, 2) }
    SEAM(10);
    { unsigned char* ws = opaque_ptr(args.ws);
        if (IN(11)) for (int rep_ = 0; rep_ < 1 + DUPF(11); ++rep_) { if (rep_) __syncthreads();
            const int cur_ = (int)F.MISC[24]; constexpr int Gp = 192;
            if ((int)blockIdx.x < Gp) {
            SchedPlain S; S.go.init(64, 6, Gp, (int)blockIdx.x); S.A = (const char*)(ws + WS_H0); S.B = (const char*)(ws + WS_WINB);
            EpiInB E{(bf16*)(ws + WS_QB), (bf16*)(ws + WS_KB), (bf16*)(ws + WS_VB), args.in[IN_GQB], args.in[IN_GKB]};
            pg8::gemm_phase<EpiInB, SchedPlain, true, true>(F.lds, (const char*)ws, 1024, S, E, F.wave);
            } else pocket_convert(F, args, cur_, Gp, Q_INB);
            __syncthreads(); if (threadIdx.x == 0) F.MISC[24] = (unsigned)pocket_end(F, cur_, Gp, Q_INB);
        } SEAM(11);
        if (IN(12)) for (int rep_ = 0; rep_ < 1 + DUPF(12); ++rep_) { if (rep_) __syncthreads();
            const int xcd = F.vcu >> 5, j = F.vcu & 31;
            for (int i = 0; i < 4; ++i) { const int pair = xcd * 4 + i, b = pair >> 2, kvh = pair & 3, hq = kvh * 4 + (j >> 3), qb = j & 7;
                attn_body::attn_unit<8>(b, hq, kvh, qb, (const attn_body::bf16*)(ws + WS_QB), (const attn_body::bf16*)(ws + WS_KB), (const attn_body::bf16*)(ws + WS_VB), (attn_body::bf16*)(ws + WS_O), (char*)lds, F.wave); }
        } SEAM(12);
    }
    { unsigned char* ws = opaque_ptr(args.ws); COMMON_PHASES(1, 10) }
    if (PSEC > 0) { __syncthreads(); const unsigned long long te_ = __builtin_amdgcn_s_memrealtime(); const unsigned dd_ = F.MISC[16]; while (__builtin_amdgcn_s_memrealtime() - te_ < dd_) __builtin_amdgcn_s_sleep(8); }
#undef IN
#undef SEAM
#undef COMMON_PHASES
}
static int g_grid = 0;
static bool mega_setup() {
    if (g_grid == 0) {
        int dev = 0, cus = 0;
        if (hipGetDevice(&dev) != hipSuccess || hipDeviceGetAttribute(&cus, hipDeviceAttributeMultiprocessorCount, dev) != hipSuccess) { g_grid = -1; return false; }
        if (hipFuncSetAttribute((const void*)mega_fwd, hipFuncAttributeMaxDynamicSharedMemorySize, LDS_BYTES) != hipSuccess) { fprintf(stderr, "hipFuncSetAttribute failed\n"); g_grid = -1; return false; }
        int per_cu = 0;
        if (hipOccupancyMaxActiveBlocksPerMultiprocessor(&per_cu, (const void*)mega_fwd, NWAVES * 64, LDS_BYTES) != hipSuccess || per_cu < 1) { fprintf(stderr, "occupancy query: %d\n", per_cu); }
        (void)hipGetLastError();
        if (cus != 256) { fprintf(stderr, "built for 256 CUs, found %d\n", cus); g_grid = -1; return false; }
        g_grid = 256;
    }
    return g_grid > 0;
}
static void mega_launch(void* const* d_in, float* out, unsigned char* ws, int lo, int hi, int li, hipStream_t stream) {
    Args a{};
    for (int i = 0; i < 20; ++i) a.in[i] = (const float*)d_in[i];
    a.out = out; a.ws = ws; a.ph_lo = lo; a.ph_hi = hi; a.li = li; a.pad = 0;
    hipLaunchKernelGGL(mega_fwd, dim3(g_grid), dim3(NWAVES * 64), LDS_BYTES, stream, a);
}
extern "C" void kernel_launch(void* const* d_in, const int* in_sizes, int n_in, void* d_out, int out_size, void* d_ws, size_t ws_size, hipStream_t stream) {
    if (n_in != 20 || ws_size < WS_END || out_size != T * D) { fprintf(stderr, "kernel_launch: unexpected n_in %d / ws %zu / out %d\n", n_in, ws_size, out_size); return; }
    if (!mega_setup()) return;
    unsigned char* ws = (unsigned char*)d_ws;
    (void)hipMemsetAsync(ws + WS_CTL, 0, CTL_ZERO_BYTES, stream);
    mega_launch(d_in, (float*)d_out, ws, 0, N_PHASES, 0, stream);
}
```
